# Optimizing an MI355X kernel written in HIP

```python
import jax, jax.numpy as jnp
from jax import lax
import numpy as np

D_MODEL = 1024
BATCH = 8
SEQ = 4096
DEPTH = 1

HEAD_DIM = 64
A_HEADS = 8
A_Q_RANK = 256
A_V_LATENT = 128
IDX_HEADS = 8
IDX_DIM = 64
B_HEADS = 8
D_FF = 2816
MAX_TOPK = 256
Q_BLOCK = 128
ROPE_THETA = 10000.0
EPS = 1e-6
A_WIDTH = A_HEADS * HEAD_DIM
B_WIDTH = B_HEADS * HEAD_DIM
IN_SPLITS = (A_Q_RANK, HEAD_DIM, A_V_LATENT, IDX_DIM, IDX_HEADS,
             B_WIDTH, B_WIDTH, B_WIDTH, D_MODEL, D_MODEL)
IN_COLS = sum(IN_SPLITS)

kernel_name = 'hybrid_dsa_stickbreak_macaron'


def rms_norm(x, g):
    xf = x.astype(jnp.float32)
    y = xf * lax.rsqrt(jnp.mean(xf * xf, axis=-1, keepdims=True) + EPS)
    return (y * g.astype(jnp.float32)).astype(x.dtype)


def swiglu(h, w_gate, w_up, w_down):
    return (jax.nn.silu(h @ w_gate) * (h @ w_up)) @ w_down


def rope_tables(positions, dim):
    inv_freq = ROPE_THETA ** (-jnp.arange(0, dim, 2, dtype=jnp.float32) / dim)
    ang = positions.astype(jnp.float32)[..., None] * inv_freq
    return jnp.cos(ang), jnp.sin(ang)


def apply_rope(x, cos, sin):
    xf = x.astype(jnp.float32)
    x1, x2 = jnp.split(xf, 2, axis=-1)
    return jnp.concatenate([x1 * cos - x2 * sin, x1 * sin + x2 * cos], axis=-1).astype(x.dtype)


def dsa_attention(q_a, k_a, v_a, q_idx, k_idx, w_idx, w_uv, top_k):
    bsz, seq = k_a.shape[0], k_a.shape[1]
    n_blocks = seq // Q_BLOCK
    key_pos = jnp.arange(seq)

    def block(i):
        q0 = i * Q_BLOCK
        qa = lax.dynamic_slice_in_dim(q_a, q0, Q_BLOCK, axis=1)
        qi = lax.dynamic_slice_in_dim(q_idx, q0, Q_BLOCK, axis=1)
        wi = lax.dynamic_slice_in_dim(w_idx, q0, Q_BLOCK, axis=1)
        t_pos = q0 + jnp.arange(Q_BLOCK)
        dots = jnp.einsum('bthd,bsd->bths', qi.astype(jnp.float32), k_idx.astype(jnp.float32))
        score = jnp.einsum('bths,bth->bts', jax.nn.relu(dots), wi.astype(jnp.float32))
        causal = key_pos[None, :] <= t_pos[:, None]
        score = jnp.where(causal[None], score, -jnp.inf)
        _, idx = lax.top_k(score, top_k)
        valid = idx <= t_pos[None, :, None]
        flat = idx.reshape(bsz, Q_BLOCK * top_k)[:, :, None]
        kg = jnp.take_along_axis(k_a, flat, axis=1).reshape(bsz, Q_BLOCK, top_k, HEAD_DIM)
        vg = jnp.take_along_axis(v_a, flat, axis=1).reshape(bsz, Q_BLOCK, top_k, A_V_LATENT)
        logits = jnp.einsum('bthd,btkd->bthk', qa.astype(jnp.float32), kg.astype(jnp.float32)) * (HEAD_DIM ** -0.5)
        logits = jnp.where(valid[:, :, None, :], logits, -jnp.inf)
        p = jax.nn.softmax(logits, axis=-1).astype(v_a.dtype)
        o_lat = jnp.einsum('bthk,btkc->bthc', p, vg)
        o = jnp.einsum('bthc,hcd->bthd', o_lat, w_uv)
        return o.reshape(bsz, Q_BLOCK, A_WIDTH)

    out = lax.map(block, jnp.arange(n_blocks))
    return out.transpose(1, 0, 2, 3).reshape(bsz, seq, A_WIDTH)


def stick_breaking_attention(q_b, k_b, v_b):
    bsz, seq = q_b.shape[0], q_b.shape[1]
    n_blocks = seq // Q_BLOCK
    key_pos = jnp.arange(seq)

    def block(i):
        q0 = i * Q_BLOCK
        qb = lax.dynamic_slice_in_dim(q_b, q0, Q_BLOCK, axis=1)
        t_pos = q0 + jnp.arange(Q_BLOCK)
        z = jnp.einsum('bthd,bshd->bhts', qb.astype(jnp.float32), k_b.astype(jnp.float32)) * (HEAD_DIM ** -0.5)
        strict = (key_pos[None, :] < t_pos[:, None])[None, None]
        log_not = jnp.where(strict, jax.nn.log_sigmoid(-z), 0.0)
        between = lax.cumsum(log_not, axis=3, reverse=True) - log_not
        log_a = jax.nn.log_sigmoid(z) + between
        a = jnp.where(strict, jnp.exp(log_a), 0.0).astype(v_b.dtype)
        o = jnp.einsum('bhts,bshd->bthd', a, v_b)
        return o.reshape(bsz, Q_BLOCK, B_WIDTH)

    out = lax.map(block, jnp.arange(n_blocks))
    return out.transpose(1, 0, 2, 3).reshape(bsz, seq, B_WIDTH)


def setup_inputs(seed: int = 0) -> dict:
    key = jax.random.key(seed)
    ks = jax.random.split(key, 24)
    f32 = jnp.float32

    def w(k, shape, fan_in):
        return jax.random.normal(k, shape, f32) * (fan_in ** -0.5)

    def gain(k, shape):
        return 1.0 + 0.02 * jax.random.normal(k, shape, f32)

    L = DEPTH
    return {
        'x': jax.random.normal(ks[0], (BATCH, SEQ, D_MODEL), f32),
        'positions': jnp.broadcast_to(jnp.arange(SEQ, dtype=jnp.int32), (BATCH, SEQ)),
        'g_ffn1': gain(ks[1], (L, D_MODEL)),
        'w1_gate': w(ks[2], (L, D_MODEL, D_FF), D_MODEL),
        'w1_up': w(ks[3], (L, D_MODEL, D_FF), D_MODEL),
        'w1_down': w(ks[4], (L, D_FF, D_MODEL), D_FF),
        'g_mix': gain(ks[5], (L, D_MODEL)),
        'w_in': w(ks[6], (L, D_MODEL, IN_COLS), D_MODEL),
        'g_cq': gain(ks[7], (L, A_Q_RANK)),
        'w_uq_a': w(ks[8], (L, A_Q_RANK, A_WIDTH), A_Q_RANK),
        'w_q_idx': w(ks[9], (L, A_Q_RANK, IDX_HEADS * IDX_DIM), A_Q_RANK),
        'g_q_a': gain(ks[10], (L, HEAD_DIM)),
        'g_k_a': gain(ks[11], (L, HEAD_DIM)),
        'w_uv_a': w(ks[12], (L, A_HEADS, A_V_LATENT, HEAD_DIM), A_V_LATENT),
        'w_o_a': w(ks[13], (L, A_WIDTH, D_MODEL), A_WIDTH),
        'w_o_b': w(ks[14], (L, B_WIDTH, D_MODEL), B_WIDTH),
        'w_out': w(ks[15], (L, D_MODEL, D_MODEL), D_MODEL),
        'g_ffn2': gain(ks[16], (L, D_MODEL)),
        'w2_gate': w(ks[17], (L, D_MODEL, D_FF), D_MODEL),
        'w2_up': w(ks[18], (L, D_MODEL, D_FF), D_MODEL),
        'w2_down': w(ks[19], (L, D_FF, D_MODEL), D_FF),
    }


def reference(x, positions, g_ffn1, w1_gate, w1_up, w1_down, g_mix, w_in, g_cq, w_uq_a, w_q_idx,
              g_q_a, g_k_a, w_uv_a, w_o_a, w_o_b, w_out, g_ffn2, w2_gate, w2_up, w2_down):
    bsz, seq, _ = x.shape
    top_k = min(MAX_TOPK, seq // 4)
    cos, sin = rope_tables(positions, HEAD_DIM)
    cos_h, sin_h = cos[:, :, None, :], sin[:, :, None, :]
    offsets = [int(o) for o in np.cumsum(IN_SPLITS)[:-1]]
    for l in range(DEPTH):
        x = x + 0.5 * swiglu(rms_norm(x, g_ffn1[l]), w1_gate[l], w1_up[l], w1_down[l])

        h = rms_norm(x, g_mix[l])
        proj = h @ w_in[l]
        (c_q, k_a, v_a, k_idx, w_idx, q_b, k_b, v_b, gate_a, gate_b) = jnp.split(proj, offsets, axis=-1)

        c_q = rms_norm(c_q, g_cq[l])
        q_a = (c_q @ w_uq_a[l]).reshape(bsz, seq, A_HEADS, HEAD_DIM)
        q_a = apply_rope(rms_norm(q_a, g_q_a[l]), cos_h, sin_h)
        k_a = apply_rope(rms_norm(k_a, g_k_a[l]), cos, sin)
        q_idx = apply_rope((c_q @ w_q_idx[l]).reshape(bsz, seq, IDX_HEADS, IDX_DIM), cos_h, sin_h)
        k_idx = apply_rope(k_idx, cos, sin)
        w_idx = w_idx * ((IDX_HEADS ** -0.5) * (IDX_DIM ** -0.5))
        y_a = dsa_attention(q_a, k_a, v_a, q_idx, k_idx, w_idx, w_uv_a[l], top_k)

        y_b = stick_breaking_attention(q_b.reshape(bsz, seq, B_HEADS, HEAD_DIM),
                                       k_b.reshape(bsz, seq, B_HEADS, HEAD_DIM),
                                       v_b.reshape(bsz, seq, B_HEADS, HEAD_DIM))

        merged = jax.nn.sigmoid(gate_a) * (y_a @ w_o_a[l]) + jax.nn.sigmoid(gate_b) * (y_b @ w_o_b[l])
        x = x + merged @ w_out[l]

        x = x + 0.5 * swiglu(rms_norm(x, g_ffn2[l]), w2_gate[l], w2_up[l], w2_down[l])
    return x
```

```cpp
#include <hip/hip_runtime.h>
#include <hip/hip_cooperative_groups.h>
#include <stdint.h>
#include <stdio.h>
namespace cg = cooperative_groups;

#ifndef MULTI_LAUNCH
#define MULTI_LAUNCH 0
#endif

#define DI __device__ __forceinline__
typedef unsigned short bf16_t;
typedef __attribute__((ext_vector_type(8))) short bf16x8;
typedef __attribute__((ext_vector_type(16))) float f32x16;
typedef __attribute__((ext_vector_type(4))) float f32x4;
typedef __attribute__((ext_vector_type(4))) unsigned u32x4;
typedef __attribute__((ext_vector_type(2))) unsigned u32x2;

constexpr int T_ = 32768, S_ = 4096, D_ = 1024, FF = 2816;
constexpr int PA_LD = 1536;
constexpr int PA_KA = 256, PA_VA = 320, PA_KI = 448, PA_QB = 512, PA_KB = 1024;
constexpr float EPS = 1e-6f;
constexpr float LOG2E = 1.4426950408889634f;

constexpr size_t W1GU = 0;
constexpr size_t W1D = W1GU + (size_t)5632 * 1024;
constexpr size_t W2GU = W1D + (size_t)1024 * 2816;
constexpr size_t W2D = W2GU + (size_t)5632 * 1024;
constexpr size_t WIN = W2D + (size_t)1024 * 2816;
constexpr size_t WQ = WIN + (size_t)4224 * 1024;
constexpr size_t WUV = WQ + (size_t)1024 * 256;
constexpr size_t WOA = WUV + (size_t)512 * 128;
constexpr size_t WOB = WOA + (size_t)1024 * 512;
constexpr size_t WOUT = WOB + (size_t)1024 * 512;
constexpr size_t WB_ELEMS = WOUT + (size_t)1024 * 1024;
constexpr size_t OFF_WB = 0;
constexpr size_t OFF_H = (WB_ELEMS * 2 + 255) & ~(size_t)255;
constexpr size_t OFF_PA = OFF_H + (size_t)T_ * 1024 * 2;
constexpr size_t OFF_VT = OFF_PA + (size_t)T_ * PA_LD * 2;
constexpr size_t OFF_GATES = OFF_VT + (size_t)T_ * 512 * 2;
constexpr size_t OFF_SLAB = OFF_GATES + (size_t)T_ * 2048 * 2;
constexpr size_t OFF_WIDX = OFF_SLAB + (size_t)512 * 16 * 4096 * 4;
constexpr size_t OFF_ROPE = OFF_WIDX + (size_t)T_ * 8 * 4;
constexpr size_t OFF_CNT = OFF_ROPE + (size_t)T_ * 32 * 8;
constexpr size_t WS_NEED = OFF_CNT + 256 + 16384;
static_assert(WS_NEED <= (size_t)512 * 1024 * 1024, "workspace too large");
static_assert((size_t)T_ * FF * 2 <= OFF_SLAB - OFF_PA, "U must fit in PA+VT+GATES");

constexpr int SMEM_BYTES = 73728;

struct Params {
  const float* x; const int* pos;
  const float *g_ffn1, *w1g, *w1u, *w1d, *g_mix, *w_in, *g_cq, *w_uq, *w_qi, *g_qa, *g_ka, *w_uv, *w_oa, *w_ob, *w_out, *g_ffn2, *w2g, *w2u, *w2d;
  float* out;
  char* ws;
};

DI unsigned f2bf(float x) { unsigned u = __float_as_uint(x); u += 0x7fffu + ((u >> 16) & 1u); return u >> 16; }
DI unsigned pack2(float a, float b) { return f2bf(a) | (f2bf(b) << 16); }
DI float bf2f(unsigned v) { return __uint_as_float(v << 16); }
DI float bflo(unsigned v) { return __uint_as_float(v << 16); }
DI float bfhi(unsigned v) { return __uint_as_float(v & 0xffff0000u); }
DI float fexp2(float x) { return __builtin_amdgcn_exp2f(x); }
DI float frcp(float x) { return __builtin_amdgcn_rcpf(x); }
DI float wave_sum(float v) {
#pragma unroll
  for (int o = 32; o > 0; o >>= 1) v += __shfl_xor(v, o);
  return v;
}
#define MFMA32(a, b, c) __builtin_amdgcn_mfma_f32_32x32x16_bf16((a), (b), (c), 0, 0, 0)
#define MFMA16(a, b, c) __builtin_amdgcn_mfma_f32_16x16x32_bf16((a), (b), (c), 0, 0, 0)
DI bf16x8 ld_frag_g(const bf16_t* p) { return __builtin_bit_cast(bf16x8, *(const u32x4*)p); }
DI bf16x8 ld_frag_s(const char* p) { return __builtin_bit_cast(bf16x8, *(const u32x4*)p); }
DI int otid() { int t = threadIdx.x; asm volatile("" : "+v"(t)); return t; }
DI int owid(int tid) { return __builtin_amdgcn_readfirstlane(tid >> 6); }
DI int crow(int reg, int g) { return (reg & 3) + 8 * (reg >> 2) + 4 * g; }

DI const float* prep_col(const Params& p, int mat, int r, int& ld) {
  switch (mat) {
    case 0: case 2: {
      int j = r >> 7, q = r & 127; int wn = q >> 6, half = (q >> 5) & 1, c = q & 31;
      int n = j * 64 + wn * 32 + c; ld = FF;
      const float* g = mat == 0 ? p.w1g : p.w2g; const float* u = mat == 0 ? p.w1u : p.w2u;
      return (half ? u : g) + n;
    }
    case 1: ld = D_; return p.w1d + r;
    case 3: ld = D_; return p.w2d + r;
    case 4: {
      ld = 4104;
      if (r < 512) return p.w_in + r;
      if (r < 4096) return p.w_in + r + 8;
      if (r < 4104) return p.w_in + (r - 4096 + 512);
      return nullptr;
    }
    case 5: ld = 512; return r < 512 ? p.w_uq + r : p.w_qi + (r - 512);
    case 6: { ld = 64; int h = r >> 6, d = r & 63; return p.w_uv + h * 8192 + d; }
    case 7: ld = D_; return p.w_oa + r;
    case 8: ld = D_; return p.w_ob + r;
    default: ld = D_; return p.w_out + r;
  }
}

DI void prep_transpose_tile(const Params& p, int mat, int K, bf16_t* dst, int tile, float* lds) {
  const int nkt = K >> 6;
  const int r0 = (tile / nkt) * 32, k0 = (tile % nkt) * 64;
  const int tid = otid(), tx = tid & 31, ty = tid >> 5;
  int ld; const float* col = prep_col(p, mat, r0 + tx, ld);
#pragma unroll
  for (int i = 0; i < 8; ++i) {
    int k = k0 + ty + 8 * i;
    float v = 0.f;
    if (col) { v = col[(size_t)k * ld]; if (mat == 5) v *= p.g_cq[k]; }
    lds[tx * 65 + ty + 8 * i] = v;
  }
  __syncthreads();
  {
    const int row = tid >> 3, kc = (tid & 7) * 8;
    const float* s = lds + row * 65 + kc;
    u32x4 o; o[0] = pack2(s[0], s[1]); o[1] = pack2(s[2], s[3]); o[2] = pack2(s[4], s[5]); o[3] = pack2(s[6], s[7]);
    *(u32x4*)(dst + (size_t)(r0 + row) * K + k0 + kc) = o;
  }
  __syncthreads();
}

DI void rmsnorm_row(const float* __restrict__ xr, const float* __restrict__ g, bf16_t* __restrict__ o) {
  const int lane = otid() & 63;
  float4 v[4]; float ss = 0.f;
#pragma unroll
  for (int j = 0; j < 4; ++j) { v[j] = *(const float4*)(xr + lane * 4 + 256 * j); ss += v[j].x * v[j].x + v[j].y * v[j].y + v[j].z * v[j].z + v[j].w * v[j].w; }
  ss = wave_sum(ss);
  const float rs = rsqrtf(ss * (1.f / 1024.f) + EPS);
#pragma unroll
  for (int j = 0; j < 4; ++j) {
    float4 gg = *(const float4*)(g + lane * 4 + 256 * j);
    u32x2 w; w[0] = pack2(v[j].x * rs * gg.x, v[j].y * rs * gg.y); w[1] = pack2(v[j].z * rs * gg.z, v[j].w * rs * gg.w);
    *(u32x2*)(o + lane * 4 + 256 * j) = w;
  }
}

DI void phase_rmsnorm(const float* __restrict__ src, const float* __restrict__ g, bf16_t* __restrict__ dst) {
  const int wid = owid(otid());
  for (int it = blockIdx.x; it < T_ / 4; it += gridDim.x) {
    int row = it * 4 + wid;
    rmsnorm_row(src + (size_t)row * D_, g, dst + (size_t)row * D_);
  }
}

DI void phase_prep(const Params& p, char* smem) {
  bf16_t* wb = (bf16_t*)(p.ws + OFF_WB);
  float* lds = (float*)smem;
  constexpr int c0 = 2816, c1 = c0 + 1408, c2 = c1 + 2816, c3 = c2 + 1408, c4 = c3 + 2112, c5 = c4 + 128, c6 = c5 + 32, c7 = c6 + 256, c8 = c7 + 256, c9 = c8 + 512;
  constexpr int nrms = T_ / 4, nrope = T_ * 32 / 256;
  const int total = c9 + nrms + nrope;
  for (int it = blockIdx.x; it < total; it += gridDim.x) {
    if (it < c9) {
      int mat, K, base; size_t off;
      if (it < c0) { mat = 0; K = 1024; base = 0; off = W1GU; }
      else if (it < c1) { mat = 1; K = 2816; base = c0; off = W1D; }
      else if (it < c2) { mat = 2; K = 1024; base = c1; off = W2GU; }
      else if (it < c3) { mat = 3; K = 2816; base = c2; off = W2D; }
      else if (it < c4) { mat = 4; K = 1024; base = c3; off = WIN; }
      else if (it < c5) { mat = 5; K = 256; base = c4; off = WQ; }
      else if (it < c6) { mat = 6; K = 128; base = c5; off = WUV; }
      else if (it < c7) { mat = 7; K = 512; base = c6; off = WOA; }
      else if (it < c8) { mat = 8; K = 512; base = c7; off = WOB; }
      else { mat = 9; K = 1024; base = c8; off = WOUT; }
      prep_transpose_tile(p, mat, K, wb + off, it - base, lds);
    } else if (it < c9 + nrms) {
      int row = (it - c9) * 4 + owid(otid());
      rmsnorm_row(p.x + (size_t)row * D_, p.g_ffn1, (bf16_t*)(p.ws + OFF_H) + (size_t)row * D_);
    } else {
      int e = (it - c9 - nrms) * 256 + otid();
      int tok = e >> 5, i = e & 31;
      float inv_freq = exp2f(-(float)i * (13.287712379549449f / 32.f));
      float ang = (float)p.pos[tok] * inv_freq;
      double rev = (double)ang * 0.15915494309189535;
      rev -= floor(rev);
      float r = (float)rev;
      float2 cs; cs.x = __builtin_amdgcn_cosf(r); cs.y = __builtin_amdgcn_sinf(r);
      ((float2*)(p.ws + OFF_ROPE))[e] = cs;
    }
  }
}

template <int LDA, int LDB, int NK>
DI void gemm_mainloop(const bf16_t* __restrict__ A, const bf16_t* __restrict__ B, char* smem, f32x16 (&acc)[2][2]) {
  const int tid = otid(), lane = tid & 63, wid = owid(tid), wm = wid >> 1, wn = wid & 1;
  const int lrow = tid >> 3, lch = tid & 7;
  const char* Ab = (const char*)A; const char* Bb = (const char*)B;
  const unsigned la = (unsigned)(lrow * LDA + lch * 8) * 2u, lb = (unsigned)(lrow * LDB + lch * 8) * 2u;
  const unsigned st_off = lrow * 128 + ((lch ^ ((lrow >> 1) & 7)) << 4);
  const int sw = (lane >> 1) & 7, g = lane >> 5;
  unsigned a_off[4], b_off[4];
#pragma unroll
  for (int ks = 0; ks < 4; ++ks) {
    unsigned c = (unsigned)(((ks * 2 + g) ^ sw) << 4);
    a_off[ks] = (wm * 64 + (lane & 31)) * 128 + c;
    b_off[ks] = 16384 + (wn * 64 + (lane & 31)) * 128 + c;
  }
  u32x4 ra[4], rb[4];
#pragma unroll
  for (int i = 0; i < 4; ++i) { ra[i] = *(const u32x4*)((Ab + (size_t)i * 64 * LDA) + la); rb[i] = *(const u32x4*)((Bb + (size_t)i * 64 * LDB) + lb); }
#pragma unroll
  for (int i = 0; i < 4; ++i) { *(u32x4*)(smem + st_off + i * 4096) = ra[i]; *(u32x4*)(smem + 16384 + st_off + i * 4096) = rb[i]; }
  __syncthreads();
  for (int kt = 0; kt < NK; ++kt) {
    const char* cur = smem + (kt & 1) * 32768;
    char* nxt = smem + ((kt + 1) & 1) * 32768;
    const bool more = kt + 1 < NK;
    if (more) {
      const char* An = Ab + (size_t)(kt + 1) * 128; const char* Bn = Bb + (size_t)(kt + 1) * 128;
#pragma unroll
      for (int i = 0; i < 4; ++i) { ra[i] = *(const u32x4*)((An + (size_t)i * 64 * LDA) + la); rb[i] = *(const u32x4*)((Bn + (size_t)i * 64 * LDB) + lb); }
    }
#pragma unroll
    for (int ks = 0; ks < 4; ++ks) {
      bf16x8 a0 = ld_frag_s(cur + a_off[ks]), a1 = ld_frag_s(cur + a_off[ks] + 4096);
      bf16x8 b0 = ld_frag_s(cur + b_off[ks]), b1 = ld_frag_s(cur + b_off[ks] + 4096);
      acc[0][0] = MFMA32(a0, b0, acc[0][0]);
      acc[0][1] = MFMA32(a0, b1, acc[0][1]);
      acc[1][0] = MFMA32(a1, b0, acc[1][0]);
      acc[1][1] = MFMA32(a1, b1, acc[1][1]);
    }
    if (more) {
#pragma unroll
      for (int i = 0; i < 4; ++i) { *(u32x4*)(nxt + st_off + i * 4096) = ra[i]; *(u32x4*)(nxt + 16384 + st_off + i * 4096) = rb[i]; }
    }
    __syncthreads();
  }
}

DI void zero_acc(f32x16 (&acc)[2][2]) {
#pragma unroll
  for (int a = 0; a < 2; ++a)
#pragma unroll
    for (int b = 0; b < 2; ++b)
#pragma unroll
      for (int r = 0; r < 16; ++r) acc[a][b][r] = 0.f;
}

DI int sched_tile(int it, int MT, int NT, int& mt, int& nt) {
  const int G = gridDim.x, b = blockIdx.x;
  const int per = G >> 3, pm = per >> 2;
  if ((G & 31) == 0 && pm > 0 && (MT % pm) == 0) {
    const int x = b & 7, j = b >> 3;
    const int nsn = (NT + 3) >> 2, nsm = MT / pm;
    const int st = it * 8 + x;
    if (st >= nsm * nsn) return -1;
    const int sm = st / nsn, sn = st - sm * nsn;
    mt = sm * pm + (j % pm); nt = sn * 4 + (j / pm);
    return nt < NT ? 1 : 0;
  } else {
    const int tile = it * G + b;
    if (tile >= MT * NT) return -1;
    nt = tile % NT; mt = tile / NT;
    return 1;
  }
}

DI void phase_ffn_gu(const Params& p, size_t woff, char* smem) {
  const bf16_t* H = (const bf16_t*)(p.ws + OFF_H);
  const bf16_t* W = (const bf16_t*)(p.ws + OFF_WB) + woff;
  bf16_t* U = (bf16_t*)(p.ws + OFF_PA);
  const int tid = otid(), lane = tid & 63, wid = owid(tid), wm = wid >> 1, wn = wid & 1, g = lane >> 5;
  for (int it = 0;; ++it) {
    int mt, nt; int s = sched_tile(it, 256, 44, mt, nt);
    if (s < 0) break; if (s == 0) continue;
    f32x16 acc[2][2]; zero_acc(acc);
    gemm_mainloop<D_, D_, 16>(H + (size_t)mt * 128 * D_, W + (size_t)nt * 128 * D_, smem, acc);
    bf16_t* tp = U + (size_t)(mt * 128) * FF + nt * 64;
    const unsigned loff = (unsigned)((wm * 64 + 4 * g) * FF + wn * 32 + (lane & 31));
#pragma unroll
    for (int mi = 0; mi < 2; ++mi)
#pragma unroll
      for (int r = 0; r < 16; ++r) {
        bf16_t* rp = tp + (mi * 32 + (r & 3) + 8 * (r >> 2)) * FF;
        float gv = acc[mi][0][r], uv = acc[mi][1][r];
        float sv = gv / (1.f + __expf(-gv)) * uv;
        rp[loff] = (bf16_t)f2bf(sv);
      }
  }
}

DI void phase_ffn_down(const Params& p, size_t woff, const float* res, char* smem) {
  const bf16_t* U = (const bf16_t*)(p.ws + OFF_PA);
  const bf16_t* W = (const bf16_t*)(p.ws + OFF_WB) + woff;
  float* out = p.out;
  const int tid = otid(), lane = tid & 63, wid = owid(tid), wm = wid >> 1, wn = wid & 1, g = lane >> 5;
  for (int it = 0;; ++it) {
    int mt, nt; int s = sched_tile(it, 256, 8, mt, nt);
    if (s < 0) break; if (s == 0) continue;
    f32x16 acc[2][2]; zero_acc(acc);
    gemm_mainloop<FF, FF, 44>(U + (size_t)mt * 128 * FF, W + (size_t)nt * 128 * FF, smem, acc);
    const size_t tb = (size_t)(mt * 128) * D_ + nt * 128;
    float* tp = out + tb; const float* rsp = res + tb;
    const unsigned loff = (unsigned)((wm * 64 + 4 * g) * D_ + wn * 64 + (lane & 31));
#pragma unroll
    for (int mi = 0; mi < 2; ++mi)
#pragma unroll
      for (int ni = 0; ni < 2; ++ni)
#pragma unroll
        for (int r = 0; r < 16; ++r) {
          const int ro = (mi * 32 + (r & 3) + 8 * (r >> 2)) * D_ + ni * 32;
          (tp + ro)[loff] = (rsp + ro)[loff] + 0.5f * acc[mi][ni][r];
        }
  }
}

DI void phase_win(const Params& p, char* smem) {
  const bf16_t* H = (const bf16_t*)(p.ws + OFF_H);
  const bf16_t* W = (const bf16_t*)(p.ws + OFF_WB) + WIN;
  bf16_t* PA = (bf16_t*)(p.ws + OFF_PA);
  bf16_t* VT = (bf16_t*)(p.ws + OFF_VT);
  bf16_t* GT = (bf16_t*)(p.ws + OFF_GATES);
  float* WI = (float*)(p.ws + OFF_WIDX);
  const int tid = otid(), lane = tid & 63, wid = owid(tid), wm = wid >> 1, wn = wid & 1, g = lane >> 5;
  for (int it = 0;; ++it) {
    int mt, nt; int s = sched_tile(it, 256, 33, mt, nt);
    if (s < 0) break; if (s == 0) continue;
    f32x16 acc[2][2]; zero_acc(acc);
    gemm_mainloop<D_, D_, 16>(H + (size_t)mt * 128 * D_, W + (size_t)nt * 128 * D_, smem, acc);
    if (nt < 12) {
      bf16_t* tp = PA + (size_t)(mt * 128) * PA_LD + nt * 128;
      const unsigned loff = (unsigned)((wm * 64 + 4 * g) * PA_LD + wn * 64 + (lane & 31));
#pragma unroll
      for (int mi = 0; mi < 2; ++mi)
#pragma unroll
        for (int ni = 0; ni < 2; ++ni)
#pragma unroll
          for (int r = 0; r < 16; ++r) {
            const int ro = (mi * 32 + (r & 3) + 8 * (r >> 2)) * PA_LD + ni * 32;
            (tp + ro)[loff] = (bf16_t)f2bf(acc[mi][ni][r]);
          }
    } else if (nt < 16) {
      const int b = mt >> 5;
#pragma unroll
      for (int mi = 0; mi < 2; ++mi)
#pragma unroll
        for (int ni = 0; ni < 2; ++ni) {
          int c = (nt - 12) * 128 + wn * 64 + ni * 32 + (lane & 31);
          int h = c >> 6, d = c & 63;
          bf16_t* dst = VT + ((size_t)(b * 8 + h) * 64 + d) * S_;
#pragma unroll
          for (int rq = 0; rq < 4; ++rq) {
            int tok = mt * 128 + wm * 64 + mi * 32 + 8 * rq + 4 * g;
            int sidx = tok & (S_ - 1);
            u32x2 w; w[0] = pack2(acc[mi][ni][4 * rq], acc[mi][ni][4 * rq + 1]); w[1] = pack2(acc[mi][ni][4 * rq + 2], acc[mi][ni][4 * rq + 3]);
            *(u32x2*)(dst + sidx) = w;
          }
        }
    } else if (nt < 32) {
      bf16_t* tp = GT + (size_t)(mt * 128) * 2048 + (nt - 16) * 128;
      const unsigned loff = (unsigned)((wm * 64 + 4 * g) * 2048 + wn * 64 + (lane & 31));
#pragma unroll
      for (int mi = 0; mi < 2; ++mi)
#pragma unroll
        for (int ni = 0; ni < 2; ++ni)
#pragma unroll
          for (int r = 0; r < 16; ++r) {
            const int ro = (mi * 32 + (r & 3) + 8 * (r >> 2)) * 2048 + ni * 32;
            float v = acc[mi][ni][r];
            float sg = 1.f / (1.f + __expf(-v));
            (tp + ro)[loff] = (bf16_t)f2bf(sg);
          }
    } else {
      if (wn == 0 && (lane & 31) < 8) {
#pragma unroll
        for (int mi = 0; mi < 2; ++mi)
#pragma unroll
          for (int r = 0; r < 16; ++r) {
            int row = mt * 128 + wm * 64 + mi * 32 + crow(r, g);
            WI[(size_t)row * 8 + (lane & 31)] = acc[mi][0][r] * 0.04419417382415922f;
          }
      }
    }
  }
}

DI void phase_qproj(const Params& p, char* smem) {
  bf16_t* PA = (bf16_t*)(p.ws + OFF_PA);
  const bf16_t* W = (const bf16_t*)(p.ws + OFF_WB) + WQ;
  bf16_t* QA = (bf16_t*)(p.ws + OFF_H);
  bf16_t* QI = QA + (size_t)T_ * 512;
  const float2* ROPE = (const float2*)(p.ws + OFF_ROPE);
  float* rstd = (float*)(smem + 65536);
  const int tid = otid(), lane = tid & 63, wid = owid(tid), wm = wid >> 1, wn = wid & 1, g = lane >> 5;
  for (int it = 0;; ++it) {
    int mt, nt; int s = sched_tile(it, 256, 8, mt, nt);
    if (s < 0) break; if (s == 0) continue;
    {
      int row = tid >> 1, half = tid & 1;
      const bf16_t* src = PA + (size_t)(mt * 128 + row) * PA_LD + half * 128;
      float ss = 0.f;
#pragma unroll
      for (int i = 0; i < 16; ++i) {
        u32x4 v = *(const u32x4*)(src + i * 8);
#pragma unroll
        for (int j = 0; j < 4; ++j) { float a = bflo(v[j]), b = bfhi(v[j]); ss += a * a + b * b; }
      }
      ss += __shfl_xor(ss, 1);
      if (half == 0) rstd[row] = rsqrtf(ss * (1.f / 256.f) + EPS);
    }
    f32x16 acc[2][2]; zero_acc(acc);
    gemm_mainloop<PA_LD, 256, 4>(PA + (size_t)mt * 128 * PA_LD, W + (size_t)nt * 128 * 256, smem, acc);
    const int d = lane & 31;
    const int head = (nt & 3) * 2 + wn;
    bf16_t* dst = nt < 4 ? QA : QI;
    float g0 = 1.f, g1 = 1.f;
    if (nt < 4) { g0 = p.g_qa[d]; g1 = p.g_qa[d + 32]; }
#pragma unroll
    for (int mi = 0; mi < 2; ++mi)
#pragma unroll
      for (int r = 0; r < 16; ++r) {
        int lr = wm * 64 + mi * 32 + crow(r, g);
        int tok = mt * 128 + lr;
        float rs = rstd[lr];
        float v0 = acc[mi][0][r] * rs, v1 = acc[mi][1][r] * rs;
        if (nt < 4) {
          float ss = v0 * v0 + v1 * v1;
#pragma unroll
          for (int o = 16; o > 0; o >>= 1) ss += __shfl_xor(ss, o);
          float r2 = rsqrtf(ss * (1.f / 64.f) + EPS);
          v0 *= r2 * g0; v1 *= r2 * g1;
        }
        float2 cs = ROPE[(size_t)tok * 32 + d];
        float o0 = v0 * cs.x - v1 * cs.y, o1 = v0 * cs.y + v1 * cs.x;
        dst[(size_t)tok * 512 + head * 64 + d] = (bf16_t)f2bf(o0);
        dst[(size_t)tok * 512 + head * 64 + d + 32] = (bf16_t)f2bf(o1);
      }
    __syncthreads();
  }
  for (int it = blockIdx.x; it < T_ / 128; it += gridDim.x) {
    const int d = lane & 31; const bool isidx = lane >= 32;
    const float g0 = isidx ? 1.f : p.g_ka[d], g1 = isidx ? 1.f : p.g_ka[d + 32];
    for (int i = 0; i < 32; ++i) {
      int tok = it * 128 + wid * 32 + i;
      bf16_t* src = PA + (size_t)tok * PA_LD + (isidx ? PA_KI : PA_KA);
      float v0 = bf2f(src[d]), v1 = bf2f(src[d + 32]);
      float ss = v0 * v0 + v1 * v1;
#pragma unroll
      for (int o = 16; o > 0; o >>= 1) ss += __shfl_xor(ss, o);
      if (!isidx) { float r2 = rsqrtf(ss * (1.f / 64.f) + EPS); v0 *= r2 * g0; v1 *= r2 * g1; }
      float2 cs = ROPE[(size_t)tok * 32 + d];
      float o0 = v0 * cs.x - v1 * cs.y, o1 = v0 * cs.y + v1 * cs.x;
      src[d] = (bf16_t)f2bf(o0); src[d + 32] = (bf16_t)f2bf(o1);
    }
  }
}

DI void sb_item(const Params& p, int b, int h, int qb, char* smem) {
  bf16_t* PA = (bf16_t*)(p.ws + OFF_PA);
  const bf16_t* VT = (const bf16_t*)(p.ws + OFF_VT) + (size_t)(b * 8 + h) * 64 * S_;
  const int tid = otid(), lane = tid & 63, wid = owid(tid), g = lane >> 5, r = lane & 31;
  const int tw = qb * 128 + wid * 32;
  constexpr int BUFSZ = 8192 + 8704;
  const float zs = 0.125f * LOG2E;
  bf16x8 qf[4];
  {
    const bf16_t* qp = PA + (size_t)(b * S_ + tw + r) * PA_LD + PA_QB + h * 64 + g * 8;
#pragma unroll
    for (int ks = 0; ks < 4; ++ks) qf[ks] = ld_frag_g(qp + ks * 16);
  }
  const int srow = tid >> 3, sch = tid & 7;
  const bf16_t* gk = PA + (size_t)(b * S_ + srow) * PA_LD + PA_KB + h * 64 + sch * 8;
  const bf16_t* gv = VT + (size_t)srow * S_ + sch * 8;
  const unsigned k_st = srow * 128 + ((sch ^ ((srow >> 1) & 7)) << 4);
  const unsigned v_st = 8192 + srow * 136 + sch * 16;
  const int sw = (lane >> 1) & 7;
  f32x16 o0, o1;
#pragma unroll
  for (int i = 0; i < 16; ++i) { o0[i] = 0.f; o1[i] = 0.f; }
  float R = 1.f;
  const int nkt = 2 * qb + 2;
  u32x4 rk[2], rv[2];
  {
    int kt = nkt - 1;
#pragma unroll
    for (int i = 0; i < 2; ++i) { rk[i] = *(const u32x4*)(gk + (size_t)(kt * 64 + i * 32) * PA_LD); rv[i] = *(const u32x4*)(gv + (size_t)(i * 32) * S_ + kt * 64); }
    char* cur = smem + (kt & 1) * BUFSZ;
#pragma unroll
    for (int i = 0; i < 2; ++i) {
      *(u32x4*)(cur + k_st + i * 4096) = rk[i];
      u32x2 lo, hi; lo[0] = rv[i][0]; lo[1] = rv[i][1]; hi[0] = rv[i][2]; hi[1] = rv[i][3];
      *(u32x2*)(cur + v_st + i * 32 * 136) = lo; *(u32x2*)(cur + v_st + i * 32 * 136 + 8) = hi;
    }
  }
  __syncthreads();
  for (int kt = nkt - 1; kt >= 0; --kt) {
    const char* cur = smem + (kt & 1) * BUFSZ;
    char* nxt = smem + ((kt + 1) & 1) * BUFSZ;
    const bool more = kt > 0;
    if (more) {
#pragma unroll
      for (int i = 0; i < 2; ++i) { rk[i] = *(const u32x4*)(gk + (size_t)((kt - 1) * 64 + i * 32) * PA_LD); rv[i] = *(const u32x4*)(gv + (size_t)(i * 32) * S_ + (kt - 1) * 64); }
    }
#pragma unroll
    for (int sub = 1; sub >= 0; --sub) {
      const int sbase = kt * 64 + sub * 32;
      if (sbase <= tw) {
        f32x16 z;
#pragma unroll
        for (int i = 0; i < 16; ++i) z[i] = 0.f;
#pragma unroll
        for (int ks = 0; ks < 4; ++ks) {
          bf16x8 kf = ld_frag_s(cur + (sub * 32 + r) * 128 + (((ks * 2 + g) ^ sw) << 4));
          z = MFMA32(kf, qf[ks], z);
        }
        const bool diag = (sbase == tw);
        float e[16], rr[16];
#pragma unroll
        for (int i = 0; i < 16; ++i) {
          float z2 = fminf(z[i] * zs, 80.f);
          float ev = fexp2(z2);
          float rv_ = frcp(1.f + ev);
          if (diag && !(crow(i, g) < r)) { ev = 0.f; rv_ = 1.f; }
          e[i] = ev; rr[i] = rv_;
        }
        float G[4], Gp[4];
#pragma unroll
        for (int q = 0; q < 4; ++q) {
          rr[4 * q + 2] *= rr[4 * q + 3];
          rr[4 * q + 1] *= rr[4 * q + 2];
          rr[4 * q + 0] *= rr[4 * q + 1];
          G[q] = rr[4 * q];
        }
#pragma unroll
        for (int q = 0; q < 4; ++q) Gp[q] = __shfl_xor(G[q], 32);
        float SO[4], SP[4];
        SO[3] = 1.f; SO[2] = G[3]; SO[1] = G[2] * G[3]; SO[0] = G[1] * SO[1];
        SP[3] = 1.f; SP[2] = Gp[3]; SP[1] = Gp[2] * Gp[3]; SP[0] = Gp[1] * SP[1];
        float a[16];
#pragma unroll
        for (int q = 0; q < 4; ++q) {
          float part = g == 0 ? SP[q] * Gp[q] : SP[q];
          float E = SO[q] * part * R;
#pragma unroll
          for (int j = 0; j < 4; ++j) a[4 * q + j] = e[4 * q + j] * rr[4 * q + j] * E;
        }
        R = R * (SO[0] * G[0]) * (SP[0] * Gp[0]);
        u32x4 pw0, pw1;
#pragma unroll
        for (int j = 0; j < 4; ++j) { pw0[j] = pack2(a[2 * j], a[2 * j + 1]); pw1[j] = pack2(a[8 + 2 * j], a[8 + 2 * j + 1]); }
        bf16x8 pf0 = __builtin_bit_cast(bf16x8, pw0), pf1 = __builtin_bit_cast(bf16x8, pw1);
#pragma unroll
        for (int ks2 = 0; ks2 < 2; ++ks2) {
          const bf16x8 pf = ks2 == 0 ? pf0 : pf1;
#pragma unroll
          for (int dt = 0; dt < 2; ++dt) {
            const char* vp = cur + 8192 + (dt * 32 + r) * 136 + (sub * 32 + 16 * ks2 + 4 * g) * 2;
            u32x2 lo = *(const u32x2*)vp, hi = *(const u32x2*)(vp + 16);
            u32x4 vv; vv[0] = lo[0]; vv[1] = lo[1]; vv[2] = hi[0]; vv[3] = hi[1];
            bf16x8 vf = __builtin_bit_cast(bf16x8, vv);
            if (dt == 0) o0 = MFMA32(vf, pf, o0); else o1 = MFMA32(vf, pf, o1);
          }
        }
      }
    }
    if (more) {
#pragma unroll
      for (int i = 0; i < 2; ++i) {
        *(u32x4*)(nxt + k_st + i * 4096) = rk[i];
        u32x2 lo, hi; lo[0] = rv[i][0]; lo[1] = rv[i][1]; hi[0] = rv[i][2]; hi[1] = rv[i][3];
        *(u32x2*)(nxt + v_st + i * 32 * 136) = lo; *(u32x2*)(nxt + v_st + i * 32 * 136 + 8) = hi;
      }
    }
    __syncthreads();
  }
  bf16_t* yp = PA + (size_t)(b * S_ + tw + r) * PA_LD + PA_QB + h * 64;
#pragma unroll
  for (int rq = 0; rq < 4; ++rq) {
    u32x2 w0, w1;
    w0[0] = pack2(o0[4 * rq], o0[4 * rq + 1]); w0[1] = pack2(o0[4 * rq + 2], o0[4 * rq + 3]);
    w1[0] = pack2(o1[4 * rq], o1[4 * rq + 1]); w1[1] = pack2(o1[4 * rq + 2], o1[4 * rq + 3]);
    *(u32x2*)(yp + 8 * rq + 4 * g) = w0;
    *(u32x2*)(yp + 32 + 8 * rq + 4 * g) = w1;
  }
}

DI unsigned tokey(float f) { unsigned u = __float_as_uint(f); return (u & 0x80000000u) ? ~u : (u | 0x80000000u); }

DI void idx_item(const Params& p, int b, int qt, char* smem) {
  bf16_t* PA = (bf16_t*)(p.ws + OFF_PA);
  const bf16_t* QI = (const bf16_t*)(p.ws + OFF_H) + (size_t)T_ * 512;
  const float* WI = (const float*)(p.ws + OFF_WIDX);
  float* slab = (float*)(p.ws + OFF_SLAB) + (size_t)blockIdx.x * 16 * 4096;
  const int tid = otid(), lane = tid & 63, wid = owid(tid), g4 = lane >> 4, r = lane & 15;
  const int t0 = qt * 16;
  {
    bf16x8 qf[8][2]; float w[8];
    const bf16_t* qp = QI + (size_t)(b * S_ + t0 + r) * 512 + g4 * 8;
#pragma unroll
    for (int hh = 0; hh < 8; ++hh) { qf[hh][0] = ld_frag_g(qp + hh * 64); qf[hh][1] = ld_frag_g(qp + hh * 64 + 32); }
    {
      const float4* wp = (const float4*)(WI + (size_t)(b * S_ + t0 + r) * 8);
      float4 wa = wp[0], wb = wp[1];
      w[0] = wa.x; w[1] = wa.y; w[2] = wa.z; w[3] = wa.w; w[4] = wb.x; w[5] = wb.y; w[6] = wb.z; w[7] = wb.w;
    }
    const int nkt = qt + 1;
    for (int kt = wid; kt < nkt; kt += 4) {
      const bf16_t* kp = PA + (size_t)(b * S_ + kt * 16 + r) * PA_LD + PA_KI + g4 * 8;
      bf16x8 k0 = ld_frag_g(kp), k1 = ld_frag_g(kp + 32);
      f32x4 sc = {0.f, 0.f, 0.f, 0.f};
#pragma unroll
      for (int hh = 0; hh < 8; ++hh) {
        f32x4 c = {0.f, 0.f, 0.f, 0.f};
        c = MFMA16(k0, qf[hh][0], c);
        c = MFMA16(k1, qf[hh][1], c);
#pragma unroll
        for (int i = 0; i < 4; ++i) sc[i] += w[hh] * fmaxf(c[i], 0.f);
      }
      *(f32x4*)(slab + (size_t)r * 4096 + kt * 16 + 4 * g4) = sc;
    }
  }
  __syncthreads();
  for (int qi = 0; qi < 4; ++qi) {
    const int q = wid * 4 + qi;
    const int t = t0 + q, n = t + 1;
    unsigned short* out = (unsigned short*)(PA + (size_t)(b * S_ + t) * PA_LD);
    if (n <= 256) {
#pragma unroll
      for (int j = 0; j < 4; ++j) { int e = j * 64 + lane; out[e] = (unsigned short)(e < n ? e : 0); }
      continue;
    }
    const float* row = slab + (size_t)q * 4096;
    const int nj = (n + 63) >> 6;
    unsigned key[64];
#pragma unroll
    for (int j = 0; j < 64; ++j) {
      key[j] = 0u;
      if (j < nj) { int e = j * 64 + lane; if (e < n) key[j] = tokey(row[e]); }
    }
    unsigned Tthr = 0u; int need = 0; bool exact = false;
    for (int bit = 31; bit >= 0; --bit) {
      const unsigned cand = Tthr | (1u << bit);
      int cnt = 0;
#pragma unroll
      for (int j = 0; j < 64; ++j) if (j < nj) cnt += __builtin_popcountll(__ballot(key[j] >= cand));
      if (cnt >= 256) Tthr = cand;
      if (cnt == 256) { exact = true; break; }
    }
    unsigned Tgt;
    if (exact) { Tgt = Tthr - 1u; need = 0; }
    else {
      int cgt = 0;
#pragma unroll
      for (int j = 0; j < 64; ++j) if (j < nj) cgt += __builtin_popcountll(__ballot(key[j] > Tthr));
      Tgt = Tthr; need = 256 - cgt;
    }
    const unsigned long long lt_mask = (1ull << lane) - 1ull;
    int base = 0, ties = 0;
#pragma unroll
    for (int j = 0; j < 64; ++j) {
      if (j < nj) {
        const bool gt = key[j] > Tgt;
        const bool eq = (!exact) && (key[j] == Tthr);
        const unsigned long long meq = __ballot(eq);
        const int myrank = ties + __builtin_popcountll(meq & lt_mask);
        const bool sel = gt || (eq && myrank < need);
        ties += __builtin_popcountll(meq);
        const unsigned long long ms = __ballot(sel);
        const int pos = base + __builtin_popcountll(ms & lt_mask);
        if (sel && pos < 256) out[pos] = (unsigned short)(j * 64 + lane);
        base += __builtin_popcountll(ms);
      }
    }
  }
  __syncthreads();
}

DI void phase_mix(const Params& p, char* smem) {
  unsigned* cnt = (unsigned*)(p.ws + OFF_CNT);
  int* s_item = (int*)(smem + SMEM_BYTES - 16);
  constexpr int NSB = 64 * 32, NIDX = 8 * 256;
  while (true) {
    if (otid() == 0) *s_item = (int)atomicAdd(cnt, 1u);
    __syncthreads();
    const int item = *s_item;
    __syncthreads();
    if (item >= NSB + NIDX) break;
    if (item < NSB) {
      int qb = 31 - (item >> 6), bh = item & 63;
      sb_item(p, bh >> 3, bh & 7, qb, smem);
    } else {
      int j = item - NSB;
      int qt = 255 - (j >> 3), b = j & 7;
      idx_item(p, b, qt, smem);
    }
  }
}

DI void phase_sparse(const Params& p, char* smem) {
  const bf16_t* PA = (const bf16_t*)(p.ws + OFF_PA);
  bf16_t* QA = (bf16_t*)(p.ws + OFF_H);
  const bf16_t* WUVb = (const bf16_t*)(p.ws + OFF_WB) + WUV;
  const int tid = otid(), lane = tid & 63, wid = owid(tid), g4 = lane >> 4, c = lane & 15;
  float* Pl = (float*)(smem + wid * 9280);
  int* Il = (int*)(smem + wid * 9280 + 8192);
  float* Sl = (float*)(smem + wid * 9280 + 9216);
  float* Pq = Pl + g4 * 32 + c;
  char* OL = smem + 37120;
  const float sc2 = 0.125f * LOG2E;
  for (int it = blockIdx.x; it < T_ / 16; it += gridDim.x) {
    const int tok0 = it * 16;
    const int b = tok0 >> 12;
    for (int qi = 0; qi < 4; ++qi) {
      const int q = wid * 4 + qi;
      const int tok = tok0 + q, t = tok & (S_ - 1);
      const int nsel = t + 1 < 256 ? t + 1 : 256;
      const unsigned short* irow = (const unsigned short*)(PA + (size_t)tok * PA_LD);
#pragma unroll
      for (int j = 0; j < 4; ++j) { int e = j * 64 + lane; int v = irow[e]; Il[e] = e < nsel ? v : 0; }
      __syncthreads();
      bf16x8 qf0, qf1;
      {
        u32x4 z4 = {0u, 0u, 0u, 0u};
        qf0 = __builtin_bit_cast(bf16x8, z4); qf1 = qf0;
        if (c < 8) { const bf16_t* qp = QA + (size_t)tok * 512 + c * 64 + g4 * 8; qf0 = ld_frag_g(qp); qf1 = ld_frag_g(qp + 32); }
      }
      float m = -INFINITY;
#pragma unroll
      for (int kg = 0; kg < 4; ++kg) {
        bf16x8 ka[4][2];
#pragma unroll
        for (int k4 = 0; k4 < 4; ++k4) {
          int key = (Il + c)[(kg * 4 + k4) * 16];
          const bf16_t* kp = PA + (size_t)(b * S_ + key) * PA_LD + PA_KA + g4 * 8;
          ka[k4][0] = ld_frag_g(kp); ka[k4][1] = ld_frag_g(kp + 32);
        }
#pragma unroll
        for (int k4 = 0; k4 < 4; ++k4) {
          f32x4 cc = {0.f, 0.f, 0.f, 0.f};
          cc = MFMA16(ka[k4][0], qf0, cc);
          cc = MFMA16(ka[k4][1], qf1, cc);
#pragma unroll
          for (int i = 0; i < 4; ++i) {
            const int ec = (kg * 4 + k4) * 16 + i;
            float v = ec + 4 * g4 < nsel ? cc[i] : -INFINITY;
            m = fmaxf(m, v);
            if (c < 8) Pq[ec * 8] = v;
          }
        }
      }
      m = fmaxf(m, __shfl_xor(m, 16)); m = fmaxf(m, __shfl_xor(m, 32));
      float sum = 0.f;
      if (c < 8) {
#pragma unroll 4
        for (int kt = 0; kt < 16; ++kt)
#pragma unroll
          for (int i = 0; i < 4; ++i) {
            const int ec = kt * 16 + i;
            float pv = fexp2((Pq[ec * 8] - m) * sc2);
            Pq[ec * 8] = pv; sum += pv;
          }
      }
      sum += __shfl_xor(sum, 16); sum += __shfl_xor(sum, 32);
      if (lane < 8) Sl[lane] = 1.f / sum;
      __syncthreads();
      float acc[8][2];
#pragma unroll
      for (int hh = 0; hh < 8; ++hh) { acc[hh][0] = 0.f; acc[hh][1] = 0.f; }
      const bf16_t* vbase = PA + (size_t)b * S_ * PA_LD + PA_VA + 2 * lane;
      const int nk8 = (nsel + 7) & ~7;
      for (int k0 = 0; k0 < nk8; k0 += 8) {
        unsigned vv[8];
#pragma unroll
        for (int kk = 0; kk < 8; ++kk) {
          int key = __builtin_amdgcn_readfirstlane(Il[k0 + kk]);
          vv[kk] = *(const unsigned*)(vbase + (size_t)key * PA_LD);
        }
#pragma unroll
        for (int kk = 0; kk < 8; ++kk) {
          const f32x4 pa = *(const f32x4*)(Pl + (k0 + kk) * 8), pb = *(const f32x4*)(Pl + (k0 + kk) * 8 + 4);
          const float v0 = bflo(vv[kk]), v1 = bfhi(vv[kk]);
#pragma unroll
          for (int hh = 0; hh < 4; ++hh) { acc[hh][0] += pa[hh] * v0; acc[hh][1] += pa[hh] * v1; acc[hh + 4][0] += pb[hh] * v0; acc[hh + 4][1] += pb[hh] * v1; }
        }
      }
#pragma unroll
      for (int hh = 0; hh < 8; ++hh) { const float iv = Sl[hh]; *(unsigned*)(OL + q * 2064 + hh * 256 + lane * 4) = pack2(acc[hh][0] * iv, acc[hh][1] * iv); }
      __syncthreads();
    }
#pragma nounroll
    for (int hh = 0; hh < 2; ++hh) {
      const int h = wid * 2 + hh;
      bf16x8 af[4];
#pragma unroll
      for (int ks = 0; ks < 4; ++ks) af[ks] = ld_frag_s(OL + c * 2064 + h * 256 + (ks * 32 + g4 * 8) * 2);
#pragma nounroll
      for (int nt = 0; nt < 4; ++nt) {
        f32x4 cc = {0.f, 0.f, 0.f, 0.f};
        const bf16_t* wp = WUVb + (size_t)(h * 64 + nt * 16 + c) * 128 + g4 * 8;
#pragma unroll
        for (int ks = 0; ks < 4; ++ks) cc = MFMA16(af[ks], ld_frag_g(wp + ks * 32), cc);
#pragma unroll
        for (int i = 0; i < 4; ++i) QA[(size_t)(tok0 + 4 * g4 + i) * 512 + h * 64 + nt * 16 + c] = (bf16_t)f2bf(cc[i]);
      }
    }
    __syncthreads();
  }
}

DI void phase_merge(const Params& p, char* smem) {
  const bf16_t* YA = (const bf16_t*)(p.ws + OFF_H);
  const bf16_t* YB = (const bf16_t*)(p.ws + OFF_PA) + PA_QB;
  const bf16_t* Wa = (const bf16_t*)(p.ws + OFF_WB) + WOA;
  const bf16_t* Wb = (const bf16_t*)(p.ws + OFF_WB) + WOB;
  const bf16_t* GT = (const bf16_t*)(p.ws + OFF_GATES);
  bf16_t* MG = (bf16_t*)(p.ws + OFF_SLAB);
  const int tid = otid(), lane = tid & 63, wid = owid(tid), wm = wid >> 1, wn = wid & 1, g = lane >> 5;
  const unsigned goff = (unsigned)((wm * 64 + 4 * g) * 2048 + wn * 64 + (lane & 31));
  const unsigned loff = (unsigned)((wm * 64 + 4 * g) * D_ + wn * 64 + (lane & 31));
  for (int it = 0;; ++it) {
    int mt, nt; int s = sched_tile(it, 256, 8, mt, nt);
    if (s < 0) break; if (s == 0) continue;
    f32x16 acc[2][2]; zero_acc(acc);
    gemm_mainloop<512, 512, 8>(YA + (size_t)mt * 128 * 512, Wa + (size_t)nt * 128 * 512, smem, acc);
    const bf16_t* gp = GT + (size_t)(mt * 128) * 2048 + nt * 128;
    bf16_t* tp = MG + (size_t)(mt * 128) * D_ + nt * 128;
#pragma unroll
    for (int mi = 0; mi < 2; ++mi)
#pragma unroll
      for (int ni = 0; ni < 2; ++ni)
#pragma unroll
        for (int r = 0; r < 16; ++r) {
          const int ro = (mi * 32 + (r & 3) + 8 * (r >> 2));
          float ga = bf2f((gp + ro * 2048 + ni * 32)[goff]);
          (tp + ro * D_ + ni * 32)[loff] = (bf16_t)f2bf(ga * acc[mi][ni][r]);
        }
  }
  for (int it = 0;; ++it) {
    int mt, nt; int s = sched_tile(it, 256, 8, mt, nt);
    if (s < 0) break; if (s == 0) continue;
    f32x16 acc[2][2]; zero_acc(acc);
    gemm_mainloop<PA_LD, 512, 8>(YB + (size_t)mt * 128 * PA_LD, Wb + (size_t)nt * 128 * 512, smem, acc);
    const bf16_t* gp = GT + (size_t)(mt * 128) * 2048 + 1024 + nt * 128;
    bf16_t* tp = MG + (size_t)(mt * 128) * D_ + nt * 128;
#pragma unroll
    for (int mi = 0; mi < 2; ++mi)
#pragma unroll
      for (int ni = 0; ni < 2; ++ni)
#pragma unroll
        for (int r = 0; r < 16; ++r) {
          const int ro = (mi * 32 + (r & 3) + 8 * (r >> 2));
          float gb = bf2f((gp + ro * 2048 + ni * 32)[goff]);
          bf16_t* e = (tp + ro * D_ + ni * 32) + loff;
          *e = (bf16_t)f2bf(bf2f(*e) + gb * acc[mi][ni][r]);
        }
  }
}

DI void phase_outproj(const Params& p, char* smem) {
  const bf16_t* MG = (const bf16_t*)(p.ws + OFF_SLAB);
  const bf16_t* W = (const bf16_t*)(p.ws + OFF_WB) + WOUT;
  float* out = p.out;
  const int tid = otid(), lane = tid & 63, wid = owid(tid), wm = wid >> 1, wn = wid & 1, g = lane >> 5;
  for (int it = 0;; ++it) {
    int mt, nt; int s = sched_tile(it, 256, 8, mt, nt);
    if (s < 0) break; if (s == 0) continue;
    f32x16 acc[2][2]; zero_acc(acc);
    gemm_mainloop<D_, D_, 16>(MG + (size_t)mt * 128 * D_, W + (size_t)nt * 128 * D_, smem, acc);
    float* tp = out + (size_t)(mt * 128) * D_ + nt * 128;
    const unsigned loff = (unsigned)((wm * 64 + 4 * g) * D_ + wn * 64 + (lane & 31));
#pragma unroll
    for (int mi = 0; mi < 2; ++mi)
#pragma unroll
      for (int ni = 0; ni < 2; ++ni)
#pragma unroll
        for (int r = 0; r < 16; ++r) {
          const int ro = (mi * 32 + (r & 3) + 8 * (r >> 2)) * D_ + ni * 32;
          (tp + ro)[loff] = (tp + ro)[loff] + acc[mi][ni][r];
        }
  }
}


#define XB_TMO      128
#define XB_XCNT(j)  (256  + 64 * (j))
#define XB_XSUB(j)  (1280 + 64 * (j))
#define XB_XGEN(j)  (2304 + 64 * (j))
#define XB_TOP      3328
#define XB_TOPGEN   3392
#define XCD_BAR_WORDS 3456
#define XB_SPIN_CAP (1u << 22)
#define LAS __attribute__((address_space(3)))
DI unsigned xb_ld(unsigned* p) { return __hip_atomic_load(p, __ATOMIC_RELAXED, __HIP_MEMORY_SCOPE_AGENT); }
DI unsigned xb_add(unsigned* p, unsigned v) { return __hip_atomic_fetch_add(p, v, __ATOMIC_RELAXED, __HIP_MEMORY_SCOPE_AGENT); }
DI unsigned xb_xcc_id() { return (unsigned)__builtin_amdgcn_s_getreg((3 << 11) | 20) & 0xFu; }
#define XB_SPIN(cond, bar) do { unsigned _sp = 0; while (cond) { __builtin_amdgcn_s_sleep(1); \
    if ((++_sp & 255u) == 0u) { if (xb_ld(&(bar)[XB_TMO])) break; if (_sp > XB_SPIN_CAP) { atomicAdd(&(bar)[XB_TMO], 1u); break; } } } } while (0)
struct XcdBarrier { unsigned* bar; unsigned x; volatile LAS unsigned* st; };
DI XcdBarrier xcd_barrier_post(unsigned* bar, volatile LAS unsigned* st) {
  XcdBarrier b; b.bar = bar; b.x = xb_xcc_id(); b.st = st;
  if (threadIdx.x == 0) (void)xb_add(&bar[XB_XCNT(b.x)], 1u);
  return b;
}
DI void xcd_barrier_complete(unsigned* bar, unsigned x, unsigned& nloc, unsigned& nx) {
  const unsigned G = gridDim.x * gridDim.y * gridDim.z;
  unsigned sum, cnt, mine, sp = 0u;
  for (;;) {
    sum = 0u; cnt = 0u; mine = 0u;
#pragma unroll
    for (unsigned j = 0; j < 16; ++j) { const unsigned c = xb_ld(&bar[XB_XCNT(j)]); sum += c; cnt += (c > 0u) ? 1u : 0u; mine = (j == x) ? c : mine; }
    if (sum == G) break;
    __builtin_amdgcn_s_sleep(1);
    if ((++sp & 255u) == 0u) { if (xb_ld(&bar[XB_TMO])) break; if (sp > XB_SPIN_CAP) { atomicAdd(&bar[XB_TMO], 1u); break; } }
  }
  nloc = mine > 0u ? mine : 1u; nx = cnt > 0u ? cnt : 1u;
}
DI void xcd_barrier(const XcdBarrier& b) {
  asm volatile("s_waitcnt vmcnt(0)" ::: "memory");
  __syncthreads();
  if (threadIdx.x == 0) {
    unsigned* bar = b.bar;
    __builtin_amdgcn_s_waitcnt(0);
    unsigned nloc = b.st[0], nx = b.st[1];
    if (nloc == 0u) { xcd_barrier_complete(bar, b.x, nloc, nx); b.st[0] = nloc; b.st[1] = nx; }
    const unsigned old = xb_add(&bar[XB_XSUB(b.x)], 1u);
    const unsigned gen = old / nloc;
    if (old + 1u == (gen + 1u) * nloc) {
      __builtin_amdgcn_fence(__ATOMIC_RELEASE, "agent");
      asm volatile("s_waitcnt vmcnt(0)" ::: "memory");
      const unsigned og = xb_add(&bar[XB_TOP], 1u);
      const unsigned tg = og / nx;
      if (og + 1u == (tg + 1u) * nx) xb_add(&bar[XB_TOPGEN], 1u);
      else XB_SPIN(xb_ld(&bar[XB_TOPGEN]) == tg, bar);
      __builtin_amdgcn_fence(__ATOMIC_ACQUIRE, "agent");
      xb_add(&bar[XB_XGEN(b.x)], 1u);
      asm volatile("s_waitcnt vmcnt(0)" ::: "memory");
    } else {
      XB_SPIN(xb_ld(&bar[XB_XGEN(b.x)]) == gen, bar);
      __builtin_amdgcn_fence(__ATOMIC_ACQUIRE, "agent");
      asm volatile("s_waitcnt vmcnt(0)" ::: "memory");
    }
  }
  __syncthreads();
}

DI void run_phase(const Params& p, int ph, char* smem) {
  switch (ph) {
    case 0: phase_prep(p, smem); break;
    case 1: phase_ffn_gu(p, W1GU, smem); break;
    case 2: phase_ffn_down(p, W1D, p.x, smem); break;
    case 3: phase_rmsnorm(p.out, p.g_mix, (bf16_t*)(p.ws + OFF_H)); break;
    case 4: phase_win(p, smem); break;
    case 5: phase_qproj(p, smem); break;
    case 6: phase_mix(p, smem); break;
    case 7: phase_sparse(p, smem); break;
    case 8: phase_merge(p, smem); break;
    case 9: phase_outproj(p, smem); break;
    case 10: phase_rmsnorm(p.out, p.g_ffn2, (bf16_t*)(p.ws + OFF_H)); break;
    case 11: phase_ffn_gu(p, W2GU, smem); break;
    case 12: phase_ffn_down(p, W2D, p.out, smem); break;
  }
}
constexpr int NPHASE = 13;

#if !MULTI_LAUNCH
__global__ void __launch_bounds__(256, 2) mega_kernel(Params p) {
  __shared__ __attribute__((aligned(16))) char smem[SMEM_BYTES];
  __shared__ uint4 xb_words;
  cg::grid_group grid = cg::this_grid();
  if (threadIdx.x == 0) xb_words = make_uint4(0u, 0u, 0u, 0u);
  __syncthreads();
  XcdBarrier xb = xcd_barrier_post((unsigned*)(p.ws + OFF_CNT + 256), (volatile LAS unsigned*)&xb_words);
#pragma nounroll
  for (int ph = 0; ph < NPHASE; ++ph) {
    int phv = ph; asm volatile("" : "+s"(phv));
    run_phase(p, phv, smem);
    if (ph == 0) grid.sync();
    else if (ph + 1 < NPHASE) xcd_barrier(xb);
  }
}
#else
template <int PH>
__global__ void __launch_bounds__(256, 2) phase_kernel(Params p) {
  __shared__ __attribute__((aligned(16))) char smem[SMEM_BYTES];
  run_phase(p, PH, smem);
}
template <int PH> static void launch_phases(const Params& p, hipStream_t stream) {
  hipLaunchKernelGGL(phase_kernel<PH>, dim3(512), dim3(256), 0, stream, p);
  if constexpr (PH + 1 < NPHASE) launch_phases<PH + 1>(p, stream);
}
#endif

extern "C" void kernel_launch(void* const* d_in, const int* in_sizes, int n_in, void* d_out, int out_size, void* d_ws,
                              size_t ws_size, hipStream_t stream) {
  Params p{};
  p.x = (const float*)d_in[0]; p.pos = (const int*)d_in[1];
  p.g_ffn1 = (const float*)d_in[2]; p.w1g = (const float*)d_in[3]; p.w1u = (const float*)d_in[4]; p.w1d = (const float*)d_in[5];
  p.g_mix = (const float*)d_in[6]; p.w_in = (const float*)d_in[7]; p.g_cq = (const float*)d_in[8]; p.w_uq = (const float*)d_in[9];
  p.w_qi = (const float*)d_in[10]; p.g_qa = (const float*)d_in[11]; p.g_ka = (const float*)d_in[12]; p.w_uv = (const float*)d_in[13];
  p.w_oa = (const float*)d_in[14]; p.w_ob = (const float*)d_in[15]; p.w_out = (const float*)d_in[16]; p.g_ffn2 = (const float*)d_in[17];
  p.w2g = (const float*)d_in[18]; p.w2u = (const float*)d_in[19]; p.w2d = (const float*)d_in[20];
  p.out = (float*)d_out; p.ws = (char*)d_ws;
  if (ws_size < WS_NEED) { fprintf(stderr, "workspace too small: %zu < %zu\n", ws_size, (size_t)WS_NEED); return; }
  (void)hipMemsetAsync((char*)d_ws + OFF_CNT, 0, 256 + 16384, stream);
#if MULTI_LAUNCH
  launch_phases<0>(p, stream);
#else
  static int grid_blocks = 0;
  if (!grid_blocks) {
    int dev = 0, cus = 0, per_cu = 0;
    (void)hipGetDevice(&dev);
    (void)hipDeviceGetAttribute(&cus, hipDeviceAttributeMultiprocessorCount, dev);
    (void)hipOccupancyMaxActiveBlocksPerMultiprocessor(&per_cu, mega_kernel, 256, 0);
    if (per_cu > 2) per_cu = 2;
    grid_blocks = cus * per_cu;
    if (grid_blocks > 512) grid_blocks = 512;
  }
  void* args[] = {&p};
  hipError_t e = hipLaunchCooperativeKernel((void*)mega_kernel, dim3(grid_blocks), dim3(256), args, 0, stream);
  if (e != hipSuccess) fprintf(stderr, "cooperative launch failed: %s (grid %d)\n", hipGetErrorString(e), grid_blocks);
#endif
}
```

```cpp
#include <hip/hip_runtime.h>
#include <hip/hip_cooperative_groups.h>
#include <stdint.h>
#include <stdio.h>
namespace cg = cooperative_groups;

#ifndef MULTI_LAUNCH
#define MULTI_LAUNCH 0
#endif

#define DI __device__ __forceinline__
typedef unsigned short bf16_t;
typedef __attribute__((ext_vector_type(8))) short bf16x8;
typedef __attribute__((ext_vector_type(16))) float f32x16;
typedef __attribute__((ext_vector_type(4))) float f32x4;
typedef __attribute__((ext_vector_type(4))) unsigned u32x4;
typedef __attribute__((ext_vector_type(2))) unsigned u32x2;

constexpr int T_ = 32768, S_ = 4096, D_ = 1024, FF = 2816;
constexpr int PA_LD = 1536;
constexpr int PA_KA = 256, PA_VA = 320, PA_KI = 448, PA_QB = 512, PA_KB = 1024;
constexpr float EPS = 1e-6f;
constexpr float LOG2E = 1.4426950408889634f;

constexpr size_t W1GU = 0;
constexpr size_t W1D = W1GU + (size_t)5632 * 1024;
constexpr size_t W2GU = W1D + (size_t)1024 * 2816;
constexpr size_t W2D = W2GU + (size_t)5632 * 1024;
constexpr size_t WIN = W2D + (size_t)1024 * 2816;
constexpr size_t WQ = WIN + (size_t)4352 * 1024;
constexpr size_t WUV = WQ + (size_t)1024 * 256;
constexpr size_t WOA = WUV + (size_t)512 * 128;
constexpr size_t WOB = WOA + (size_t)1024 * 512;
constexpr size_t WOUT = WOB + (size_t)1024 * 512;
constexpr size_t WB_ELEMS = WOUT + (size_t)1024 * 1024;
constexpr size_t OFF_WB = 0;
constexpr size_t OFF_H = (WB_ELEMS * 2 + 255) & ~(size_t)255;
constexpr size_t OFF_PA = OFF_H + (size_t)T_ * 1024 * 2;
constexpr size_t OFF_VT = OFF_PA + (size_t)T_ * PA_LD * 2;
constexpr size_t OFF_GATES = OFF_VT + (size_t)T_ * 512 * 2;
constexpr size_t OFF_SLAB = OFF_GATES + (size_t)T_ * 2048 * 2;
constexpr size_t OFF_WIDX = OFF_SLAB + (size_t)512 * 16 * 4096 * 4;
constexpr size_t OFF_ROPE = OFF_WIDX + (size_t)T_ * 8 * 4;
constexpr size_t OFF_CNT = OFF_ROPE + (size_t)T_ * 32 * 8;
constexpr size_t WS_NEED = OFF_CNT + 256 + 16384;
static_assert(WS_NEED <= (size_t)512 * 1024 * 1024, "workspace too large");
static_assert((size_t)T_ * FF * 2 <= OFF_SLAB - OFF_PA, "U must fit in PA+VT+GATES");

constexpr int SMEM_BYTES = 131072 + 2048;
constexpr int NTHR = 512, NWAVE = 8;

struct Params {
  const float* x; const int* pos;
  const float *g_ffn1, *w1g, *w1u, *w1d, *g_mix, *w_in, *g_cq, *w_uq, *w_qi, *g_qa, *g_ka, *w_uv, *w_oa, *w_ob, *w_out, *g_ffn2, *w2g, *w2u, *w2d;
  float* out;
  char* ws;
};

DI unsigned f2bf(float x) { unsigned u = __float_as_uint(x); u += 0x7fffu + ((u >> 16) & 1u); return u >> 16; }
DI unsigned pack2(float a, float b) { return f2bf(a) | (f2bf(b) << 16); }
DI float bf2f(unsigned v) { return __uint_as_float(v << 16); }
DI float bflo(unsigned v) { return __uint_as_float(v << 16); }
DI float bfhi(unsigned v) { return __uint_as_float(v & 0xffff0000u); }
DI float fexp2(float x) { return __builtin_amdgcn_exp2f(x); }
DI float frcp(float x) { return __builtin_amdgcn_rcpf(x); }
DI float wave_sum(float v) {
#pragma unroll
  for (int o = 32; o > 0; o >>= 1) v += __shfl_xor(v, o);
  return v;
}
#define MFMA32(a, b, c) __builtin_amdgcn_mfma_f32_32x32x16_bf16((a), (b), (c), 0, 0, 0)
#define MFMA16(a, b, c) __builtin_amdgcn_mfma_f32_16x16x32_bf16((a), (b), (c), 0, 0, 0)
DI bf16x8 ld_frag_g(const bf16_t* p) { return __builtin_bit_cast(bf16x8, *(const u32x4*)p); }
DI bf16x8 ld_frag_s(const char* p) { return __builtin_bit_cast(bf16x8, *(const u32x4*)p); }
DI int otid() { int t = threadIdx.x; asm volatile("" : "+v"(t)); return t; }
DI int owid(int tid) { return __builtin_amdgcn_readfirstlane(tid >> 6); }
DI int crow(int reg, int g) { return (reg & 3) + 8 * (reg >> 2) + 4 * g; }

DI const float* prep_col(const Params& p, int mat, int r, int& ld) {
  switch (mat) {
    case 0: case 2: {
      int j = r >> 8, q = r & 255; int wn = q >> 6, half = (q >> 5) & 1, c = q & 31;
      int n = j * 128 + wn * 32 + c; ld = FF;
      const float* g = mat == 0 ? p.w1g : p.w2g; const float* u = mat == 0 ? p.w1u : p.w2u;
      return (half ? u : g) + n;
    }
    case 1: ld = D_; return p.w1d + r;
    case 3: ld = D_; return p.w2d + r;
    case 4: {
      ld = 4104;
      if (r < 512) return p.w_in + r;
      if (r < 4096) return p.w_in + r + 8;
      if (r < 4104) return p.w_in + (r - 4096 + 512);
      return nullptr;
    }
    case 5: ld = 512; return r < 512 ? p.w_uq + r : p.w_qi + (r - 512);
    case 6: { ld = 64; int h = r >> 6, d = r & 63; return p.w_uv + h * 8192 + d; }
    case 7: ld = D_; return p.w_oa + r;
    case 8: ld = D_; return p.w_ob + r;
    default: ld = D_; return p.w_out + r;
  }
}

DI void prep_transpose_tile(const Params& p, bool valid, int mat, int K, bf16_t* dst, int tile, float* lds, int t) {
  const int nkt = K >> 6;
  const int r0 = (tile / nkt) * 32, k0 = (tile % nkt) * 64;
  const int tx = t & 31, ty = t >> 5;
  if (valid) {
    int ld; const float* col = prep_col(p, mat, r0 + tx, ld);
#pragma unroll
    for (int i = 0; i < 8; ++i) {
      int k = k0 + ty + 8 * i;
      float v = 0.f;
      if (col) { v = col[(size_t)k * ld]; if (mat == 5) v *= p.g_cq[k]; }
      lds[tx * 65 + ty + 8 * i] = v;
    }
  }
  __syncthreads();
  if (valid) {
    const int row = t >> 3, kc = (t & 7) * 8;
    const float* s = lds + row * 65 + kc;
    u32x4 o; o[0] = pack2(s[0], s[1]); o[1] = pack2(s[2], s[3]); o[2] = pack2(s[4], s[5]); o[3] = pack2(s[6], s[7]);
    *(u32x4*)(dst + (size_t)(r0 + row) * K + k0 + kc) = o;
  }
  __syncthreads();
}

DI void rmsnorm_row(const float* __restrict__ xr, const float* __restrict__ g, bf16_t* __restrict__ o) {
  const int lane = otid() & 63;
  float4 v[4]; float ss = 0.f;
#pragma unroll
  for (int j = 0; j < 4; ++j) { v[j] = *(const float4*)(xr + lane * 4 + 256 * j); ss += v[j].x * v[j].x + v[j].y * v[j].y + v[j].z * v[j].z + v[j].w * v[j].w; }
  ss = wave_sum(ss);
  const float rs = rsqrtf(ss * (1.f / 1024.f) + EPS);
#pragma unroll
  for (int j = 0; j < 4; ++j) {
    float4 gg = *(const float4*)(g + lane * 4 + 256 * j);
    u32x2 w; w[0] = pack2(v[j].x * rs * gg.x, v[j].y * rs * gg.y); w[1] = pack2(v[j].z * rs * gg.z, v[j].w * rs * gg.w);
    *(u32x2*)(o + lane * 4 + 256 * j) = w;
  }
}

DI void phase_rmsnorm(const float* __restrict__ src, const float* __restrict__ g, bf16_t* __restrict__ dst) {
  const int wid = owid(otid());
  for (int it = blockIdx.x; it < T_ / NWAVE; it += gridDim.x) {
    int row = it * NWAVE + wid;
    rmsnorm_row(src + (size_t)row * D_, g, dst + (size_t)row * D_);
  }
}

DI void phase_prep(const Params& p, char* smem) {
  bf16_t* wb = (bf16_t*)(p.ws + OFF_WB);
  const int tid = otid(), vb = tid >> 8, t = tid & 255;
  float* lds = (float*)smem + vb * 2112;
  constexpr int c0 = 2816, c1 = c0 + 1408, c2 = c1 + 2816, c3 = c2 + 1408, c4 = c3 + 2176, c5 = c4 + 128, c6 = c5 + 32, c7 = c6 + 256, c8 = c7 + 256, c9 = c8 + 512;
  static_assert((c9 & 1) == 0, "pairs");
  for (int it0 = blockIdx.x; it0 < c9 / 2; it0 += gridDim.x) {
    const int it = it0 * 2 + vb;
    int mat, K, base; size_t off;
    if (it < c0) { mat = 0; K = 1024; base = 0; off = W1GU; }
    else if (it < c1) { mat = 1; K = 2816; base = c0; off = W1D; }
    else if (it < c2) { mat = 2; K = 1024; base = c1; off = W2GU; }
    else if (it < c3) { mat = 3; K = 2816; base = c2; off = W2D; }
    else if (it < c4) { mat = 4; K = 1024; base = c3; off = WIN; }
    else if (it < c5) { mat = 5; K = 256; base = c4; off = WQ; }
    else if (it < c6) { mat = 6; K = 128; base = c5; off = WUV; }
    else if (it < c7) { mat = 7; K = 512; base = c6; off = WOA; }
    else if (it < c8) { mat = 8; K = 512; base = c7; off = WOB; }
    else { mat = 9; K = 1024; base = c8; off = WOUT; }
    prep_transpose_tile(p, true, mat, K, wb + off, it - base, lds, t);
  }
  {
    const int wid = owid(tid);
    for (int it = blockIdx.x; it < T_ / NWAVE; it += gridDim.x) {
      int row = it * NWAVE + wid;
      rmsnorm_row(p.x + (size_t)row * D_, p.g_ffn1, (bf16_t*)(p.ws + OFF_H) + (size_t)row * D_);
    }
  }
  for (int it = blockIdx.x; it < T_ * 32 / NTHR; it += gridDim.x) {
    int e = it * NTHR + tid;
    int tok = e >> 5, i = e & 31;
    float inv_freq = exp2f(-(float)i * (13.287712379549449f / 32.f));
    float ang = (float)p.pos[tok] * inv_freq;
    double rev = (double)ang * 0.15915494309189535;
    rev -= floor(rev);
    float r = (float)rev;
    float2 cs; cs.x = __builtin_amdgcn_cosf(r); cs.y = __builtin_amdgcn_sinf(r);
    ((float2*)(p.ws + OFF_ROPE))[e] = cs;
  }
}

template <int LDA, int LDB, int NK>
DI void gemm_mainloop(const bf16_t* __restrict__ A, const bf16_t* __restrict__ B, char* smem, f32x16 (&acc)[4][2]) {
  const int tid = otid(), lane = tid & 63, wid = owid(tid), wm = wid >> 2, wn = wid & 3;
  const int lrow = tid >> 3, lch = tid & 7;
  const char* Ab = (const char*)A; const char* Bb = (const char*)B;
  const unsigned la = (unsigned)(lrow * LDA + lch * 8) * 2u, lb = (unsigned)(lrow * LDB + lch * 8) * 2u;
  const unsigned st_off = lrow * 128 + ((lch ^ ((lrow >> 1) & 7)) << 4);
  const int sw = (lane >> 1) & 7, g = lane >> 5;
  unsigned a_off[4], b_off[4];
#pragma unroll
  for (int ks = 0; ks < 4; ++ks) {
    unsigned c = (unsigned)(((ks * 2 + g) ^ sw) << 4);
    a_off[ks] = (wm * 128 + (lane & 31)) * 128 + c;
    b_off[ks] = 32768 + (wn * 64 + (lane & 31)) * 128 + c;
  }
  u32x4 ra[4], rb[4];
#pragma unroll
  for (int i = 0; i < 4; ++i) { ra[i] = *(const u32x4*)((Ab + (size_t)i * 128 * LDA) + la); rb[i] = *(const u32x4*)((Bb + (size_t)i * 128 * LDB) + lb); }
#pragma unroll
  for (int i = 0; i < 4; ++i) { *(u32x4*)(smem + st_off + i * 8192) = ra[i]; *(u32x4*)(smem + 32768 + st_off + i * 8192) = rb[i]; }
  __syncthreads();
  for (int kt = 0; kt < NK; ++kt) {
    const char* cur = smem + (kt & 1) * 65536;
    char* nxt = smem + ((kt + 1) & 1) * 65536;
    const bool more = kt + 1 < NK;
    if (more) {
      const char* An = Ab + (size_t)(kt + 1) * 128; const char* Bn = Bb + (size_t)(kt + 1) * 128;
#pragma unroll
      for (int i = 0; i < 4; ++i) { ra[i] = *(const u32x4*)((An + (size_t)i * 128 * LDA) + la); rb[i] = *(const u32x4*)((Bn + (size_t)i * 128 * LDB) + lb); }
    }
    __builtin_amdgcn_sched_barrier(0);
#pragma unroll
    for (int ks = 0; ks < 4; ++ks) {
      bf16x8 b0 = ld_frag_s(cur + b_off[ks]), b1 = ld_frag_s(cur + b_off[ks] + 4096);
#pragma unroll
      for (int mi = 0; mi < 4; ++mi) {
        bf16x8 a = ld_frag_s(cur + a_off[ks] + mi * 4096);
        acc[mi][0] = MFMA32(a, b0, acc[mi][0]);
        acc[mi][1] = MFMA32(a, b1, acc[mi][1]);
      }
    }
    __builtin_amdgcn_sched_barrier(0);
    if (more) {
#pragma unroll
      for (int i = 0; i < 4; ++i) { *(u32x4*)(nxt + st_off + i * 8192) = ra[i]; *(u32x4*)(nxt + 32768 + st_off + i * 8192) = rb[i]; }
    }
    __syncthreads();
  }
}

DI void zero_acc(f32x16 (&acc)[4][2]) {
#pragma unroll
  for (int a = 0; a < 4; ++a)
#pragma unroll
    for (int b = 0; b < 2; ++b)
#pragma unroll
      for (int r = 0; r < 16; ++r) acc[a][b][r] = 0.f;
}

DI int sched_tile(int it, int MT, int NT, int& mt, int& nt) {
  const int G = gridDim.x, b = blockIdx.x;
  const int per = G >> 3, pm = per >> 2;
  if ((G & 31) == 0 && pm > 0 && (MT % pm) == 0) {
    const int x = b & 7, j = b >> 3;
    const int nsn = (NT + 3) >> 2, nsm = MT / pm;
    const int st = it * 8 + x;
    if (st >= nsm * nsn) return -1;
    const int sm = st / nsn, sn = st - sm * nsn;
    mt = sm * pm + (j % pm); nt = sn * 4 + (j / pm);
    return nt < NT ? 1 : 0;
  } else {
    const int tile = it * G + b;
    if (tile >= MT * NT) return -1;
    nt = tile % NT; mt = tile / NT;
    return 1;
  }
}

#define EPI_IDS const int tid = otid(), lane = tid & 63, wid = owid(tid), wm = wid >> 2, wn = wid & 3, g = lane >> 5; (void)wm; (void)wn; (void)g;
#define ROWOF(mi, r) ((mi) * 32 + ((r) & 3) + 8 * ((r) >> 2))

DI void phase_ffn_gu(const Params& p, size_t woff, char* smem) {
  const bf16_t* H = (const bf16_t*)(p.ws + OFF_H);
  const bf16_t* W = (const bf16_t*)(p.ws + OFF_WB) + woff;
  bf16_t* U = (bf16_t*)(p.ws + OFF_PA);
  EPI_IDS
  for (int it = 0;; ++it) {
    int mt, nt; int s = sched_tile(it, 128, 22, mt, nt);
    if (s < 0) break; if (s == 0) continue;
    f32x16 acc[4][2]; zero_acc(acc);
    gemm_mainloop<D_, D_, 16>(H + (size_t)mt * 256 * D_, W + (size_t)nt * 256 * D_, smem, acc);
    bf16_t* tp = U + (size_t)(mt * 256) * FF + nt * 128;
    const unsigned loff = (unsigned)((wm * 128 + 4 * g) * FF + wn * 32 + (lane & 31));
#pragma unroll
    for (int mi = 0; mi < 4; ++mi)
#pragma unroll
      for (int r = 0; r < 16; ++r) {
        bf16_t* rp = tp + ROWOF(mi, r) * FF;
        float gv = acc[mi][0][r], uv = acc[mi][1][r];
        float sv = gv / (1.f + __expf(-gv)) * uv;
        rp[loff] = (bf16_t)f2bf(sv);
      }
  }
}

DI void phase_ffn_down(const Params& p, size_t woff, const float* res, char* smem) {
  const bf16_t* U = (const bf16_t*)(p.ws + OFF_PA);
  const bf16_t* W = (const bf16_t*)(p.ws + OFF_WB) + woff;
  float* out = p.out;
  EPI_IDS
  for (int it = 0;; ++it) {
    int mt, nt; int s = sched_tile(it, 128, 4, mt, nt);
    if (s < 0) break; if (s == 0) continue;
    f32x16 acc[4][2]; zero_acc(acc);
    gemm_mainloop<FF, FF, 44>(U + (size_t)mt * 256 * FF, W + (size_t)nt * 256 * FF, smem, acc);
    const size_t tb = (size_t)(mt * 256) * D_ + nt * 256;
    float* tp = out + tb; const float* rsp = res + tb;
    const unsigned loff = (unsigned)((wm * 128 + 4 * g) * D_ + wn * 64 + (lane & 31));
#pragma unroll
    for (int mi = 0; mi < 4; ++mi)
#pragma unroll
      for (int ni = 0; ni < 2; ++ni)
#pragma unroll
        for (int r = 0; r < 16; ++r) {
          const int ro = ROWOF(mi, r) * D_ + ni * 32;
          (tp + ro)[loff] = (rsp + ro)[loff] + 0.5f * acc[mi][ni][r];
        }
  }
}

DI void phase_win(const Params& p, char* smem) {
  const bf16_t* H = (const bf16_t*)(p.ws + OFF_H);
  const bf16_t* W = (const bf16_t*)(p.ws + OFF_WB) + WIN;
  bf16_t* PA = (bf16_t*)(p.ws + OFF_PA);
  bf16_t* VT = (bf16_t*)(p.ws + OFF_VT);
  bf16_t* GT = (bf16_t*)(p.ws + OFF_GATES);
  float* WI = (float*)(p.ws + OFF_WIDX);
  EPI_IDS
  for (int it = 0;; ++it) {
    int mt, nt; int s = sched_tile(it, 128, 17, mt, nt);
    if (s < 0) break; if (s == 0) continue;
    f32x16 acc[4][2]; zero_acc(acc);
    gemm_mainloop<D_, D_, 16>(H + (size_t)mt * 256 * D_, W + (size_t)nt * 256 * D_, smem, acc);
    if (nt < 6) {
      bf16_t* tp = PA + (size_t)(mt * 256) * PA_LD + nt * 256;
      const unsigned loff = (unsigned)((wm * 128 + 4 * g) * PA_LD + wn * 64 + (lane & 31));
#pragma unroll
      for (int mi = 0; mi < 4; ++mi)
#pragma unroll
        for (int ni = 0; ni < 2; ++ni)
#pragma unroll
          for (int r = 0; r < 16; ++r) {
            const int ro = ROWOF(mi, r) * PA_LD + ni * 32;
            (tp + ro)[loff] = (bf16_t)f2bf(acc[mi][ni][r]);
          }
    } else if (nt < 8) {
      const int b = mt >> 4;
#pragma unroll
      for (int mi = 0; mi < 4; ++mi)
#pragma unroll
        for (int ni = 0; ni < 2; ++ni) {
          int c = (nt - 6) * 256 + wn * 64 + ni * 32 + (lane & 31);
          int h = c >> 6, d = c & 63;
          bf16_t* dst = VT + ((size_t)(b * 8 + h) * 64 + d) * S_;
#pragma unroll
          for (int rq = 0; rq < 4; ++rq) {
            int tok = mt * 256 + wm * 128 + mi * 32 + 8 * rq + 4 * g;
            int sidx = tok & (S_ - 1);
            u32x2 w; w[0] = pack2(acc[mi][ni][4 * rq], acc[mi][ni][4 * rq + 1]); w[1] = pack2(acc[mi][ni][4 * rq + 2], acc[mi][ni][4 * rq + 3]);
            *(u32x2*)(dst + sidx) = w;
          }
        }
    } else if (nt < 16) {
      bf16_t* tp = GT + (size_t)(mt * 256) * 2048 + (nt - 8) * 256;
      const unsigned loff = (unsigned)((wm * 128 + 4 * g) * 2048 + wn * 64 + (lane & 31));
#pragma unroll
      for (int mi = 0; mi < 4; ++mi)
#pragma unroll
        for (int ni = 0; ni < 2; ++ni)
#pragma unroll
          for (int r = 0; r < 16; ++r) {
            const int ro = ROWOF(mi, r) * 2048 + ni * 32;
            float v = acc[mi][ni][r];
            float sg = 1.f / (1.f + __expf(-v));
            (tp + ro)[loff] = (bf16_t)f2bf(sg);
          }
    } else {
      if (wn == 0 && (lane & 31) < 8) {
#pragma unroll
        for (int mi = 0; mi < 4; ++mi)
#pragma unroll
          for (int r = 0; r < 16; ++r) {
            int row = mt * 256 + wm * 128 + mi * 32 + crow(r, g);
            WI[(size_t)row * 8 + (lane & 31)] = acc[mi][0][r] * 0.04419417382415922f;
          }
      }
    }
  }
}

DI void phase_qproj(const Params& p, char* smem) {
  bf16_t* PA = (bf16_t*)(p.ws + OFF_PA);
  const bf16_t* W = (const bf16_t*)(p.ws + OFF_WB) + WQ;
  bf16_t* QA = (bf16_t*)(p.ws + OFF_H);
  bf16_t* QI = QA + (size_t)T_ * 512;
  const float2* ROPE = (const float2*)(p.ws + OFF_ROPE);
  float* rstd = (float*)(smem + 131072);
  EPI_IDS
  for (int it = 0;; ++it) {
    int mt, nt; int s = sched_tile(it, 128, 4, mt, nt);
    if (s < 0) break; if (s == 0) continue;
    {
      int row = tid >> 1, half = tid & 1;
      const bf16_t* src = PA + (size_t)(mt * 256 + row) * PA_LD + half * 128;
      float ss = 0.f;
#pragma unroll 4
      for (int i = 0; i < 16; ++i) {
        u32x4 v = *(const u32x4*)(src + i * 8);
#pragma unroll
        for (int j = 0; j < 4; ++j) { float a = bflo(v[j]), b = bfhi(v[j]); ss += a * a + b * b; }
      }
      ss += __shfl_xor(ss, 1);
      if (half == 0) rstd[row] = rsqrtf(ss * (1.f / 256.f) + EPS);
    }
    f32x16 acc[4][2]; zero_acc(acc);
    gemm_mainloop<PA_LD, 256, 4>(PA + (size_t)mt * 256 * PA_LD, W + (size_t)nt * 256 * 256, smem, acc);
    const int d = lane & 31;
    const int head = (nt & 1) * 4 + wn;
    bf16_t* dtp = (nt < 2 ? QA : QI) + (size_t)(mt * 256) * 512 + head * 64;
    const float2* rtp = ROPE + (size_t)(mt * 256) * 32;
    const unsigned doff = (unsigned)((wm * 128 + 4 * g) * 512 + d);
    const unsigned roff = (unsigned)((wm * 128 + 4 * g) * 32 + d);
    const float* rsl = rstd + wm * 128 + 4 * g;
    float g0 = 1.f, g1 = 1.f;
    if (nt < 2) { g0 = p.g_qa[d]; g1 = p.g_qa[d + 32]; }
    const bool do_norm = nt < 2;
#pragma unroll
    for (int mi = 0; mi < 4; ++mi)
#pragma unroll
      for (int r = 0; r < 16; ++r) {
        const int ro = ROWOF(mi, r);
        float rs = rsl[ro];
        float v0 = acc[mi][0][r] * rs, v1 = acc[mi][1][r] * rs;
        if (do_norm) {
          float ss = v0 * v0 + v1 * v1;
#pragma unroll
          for (int o = 16; o > 0; o >>= 1) ss += __shfl_xor(ss, o);
          float r2 = rsqrtf(ss * (1.f / 64.f) + EPS);
          v0 *= r2 * g0; v1 *= r2 * g1;
        }
        float2 cs = (rtp + ro * 32)[roff];
        float o0 = v0 * cs.x - v1 * cs.y, o1 = v0 * cs.y + v1 * cs.x;
        (dtp + ro * 512)[doff] = (bf16_t)f2bf(o0);
        (dtp + ro * 512 + 32)[doff] = (bf16_t)f2bf(o1);
        if ((r & 3) == 3) __builtin_amdgcn_sched_barrier(0);
      }
    __syncthreads();
  }
  for (int it = blockIdx.x; it < T_ / 256; it += gridDim.x) {
    const int d = lane & 31; const bool isidx = lane >= 32;
    const float g0 = isidx ? 1.f : p.g_ka[d], g1 = isidx ? 1.f : p.g_ka[d + 32];
    for (int i = 0; i < 32; ++i) {
      int tok = it * 256 + wid * 32 + i;
      bf16_t* src = PA + (size_t)tok * PA_LD + (isidx ? PA_KI : PA_KA);
      float v0 = bf2f(src[d]), v1 = bf2f(src[d + 32]);
      float ss = v0 * v0 + v1 * v1;
#pragma unroll
      for (int o = 16; o > 0; o >>= 1) ss += __shfl_xor(ss, o);
      if (!isidx) { float r2 = rsqrtf(ss * (1.f / 64.f) + EPS); v0 *= r2 * g0; v1 *= r2 * g1; }
      float2 cs = ROPE[(size_t)tok * 32 + d];
      float o0 = v0 * cs.x - v1 * cs.y, o1 = v0 * cs.y + v1 * cs.x;
      src[d] = (bf16_t)f2bf(o0); src[d + 32] = (bf16_t)f2bf(o1);
    }
  }
}

DI void sb_item(const Params& p, int b, int h, int qb, char* smem) {
  bf16_t* PA = (bf16_t*)(p.ws + OFF_PA);
  const bf16_t* VT = (const bf16_t*)(p.ws + OFF_VT) + (size_t)(b * 8 + h) * 64 * S_;
  const int tid = otid(), lane = tid & 63, wid = owid(tid), g = lane >> 5, r = lane & 31;
  const int tw = qb * 256 + wid * 32;
  constexpr int BUFSZ = 8192 + 8704;
  const float zs = 0.125f * LOG2E;
  bf16x8 qf[4];
  {
    const bf16_t* qp = PA + (size_t)(b * S_ + tw + r) * PA_LD + PA_QB + h * 64 + g * 8;
#pragma unroll
    for (int ks = 0; ks < 4; ++ks) qf[ks] = ld_frag_g(qp + ks * 16);
  }
  const int srow = tid >> 3, sch = tid & 7;
  const bf16_t* gk = PA + (size_t)(b * S_ + srow) * PA_LD + PA_KB + h * 64 + sch * 8;
  const bf16_t* gv = VT + (size_t)srow * S_ + sch * 8;
  const unsigned k_st = srow * 128 + ((sch ^ ((srow >> 1) & 7)) << 4);
  const unsigned v_st = 8192 + srow * 136 + sch * 16;
  const int sw = (lane >> 1) & 7;
  f32x16 o0, o1;
#pragma unroll
  for (int i = 0; i < 16; ++i) { o0[i] = 0.f; o1[i] = 0.f; }
  float R = 1.f;
  const int nkt = 4 * qb + 4;
  u32x4 rk, rv;
  {
    int kt = nkt - 1;
    rk = *(const u32x4*)(gk + (size_t)(kt * 64) * PA_LD); rv = *(const u32x4*)(gv + kt * 64);
    char* cur = smem + (kt & 1) * BUFSZ;
    *(u32x4*)(cur + k_st) = rk;
    u32x2 lo, hi; lo[0] = rv[0]; lo[1] = rv[1]; hi[0] = rv[2]; hi[1] = rv[3];
    *(u32x2*)(cur + v_st) = lo; *(u32x2*)(cur + v_st + 8) = hi;
  }
  __syncthreads();
  for (int kt = nkt - 1; kt >= 0; --kt) {
    const char* cur = smem + (kt & 1) * BUFSZ;
    char* nxt = smem + ((kt + 1) & 1) * BUFSZ;
    const bool more = kt > 0;
    if (more) { rk = *(const u32x4*)(gk + (size_t)((kt - 1) * 64) * PA_LD); rv = *(const u32x4*)(gv + (kt - 1) * 64); }
    __builtin_amdgcn_sched_barrier(0);
#pragma unroll
    for (int sub = 1; sub >= 0; --sub) {
      const int sbase = kt * 64 + sub * 32;
      if (sbase <= tw) {
        f32x16 z;
#pragma unroll
        for (int i = 0; i < 16; ++i) z[i] = 0.f;
#pragma unroll
        for (int ks = 0; ks < 4; ++ks) {
          bf16x8 kf = ld_frag_s(cur + (sub * 32 + r) * 128 + (((ks * 2 + g) ^ sw) << 4));
          z = MFMA32(kf, qf[ks], z);
        }
        const bool diag = (sbase == tw);
        float e[16], rr[16];
#pragma unroll
        for (int i = 0; i < 16; ++i) {
          float z2 = fminf(z[i] * zs, 80.f);
          float ev = fexp2(z2);
          float rv_ = frcp(1.f + ev);
          if (diag && !(crow(i, g) < r)) { ev = 0.f; rv_ = 1.f; }
          e[i] = ev; rr[i] = rv_;
        }
        float G[4], Gp[4];
#pragma unroll
        for (int q = 0; q < 4; ++q) {
          rr[4 * q + 2] *= rr[4 * q + 3];
          rr[4 * q + 1] *= rr[4 * q + 2];
          rr[4 * q + 0] *= rr[4 * q + 1];
          G[q] = rr[4 * q];
        }
#pragma unroll
        for (int q = 0; q < 4; ++q) Gp[q] = __shfl_xor(G[q], 32);
        float SO[4], SP[4];
        SO[3] = 1.f; SO[2] = G[3]; SO[1] = G[2] * G[3]; SO[0] = G[1] * SO[1];
        SP[3] = 1.f; SP[2] = Gp[3]; SP[1] = Gp[2] * Gp[3]; SP[0] = Gp[1] * SP[1];
        float a[16];
#pragma unroll
        for (int q = 0; q < 4; ++q) {
          float part = g == 0 ? SP[q] * Gp[q] : SP[q];
          float E = SO[q] * part * R;
#pragma unroll
          for (int j = 0; j < 4; ++j) a[4 * q + j] = e[4 * q + j] * rr[4 * q + j] * E;
        }
        R = R * (SO[0] * G[0]) * (SP[0] * Gp[0]);
        u32x4 pw0, pw1;
#pragma unroll
        for (int j = 0; j < 4; ++j) { pw0[j] = pack2(a[2 * j], a[2 * j + 1]); pw1[j] = pack2(a[8 + 2 * j], a[8 + 2 * j + 1]); }
        bf16x8 pf0 = __builtin_bit_cast(bf16x8, pw0), pf1 = __builtin_bit_cast(bf16x8, pw1);
#pragma unroll
        for (int ks2 = 0; ks2 < 2; ++ks2) {
          const bf16x8 pf = ks2 == 0 ? pf0 : pf1;
#pragma unroll
          for (int dt = 0; dt < 2; ++dt) {
            const char* vp = cur + 8192 + (dt * 32 + r) * 136 + (sub * 32 + 16 * ks2 + 4 * g) * 2;
            u32x2 lo = *(const u32x2*)vp, hi = *(const u32x2*)(vp + 16);
            u32x4 vv; vv[0] = lo[0]; vv[1] = lo[1]; vv[2] = hi[0]; vv[3] = hi[1];
            bf16x8 vf = __builtin_bit_cast(bf16x8, vv);
            if (dt == 0) o0 = MFMA32(vf, pf, o0); else o1 = MFMA32(vf, pf, o1);
          }
        }
      }
    }
    __builtin_amdgcn_sched_barrier(0);
    if (more) {
      *(u32x4*)(nxt + k_st) = rk;
      u32x2 lo, hi; lo[0] = rv[0]; lo[1] = rv[1]; hi[0] = rv[2]; hi[1] = rv[3];
      *(u32x2*)(nxt + v_st) = lo; *(u32x2*)(nxt + v_st + 8) = hi;
    }
    __syncthreads();
  }
  bf16_t* yp = PA + (size_t)(b * S_ + tw + r) * PA_LD + PA_QB + h * 64;
#pragma unroll
  for (int rq = 0; rq < 4; ++rq) {
    u32x2 w0, w1;
    w0[0] = pack2(o0[4 * rq], o0[4 * rq + 1]); w0[1] = pack2(o0[4 * rq + 2], o0[4 * rq + 3]);
    w1[0] = pack2(o1[4 * rq], o1[4 * rq + 1]); w1[1] = pack2(o1[4 * rq + 2], o1[4 * rq + 3]);
    *(u32x2*)(yp + 8 * rq + 4 * g) = w0;
    *(u32x2*)(yp + 32 + 8 * rq + 4 * g) = w1;
  }
}

DI unsigned tokey(float f) { unsigned u = __float_as_uint(f); return (u & 0x80000000u) ? ~u : (u | 0x80000000u); }
DI int wave_count_sum(int c) {
  int tot = 0;
#pragma unroll
  for (int bt = 0; bt < 7; ++bt) tot += __builtin_popcountll(__ballot((c >> bt) & 1)) << bt;
  return tot;
}

DI void idx_item(const Params& p, int b, int qt, char* smem) {
  bf16_t* PA = (bf16_t*)(p.ws + OFF_PA);
  const bf16_t* QI = (const bf16_t*)(p.ws + OFF_H) + (size_t)T_ * 512;
  const float* WI = (const float*)(p.ws + OFF_WIDX);
  float* slab = (float*)(p.ws + OFF_SLAB) + (size_t)blockIdx.x * 16 * 4096;
  const int tid = otid(), lane = tid & 63, wid = owid(tid), g4 = lane >> 4, r = lane & 15;
  const int t0 = qt * 16;
  {
    bf16x8 qf[8][2]; float w[8];
    const bf16_t* qp = QI + (size_t)(b * S_ + t0 + r) * 512 + g4 * 8;
#pragma unroll
    for (int hh = 0; hh < 8; ++hh) { qf[hh][0] = ld_frag_g(qp + hh * 64); qf[hh][1] = ld_frag_g(qp + hh * 64 + 32); }
    {
      const float4* wp = (const float4*)(WI + (size_t)(b * S_ + t0 + r) * 8);
      float4 wa = wp[0], wb = wp[1];
      w[0] = wa.x; w[1] = wa.y; w[2] = wa.z; w[3] = wa.w; w[4] = wb.x; w[5] = wb.y; w[6] = wb.z; w[7] = wb.w;
    }
    const int nkt = qt + 1;
    const bf16_t* kbase = PA + (size_t)(b * S_ + r) * PA_LD + PA_KI + g4 * 8;
    bf16x8 k0, k1;
    {
      int kt = wid < nkt ? wid : 0;
      const bf16_t* kp = kbase + (size_t)(kt * 16) * PA_LD;
      k0 = ld_frag_g(kp); k1 = ld_frag_g(kp + 32);
    }
    for (int kt = wid; kt < nkt; kt += NWAVE) {
      bf16x8 n0, n1;
      {
        int kn = kt + NWAVE < nkt ? kt + NWAVE : kt;
        const bf16_t* kp = kbase + (size_t)(kn * 16) * PA_LD;
        n0 = ld_frag_g(kp); n1 = ld_frag_g(kp + 32);
      }
      f32x4 sc = {0.f, 0.f, 0.f, 0.f};
#pragma unroll
      for (int hh = 0; hh < 8; ++hh) {
        f32x4 c = {0.f, 0.f, 0.f, 0.f};
        c = MFMA16(k0, qf[hh][0], c);
        c = MFMA16(k1, qf[hh][1], c);
#pragma unroll
        for (int i = 0; i < 4; ++i) sc[i] += w[hh] * fmaxf(c[i], 0.f);
      }
      *(f32x4*)(slab + (size_t)r * 4096 + kt * 16 + 4 * g4) = sc;
      k0 = n0; k1 = n1;
    }
  }
  __syncthreads();
  for (int qi = 0; qi < 2; ++qi) {
    const int q = wid * 2 + qi;
    const int t = t0 + q, n = t + 1;
    unsigned short* out = (unsigned short*)(PA + (size_t)(b * S_ + t) * PA_LD);
    if (n <= 256) {
#pragma unroll
      for (int j = 0; j < 4; ++j) { int e = j * 64 + lane; out[e] = (unsigned short)(e < n ? e : 0); }
      continue;
    }
    const float* row = slab + (size_t)q * 4096 + lane;
    const int nj = (n + 63) >> 6;
    unsigned key[64];
#pragma unroll
    for (int ch = 0; ch < 4; ++ch) {
#pragma unroll
      for (int jj = 0; jj < 16; ++jj) key[ch * 16 + jj] = 0u;
      if (nj > ch * 16) {
#pragma unroll
        for (int jj = 0; jj < 16; ++jj) { const int j = ch * 16 + jj; if (j * 64 + lane < n) key[j] = tokey(row[j * 64]); }
      }
    }
    unsigned Tthr = 0u; int need = 0; bool exact = false;
    for (int bit = 31; bit >= 0; --bit) {
      const unsigned cand = Tthr | (1u << bit);
      int c = 0;
#pragma unroll
      for (int ch = 0; ch < 4; ++ch) {
        if (nj > ch * 16) {
#pragma unroll
          for (int jj = 0; jj < 16; ++jj) c += (key[ch * 16 + jj] >= cand) ? 1 : 0;
        }
      }
      const int cnt = wave_count_sum(c);
      if (cnt >= 256) Tthr = cand;
      if (cnt == 256) { exact = true; break; }
    }
    unsigned Tgt;
    if (exact) { Tgt = Tthr - 1u; need = 0; }
    else {
      int c = 0;
#pragma unroll
      for (int j = 0; j < 64; ++j) c += (key[j] > Tthr) ? 1 : 0;
      Tgt = Tthr; need = 256 - wave_count_sum(c);
    }
    const unsigned long long lt_mask = (1ull << lane) - 1ull;
    int base = 0, ties = 0;
#pragma unroll
    for (int j = 0; j < 64; ++j) {
      if (j < nj) {
        const bool gt = key[j] > Tgt;
        const bool eq = (!exact) && (key[j] == Tthr);
        const unsigned long long meq = __ballot(eq);
        const int myrank = ties + __builtin_popcountll(meq & lt_mask);
        const bool sel = gt || (eq && myrank < need);
        ties += __builtin_popcountll(meq);
        const unsigned long long ms = __ballot(sel);
        const int pos = base + __builtin_popcountll(ms & lt_mask);
        if (sel && pos < 256) out[pos] = (unsigned short)(j * 64 + lane);
        base += __builtin_popcountll(ms);
      }
    }
  }
  __syncthreads();
}

template <bool IDX_ONLY>
DI void phase_mix(const Params& p, char* smem) {
  unsigned* cnt = (unsigned*)(p.ws + OFF_CNT) + (IDX_ONLY ? 8 : 0);
  int* s_item = (int*)(smem + SMEM_BYTES - 16);
  constexpr int NSB = 64 * 16, NIDX = 8 * 256;
  while (true) {
    if (otid() == 0) *s_item = (int)atomicAdd(cnt, 1u);
    __syncthreads();
    const int item = *s_item;
    __syncthreads();
    if (IDX_ONLY) { if (item >= NIDX) break; int qt = 255 - (item >> 3), b = item & 7; idx_item(p, b, qt, smem); continue; }
    if (item >= NSB + NIDX) break;
    if (item < NSB) {
      int qb = 15 - (item >> 6), bh = item & 63;
      sb_item(p, bh >> 3, bh & 7, qb, smem);
    } else {
      int j = item - NSB;
      int qt = 255 - (j >> 3), b = j & 7;
      idx_item(p, b, qt, smem);
    }
  }
}

DI void phase_sparse(const Params& p, char* smem) {
  const bf16_t* PA = (const bf16_t*)(p.ws + OFF_PA);
  const bf16_t* QA = (const bf16_t*)(p.ws + OFF_H);
  bf16_t* YA = (bf16_t*)(p.ws + OFF_SLAB + (size_t)64 * 1024 * 1024);
  const bf16_t* WUVb = (const bf16_t*)(p.ws + OFF_WB) + WUV;
  const int tid = otid(), lane = tid & 63, wid = owid(tid), g4 = lane >> 4, c = lane & 15;
  float* Pl = (float*)(smem + wid * 9280);
  int* Il = (int*)(smem + wid * 9280 + 8192);
  float* Sl = (float*)(smem + wid * 9280 + 9216);
  float* Pq = Pl + g4 * 32 + c;
  char* OL = smem + 8 * 9280;
  const float sc2 = 0.125f * LOG2E;
  for (int it = blockIdx.x; it < T_ / 16; it += gridDim.x) {
    const int tok0 = it * 16;
    const int b = tok0 >> 12;
    for (int qi = 0; qi < 2; ++qi) {
      const int q = wid * 2 + qi;
      const int tok = tok0 + q, t = tok & (S_ - 1);
      const int nsel = t + 1 < 256 ? t + 1 : 256;
      const unsigned short* irow = (const unsigned short*)(PA + (size_t)tok * PA_LD);
#pragma unroll
      for (int j = 0; j < 4; ++j) { int e = j * 64 + lane; int v = irow[e]; Il[e] = e < nsel ? v : 0; }
      __syncthreads();
      bf16x8 qf0, qf1;
      {
        u32x4 z4 = {0u, 0u, 0u, 0u};
        qf0 = __builtin_bit_cast(bf16x8, z4); qf1 = qf0;
        if (c < 8) { const bf16_t* qp = QA + (size_t)tok * 512 + c * 64 + g4 * 8; qf0 = ld_frag_g(qp); qf1 = ld_frag_g(qp + 32); }
      }
      float m = -INFINITY;
#pragma unroll
      for (int kg = 0; kg < 4; ++kg) {
        bf16x8 ka[4][2];
#pragma unroll
        for (int k4 = 0; k4 < 4; ++k4) {
          int key = (Il + c)[(kg * 4 + k4) * 16];
          const bf16_t* kp = PA + (size_t)(b * S_ + key) * PA_LD + PA_KA + g4 * 8;
          ka[k4][0] = ld_frag_g(kp); ka[k4][1] = ld_frag_g(kp + 32);
        }
#pragma unroll
        for (int k4 = 0; k4 < 4; ++k4) {
          f32x4 cc = {0.f, 0.f, 0.f, 0.f};
          cc = MFMA16(ka[k4][0], qf0, cc);
          cc = MFMA16(ka[k4][1], qf1, cc);
#pragma unroll
          for (int i = 0; i < 4; ++i) {
            const int ec = (kg * 4 + k4) * 16 + i;
            float v = ec + 4 * g4 < nsel ? cc[i] : -INFINITY;
            m = fmaxf(m, v);
            if (c < 8) Pq[ec * 8] = v;
          }
        }
      }
      m = fmaxf(m, __shfl_xor(m, 16)); m = fmaxf(m, __shfl_xor(m, 32));
      float sum = 0.f;
      if (c < 8) {
#pragma unroll 4
        for (int kt = 0; kt < 16; ++kt)
#pragma unroll
          for (int i = 0; i < 4; ++i) {
            const int ec = kt * 16 + i;
            float pv = fexp2((Pq[ec * 8] - m) * sc2);
            Pq[ec * 8] = pv; sum += pv;
          }
      }
      sum += __shfl_xor(sum, 16); sum += __shfl_xor(sum, 32);
      if (lane < 8) Sl[lane] = 1.f / sum;
      __syncthreads();
      float acc[8][2];
#pragma unroll
      for (int hh = 0; hh < 8; ++hh) { acc[hh][0] = 0.f; acc[hh][1] = 0.f; }
      const bf16_t* vbase = PA + (size_t)b * S_ * PA_LD + PA_VA + 2 * lane;
      const int nk8 = (nsel + 7) & ~7;
      for (int k0 = 0; k0 < nk8; k0 += 8) {
        unsigned vv[8];
#pragma unroll
        for (int kk = 0; kk < 8; ++kk) {
          int key = __builtin_amdgcn_readfirstlane(Il[k0 + kk]);
          vv[kk] = *(const unsigned*)(vbase + (size_t)key * PA_LD);
        }
#pragma unroll
        for (int kk = 0; kk < 8; ++kk) {
          const f32x4 pa = *(const f32x4*)(Pl + (k0 + kk) * 8), pb = *(const f32x4*)(Pl + (k0 + kk) * 8 + 4);
          const float v0 = bflo(vv[kk]), v1 = bfhi(vv[kk]);
#pragma unroll
          for (int hh = 0; hh < 4; ++hh) { acc[hh][0] += pa[hh] * v0; acc[hh][1] += pa[hh] * v1; acc[hh + 4][0] += pb[hh] * v0; acc[hh + 4][1] += pb[hh] * v1; }
        }
      }
#pragma unroll
      for (int hh = 0; hh < 8; ++hh) { const float iv = Sl[hh]; *(unsigned*)(OL + q * 2064 + hh * 256 + lane * 4) = pack2(acc[hh][0] * iv, acc[hh][1] * iv); }
      __syncthreads();
    }
    {
      const int h = wid;
      bf16x8 af[4];
#pragma unroll
      for (int ks = 0; ks < 4; ++ks) af[ks] = ld_frag_s(OL + c * 2064 + h * 256 + (ks * 32 + g4 * 8) * 2);
#pragma nounroll
      for (int nt = 0; nt < 4; ++nt) {
        f32x4 cc = {0.f, 0.f, 0.f, 0.f};
        const bf16_t* wp = WUVb + (size_t)(h * 64 + nt * 16 + c) * 128 + g4 * 8;
#pragma unroll
        for (int ks = 0; ks < 4; ++ks) cc = MFMA16(af[ks], ld_frag_g(wp + ks * 32), cc);
#pragma unroll
        for (int i = 0; i < 4; ++i) YA[(size_t)(tok0 + 4 * g4 + i) * 512 + h * 64 + nt * 16 + c] = (bf16_t)f2bf(cc[i]);
      }
    }
    __syncthreads();
  }
}

DI void phase_merge(const Params& p, char* smem) {
  const bf16_t* YA = (const bf16_t*)(p.ws + OFF_SLAB + (size_t)64 * 1024 * 1024);
  const bf16_t* YB = (const bf16_t*)(p.ws + OFF_PA) + PA_QB;
  const bf16_t* Wa = (const bf16_t*)(p.ws + OFF_WB) + WOA;
  const bf16_t* Wb = (const bf16_t*)(p.ws + OFF_WB) + WOB;
  const bf16_t* GT = (const bf16_t*)(p.ws + OFF_GATES);
  bf16_t* MG = (bf16_t*)(p.ws + OFF_SLAB);
  EPI_IDS
  const unsigned goff = (unsigned)((wm * 128 + 4 * g) * 2048 + wn * 64 + (lane & 31));
  const unsigned loff = (unsigned)((wm * 128 + 4 * g) * D_ + wn * 64 + (lane & 31));
  for (int it = 0;; ++it) {
    int mt, nt; int s = sched_tile(it, 128, 4, mt, nt);
    if (s < 0) break; if (s == 0) continue;
    f32x16 acc[4][2]; zero_acc(acc);
    gemm_mainloop<512, 512, 8>(YA + (size_t)mt * 256 * 512, Wa + (size_t)nt * 256 * 512, smem, acc);
    const bf16_t* gp = GT + (size_t)(mt * 256) * 2048 + nt * 256;
    bf16_t* tp = MG + (size_t)(mt * 256) * D_ + nt * 256;
#pragma unroll
    for (int mi = 0; mi < 4; ++mi)
#pragma unroll
      for (int ni = 0; ni < 2; ++ni)
#pragma unroll
        for (int r = 0; r < 16; ++r) {
          const int ro = ROWOF(mi, r);
          float ga = bf2f((gp + ro * 2048 + ni * 32)[goff]);
          (tp + ro * D_ + ni * 32)[loff] = (bf16_t)f2bf(ga * acc[mi][ni][r]);
        }
  }
  for (int it = 0;; ++it) {
    int mt, nt; int s = sched_tile(it, 128, 4, mt, nt);
    if (s < 0) break; if (s == 0) continue;
    f32x16 acc[4][2]; zero_acc(acc);
    gemm_mainloop<PA_LD, 512, 8>(YB + (size_t)mt * 256 * PA_LD, Wb + (size_t)nt * 256 * 512, smem, acc);
    const bf16_t* gp = GT + (size_t)(mt * 256) * 2048 + 1024 + nt * 256;
    bf16_t* tp = MG + (size_t)(mt * 256) * D_ + nt * 256;
#pragma unroll
    for (int mi = 0; mi < 4; ++mi)
#pragma unroll
      for (int ni = 0; ni < 2; ++ni)
#pragma unroll
        for (int r = 0; r < 16; ++r) {
          const int ro = ROWOF(mi, r);
          float gb = bf2f((gp + ro * 2048 + ni * 32)[goff]);
          bf16_t* e = (tp + ro * D_ + ni * 32) + loff;
          *e = (bf16_t)f2bf(bf2f(*e) + gb * acc[mi][ni][r]);
        }
  }
}

DI void phase_outproj(const Params& p, char* smem) {
  const bf16_t* MG = (const bf16_t*)(p.ws + OFF_SLAB);
  const bf16_t* W = (const bf16_t*)(p.ws + OFF_WB) + WOUT;
  float* out = p.out;
  EPI_IDS
  for (int it = 0;; ++it) {
    int mt, nt; int s = sched_tile(it, 128, 4, mt, nt);
    if (s < 0) break; if (s == 0) continue;
    f32x16 acc[4][2]; zero_acc(acc);
    gemm_mainloop<D_, D_, 16>(MG + (size_t)mt * 256 * D_, W + (size_t)nt * 256 * D_, smem, acc);
    float* tp = out + (size_t)(mt * 256) * D_ + nt * 256;
    const unsigned loff = (unsigned)((wm * 128 + 4 * g) * D_ + wn * 64 + (lane & 31));
#pragma unroll
    for (int mi = 0; mi < 4; ++mi)
#pragma unroll
      for (int ni = 0; ni < 2; ++ni)
#pragma unroll
        for (int r = 0; r < 16; ++r) {
          const int ro = ROWOF(mi, r) * D_ + ni * 32;
          (tp + ro)[loff] = (tp + ro)[loff] + acc[mi][ni][r];
        }
  }
}

#define XB_TMO      128
#define XB_XCNT(j)  (256  + 64 * (j))
#define XB_XSUB(j)  (1280 + 64 * (j))
#define XB_XGEN(j)  (2304 + 64 * (j))
#define XB_TOP      3328
#define XB_TOPGEN   3392
#define XCD_BAR_WORDS 3456
#define XB_SPIN_CAP (1u << 22)
#define LAS __attribute__((address_space(3)))
DI unsigned xb_ld(unsigned* p) { return __hip_atomic_load(p, __ATOMIC_RELAXED, __HIP_MEMORY_SCOPE_AGENT); }
DI unsigned xb_add(unsigned* p, unsigned v) { return __hip_atomic_fetch_add(p, v, __ATOMIC_RELAXED, __HIP_MEMORY_SCOPE_AGENT); }
DI unsigned xb_xcc_id() { return (unsigned)__builtin_amdgcn_s_getreg((3 << 11) | 20) & 0xFu; }
#define XB_SPIN(cond, bar) do { unsigned _sp = 0; while (cond) { __builtin_amdgcn_s_sleep(1); \
    if ((++_sp & 255u) == 0u) { if (xb_ld(&(bar)[XB_TMO])) break; if (_sp > XB_SPIN_CAP) { atomicAdd(&(bar)[XB_TMO], 1u); break; } } } } while (0)
struct XcdBarrier { unsigned* bar; unsigned x; volatile LAS unsigned* st; };
DI XcdBarrier xcd_barrier_post(unsigned* bar, volatile LAS unsigned* st) {
  XcdBarrier b; b.bar = bar; b.x = xb_xcc_id(); b.st = st;
  if (threadIdx.x == 0) (void)xb_add(&bar[XB_XCNT(b.x)], 1u);
  return b;
}
DI void xcd_barrier_complete(unsigned* bar, unsigned x, unsigned& nloc, unsigned& nx) {
  const unsigned G = gridDim.x * gridDim.y * gridDim.z;
  unsigned sum, cnt, mine, sp = 0u;
  for (;;) {
    sum = 0u; cnt = 0u; mine = 0u;
#pragma unroll
    for (unsigned j = 0; j < 16; ++j) { const unsigned c = xb_ld(&bar[XB_XCNT(j)]); sum += c; cnt += (c > 0u) ? 1u : 0u; mine = (j == x) ? c : mine; }
    if (sum == G) break;
    __builtin_amdgcn_s_sleep(1);
    if ((++sp & 255u) == 0u) { if (xb_ld(&bar[XB_TMO])) break; if (sp > XB_SPIN_CAP) { atomicAdd(&bar[XB_TMO], 1u); break; } }
  }
  nloc = mine > 0u ? mine : 1u; nx = cnt > 0u ? cnt : 1u;
}
DI void xcd_barrier(const XcdBarrier& b) {
  asm volatile("s_waitcnt vmcnt(0)" ::: "memory");
  __syncthreads();
  if (threadIdx.x == 0) {
    unsigned* bar = b.bar;
    __builtin_amdgcn_s_waitcnt(0);
    unsigned nloc = b.st[0], nx = b.st[1];
    if (nloc == 0u) { xcd_barrier_complete(bar, b.x, nloc, nx); b.st[0] = nloc; b.st[1] = nx; }
    const unsigned old = xb_add(&bar[XB_XSUB(b.x)], 1u);
    const unsigned gen = old / nloc;
    if (old + 1u == (gen + 1u) * nloc) {
      __builtin_amdgcn_fence(__ATOMIC_RELEASE, "agent");
      asm volatile("s_waitcnt vmcnt(0)" ::: "memory");
      const unsigned og = xb_add(&bar[XB_TOP], 1u);
      const unsigned tg = og / nx;
      if (og + 1u == (tg + 1u) * nx) xb_add(&bar[XB_TOPGEN], 1u);
      else XB_SPIN(xb_ld(&bar[XB_TOPGEN]) == tg, bar);
      __builtin_amdgcn_fence(__ATOMIC_ACQUIRE, "agent");
      xb_add(&bar[XB_XGEN(b.x)], 1u);
      asm volatile("s_waitcnt vmcnt(0)" ::: "memory");
    } else {
      XB_SPIN(xb_ld(&bar[XB_XGEN(b.x)]) == gen, bar);
      __builtin_amdgcn_fence(__ATOMIC_ACQUIRE, "agent");
      asm volatile("s_waitcnt vmcnt(0)" ::: "memory");
    }
  }
  __syncthreads();
}

DI void run_phase(const Params& p, int ph, char* smem) {
  switch (ph) {
    case 0: phase_prep(p, smem); break;
    case 1: phase_ffn_gu(p, W1GU, smem); break;
    case 2: phase_ffn_down(p, W1D, p.x, smem); break;
    case 3: phase_rmsnorm(p.out, p.g_mix, (bf16_t*)(p.ws + OFF_H)); break;
    case 4: phase_win(p, smem); break;
    case 5: phase_qproj(p, smem); break;
    case 6: phase_mix<false>(p, smem); break;
    case 13: phase_mix<true>(p, smem); break;
    case 7: phase_sparse(p, smem); break;
    case 8: phase_merge(p, smem); break;
    case 9: phase_outproj(p, smem); break;
    case 10: phase_rmsnorm(p.out, p.g_ffn2, (bf16_t*)(p.ws + OFF_H)); break;
    case 11: phase_ffn_gu(p, W2GU, smem); break;
    case 12: phase_ffn_down(p, W2D, p.out, smem); break;
  }
}
constexpr int NPHASE = 13;

#if !MULTI_LAUNCH
__global__ void __launch_bounds__(512, 2) mega_kernel(Params p) {
  __shared__ __attribute__((aligned(16))) char smem[SMEM_BYTES];
  __shared__ uint4 xb_words;
  cg::grid_group grid = cg::this_grid();
  if (threadIdx.x == 0) xb_words = make_uint4(0u, 0u, 0u, 0u);
  __syncthreads();
  XcdBarrier xb = xcd_barrier_post((unsigned*)(p.ws + OFF_CNT + 256), (volatile LAS unsigned*)&xb_words);
#pragma nounroll
  for (int ph = 0; ph < NPHASE; ++ph) {
    int phv = ph; asm volatile("" : "+s"(phv));
    run_phase(p, phv, smem);
    if (ph == 0) grid.sync();
    else if (ph + 1 < NPHASE) xcd_barrier(xb);
  }
}
#else
template <int PH>
__global__ void __launch_bounds__(512, 2) phase_kernel(Params p) {
  __shared__ __attribute__((aligned(16))) char smem[SMEM_BYTES];
  run_phase(p, PH, smem);
}
#ifndef PROBE_MASK
#define PROBE_MASK 0
#endif
template <int PH> static void launch_phases(const Params& p, hipStream_t stream) {
  hipLaunchKernelGGL(phase_kernel<PH>, dim3(256), dim3(NTHR), 0, stream, p);
  if constexpr (((PROBE_MASK >> PH) & 1) != 0 && PH != 6) hipLaunchKernelGGL(phase_kernel<PH>, dim3(256), dim3(NTHR), 0, stream, p);
  if constexpr (((PROBE_MASK >> PH) & 1) != 0 && PH == 6) hipLaunchKernelGGL(phase_kernel<13>, dim3(256), dim3(NTHR), 0, stream, p);
  if constexpr (PH + 1 < NPHASE) launch_phases<PH + 1>(p, stream);
}
#endif

extern "C" void kernel_launch(void* const* d_in, const int* in_sizes, int n_in, void* d_out, int out_size, void* d_ws,
                              size_t ws_size, hipStream_t stream) {
  Params p{};
  p.x = (const float*)d_in[0]; p.pos = (const int*)d_in[1];
  p.g_ffn1 = (const float*)d_in[2]; p.w1g = (const float*)d_in[3]; p.w1u = (const float*)d_in[4]; p.w1d = (const float*)d_in[5];
  p.g_mix = (const float*)d_in[6]; p.w_in = (const float*)d_in[7]; p.g_cq = (const float*)d_in[8]; p.w_uq = (const float*)d_in[9];
  p.w_qi = (const float*)d_in[10]; p.g_qa = (const float*)d_in[11]; p.g_ka = (const float*)d_in[12]; p.w_uv = (const float*)d_in[13];
  p.w_oa = (const float*)d_in[14]; p.w_ob = (const float*)d_in[15]; p.w_out = (const float*)d_in[16]; p.g_ffn2 = (const float*)d_in[17];
  p.w2g = (const float*)d_in[18]; p.w2u = (const float*)d_in[19]; p.w2d = (const float*)d_in[20];
  p.out = (float*)d_out; p.ws = (char*)d_ws;
  if (ws_size < WS_NEED) { fprintf(stderr, "workspace too small: %zu < %zu\n", ws_size, (size_t)WS_NEED); return; }
  (void)hipMemsetAsync((char*)d_ws + OFF_CNT, 0, 256 + 16384, stream);
#if MULTI_LAUNCH
  launch_phases<0>(p, stream);
#else
  static int grid_blocks = 0;
  if (!grid_blocks) {
    int dev = 0, cus = 0, per_cu = 0;
    (void)hipGetDevice(&dev);
    (void)hipDeviceGetAttribute(&cus, hipDeviceAttributeMultiprocessorCount, dev);
    (void)hipOccupancyMaxActiveBlocksPerMultiprocessor(&per_cu, mega_kernel, NTHR, 0);
    if (per_cu > 1) per_cu = 1;
    grid_blocks = cus * per_cu;
    if (grid_blocks > 256) grid_blocks = 256;
  }
  void* args[] = {&p};
  hipError_t e = hipLaunchCooperativeKernel((void*)mega_kernel, dim3(grid_blocks), dim3(NTHR), args, 0, stream);
  if (e != hipSuccess) fprintf(stderr, "cooperative launch failed: %s (grid %d)\n", hipGetErrorString(e), grid_blocks);
#endif
}
```

```cpp
#include <hip/hip_runtime.h>
#include <hip/hip_cooperative_groups.h>
#include <stdint.h>
#include <stdio.h>
namespace cg = cooperative_groups;

#ifndef MULTI_LAUNCH
#define MULTI_LAUNCH 0
#endif

#define DI __device__ __forceinline__
typedef unsigned short bf16_t;
typedef __attribute__((ext_vector_type(8))) short bf16x8;
typedef __attribute__((ext_vector_type(16))) float f32x16;
typedef __attribute__((ext_vector_type(4))) float f32x4;
typedef __attribute__((ext_vector_type(4))) unsigned u32x4;
typedef __attribute__((ext_vector_type(2))) unsigned u32x2;

constexpr int T_ = 32768, S_ = 4096, D_ = 1024, FF = 2816;
constexpr int PA_LD = 1536;
constexpr int PA_KA = 256, PA_VA = 320, PA_KI = 448, PA_QB = 512, PA_KB = 1024;
constexpr float EPS = 1e-6f;
constexpr float LOG2E = 1.4426950408889634f;

constexpr size_t W1GU = 0;
constexpr size_t W1D = W1GU + (size_t)5632 * 1024;
constexpr size_t W2GU = W1D + (size_t)1024 * 2816;
constexpr size_t W2D = W2GU + (size_t)5632 * 1024;
constexpr size_t WIN = W2D + (size_t)1024 * 2816;
constexpr size_t WQ = WIN + (size_t)4352 * 1024;
constexpr size_t WUV = WQ + (size_t)1024 * 256;
constexpr size_t WOA = WUV + (size_t)512 * 128;
constexpr size_t WOB = WOA + (size_t)1024 * 512;
constexpr size_t WOUT = WOB + (size_t)1024 * 512;
constexpr size_t WB_ELEMS = WOUT + (size_t)1024 * 1024;
constexpr size_t OFF_WB = 0;
constexpr size_t OFF_H = (WB_ELEMS * 2 + 255) & ~(size_t)255;
constexpr size_t OFF_PA = OFF_H + (size_t)T_ * 1024 * 2;
constexpr size_t OFF_VT = OFF_PA + (size_t)T_ * PA_LD * 2;
constexpr size_t OFF_GATES = OFF_VT + (size_t)T_ * 512 * 2;
constexpr size_t OFF_SLAB = OFF_GATES + (size_t)T_ * 2048 * 2;
constexpr size_t OFF_WIDX = OFF_SLAB + (size_t)512 * 16 * 4096 * 4;
constexpr size_t OFF_ROPE = OFF_WIDX + (size_t)T_ * 8 * 4;
constexpr size_t OFF_CNT = OFF_ROPE + (size_t)T_ * 32 * 8;
constexpr size_t WS_NEED = OFF_CNT + 256 + 16384;
static_assert(WS_NEED <= (size_t)512 * 1024 * 1024, "workspace too large");
static_assert((size_t)T_ * FF * 2 <= OFF_SLAB - OFF_PA, "U must fit in PA+VT+GATES");

constexpr int SMEM_BYTES = 131072 + 2048;
constexpr int NTHR = 512, NWAVE = 8;

struct Params {
  const float* x; const int* pos;
  const float *g_ffn1, *w1g, *w1u, *w1d, *g_mix, *w_in, *g_cq, *w_uq, *w_qi, *g_qa, *g_ka, *w_uv, *w_oa, *w_ob, *w_out, *g_ffn2, *w2g, *w2u, *w2d;
  float* out;
  char* ws;
};

typedef __attribute__((ext_vector_type(2))) __bf16 bf16x2_t;
typedef __attribute__((ext_vector_type(2))) float f32x2_t;
DI unsigned pack2(float a, float b) { f32x2_t v = {a, b}; return __builtin_bit_cast(unsigned, __builtin_convertvector(v, bf16x2_t)); }
DI unsigned f2bf(float x) { return pack2(x, 0.f) & 0xffffu; }
DI float bf2f(unsigned v) { return __uint_as_float(v << 16); }
DI float bflo(unsigned v) { return __uint_as_float(v << 16); }
DI float bfhi(unsigned v) { return __uint_as_float(v & 0xffff0000u); }
DI float fexp2(float x) { return __builtin_amdgcn_exp2f(x); }
DI float frcp(float x) { return __builtin_amdgcn_rcpf(x); }
DI float wave_sum(float v) {
#pragma unroll
  for (int o = 32; o > 0; o >>= 1) v += __shfl_xor(v, o);
  return v;
}
#define MFMA32(a, b, c) __builtin_amdgcn_mfma_f32_32x32x16_bf16((a), (b), (c), 0, 0, 0)
#define MFMA16(a, b, c) __builtin_amdgcn_mfma_f32_16x16x32_bf16((a), (b), (c), 0, 0, 0)
DI bf16x8 ld_frag_g(const bf16_t* p) { return __builtin_bit_cast(bf16x8, *(const u32x4*)p); }
DI bf16x8 ld_frag_s(const char* p) { return __builtin_bit_cast(bf16x8, *(const u32x4*)p); }
DI int otid() { int t = threadIdx.x; asm volatile("" : "+v"(t)); return t; }
DI int owid(int tid) { return __builtin_amdgcn_readfirstlane(tid >> 6); }
DI int crow(int reg, int g) { return (reg & 3) + 8 * (reg >> 2) + 4 * g; }

DI const float* prep_col(const Params& p, int mat, int r, int& ld) {
  switch (mat) {
    case 0: case 2: {
      int j = r >> 8, q = r & 255; int half = q >> 7, c = q & 127;
      int n = j * 128 + c; ld = FF;
      const float* g = mat == 0 ? p.w1g : p.w2g; const float* u = mat == 0 ? p.w1u : p.w2u;
      return (half ? u : g) + n;
    }
    case 1: ld = D_; return p.w1d + r;
    case 3: ld = D_; return p.w2d + r;
    case 4: {
      ld = 4104;
      if (r < 512) return p.w_in + r;
      if (r < 4096) return p.w_in + r + 8;
      if (r < 4104) return p.w_in + (r - 4096 + 512);
      return nullptr;
    }
    case 5: {
      ld = 512;
      int T = r >> 8, q = r & 255; int hl = (q & 127) >> 5, d = (q >> 7) * 32 + (q & 31);
      int col = ((T & 1) * 4 + hl) * 64 + d;
      return (T < 2 ? p.w_uq : p.w_qi) + col;
    }
    case 6: { ld = 64; int h = r >> 6, d = r & 63; return p.w_uv + h * 8192 + d; }
    case 7: ld = D_; return p.w_oa + r;
    case 8: ld = D_; return p.w_ob + r;
    default: ld = D_; return p.w_out + r;
  }
}

DI void prep_transpose_tile(const Params& p, bool valid, int mat, int K, bf16_t* dst, int tile, float* lds, int t) {
  const int nkt = K >> 6;
  const int r0 = (tile / nkt) * 32, k0 = (tile % nkt) * 64;
  const int tx = t & 31, ty = t >> 5;
  if (valid) {
    int ld; const float* col = prep_col(p, mat, r0 + tx, ld);
#pragma unroll
    for (int i = 0; i < 8; ++i) {
      int k = k0 + ty + 8 * i;
      float v = 0.f;
      if (col) { v = col[(size_t)k * ld]; if (mat == 5) v *= p.g_cq[k]; }
      lds[tx * 65 + ty + 8 * i] = v;
    }
  }
  __syncthreads();
  if (valid) {
    const int row = t >> 3, kc = (t & 7) * 8;
    const float* s = lds + row * 65 + kc;
    u32x4 o; o[0] = pack2(s[0], s[1]); o[1] = pack2(s[2], s[3]); o[2] = pack2(s[4], s[5]); o[3] = pack2(s[6], s[7]);
    *(u32x4*)(dst + (size_t)(r0 + row) * K + k0 + kc) = o;
  }
  __syncthreads();
}

DI void rmsnorm_row(const float* __restrict__ xr, const float* __restrict__ g, bf16_t* __restrict__ o) {
  const int lane = otid() & 63;
  float4 v[4]; float ss = 0.f;
#pragma unroll
  for (int j = 0; j < 4; ++j) { v[j] = *(const float4*)(xr + lane * 4 + 256 * j); ss += v[j].x * v[j].x + v[j].y * v[j].y + v[j].z * v[j].z + v[j].w * v[j].w; }
  ss = wave_sum(ss);
  const float rs = rsqrtf(ss * (1.f / 1024.f) + EPS);
#pragma unroll
  for (int j = 0; j < 4; ++j) {
    float4 gg = *(const float4*)(g + lane * 4 + 256 * j);
    u32x2 w; w[0] = pack2(v[j].x * rs * gg.x, v[j].y * rs * gg.y); w[1] = pack2(v[j].z * rs * gg.z, v[j].w * rs * gg.w);
    *(u32x2*)(o + lane * 4 + 256 * j) = w;
  }
}

DI void phase_rmsnorm(const float* __restrict__ src, const float* __restrict__ g, bf16_t* __restrict__ dst) {
  const int wid = owid(otid());
  for (int it = blockIdx.x; it < T_ / NWAVE; it += gridDim.x) {
    int row = it * NWAVE + wid;
    rmsnorm_row(src + (size_t)row * D_, g, dst + (size_t)row * D_);
  }
}

DI void phase_prep(const Params& p, char* smem) {
  bf16_t* wb = (bf16_t*)(p.ws + OFF_WB);
  const int tid = otid(), vb = tid >> 8, t = tid & 255;
  float* lds = (float*)smem + vb * 2112;
  constexpr int c0 = 2816, c1 = c0 + 1408, c2 = c1 + 2816, c3 = c2 + 1408, c4 = c3 + 2176, c5 = c4 + 128, c6 = c5 + 32, c7 = c6 + 256, c8 = c7 + 256, c9 = c8 + 512;
  static_assert((c9 & 1) == 0, "pairs");
  for (int it0 = blockIdx.x; it0 < c9 / 2; it0 += gridDim.x) {
    const int it = it0 * 2 + vb;
    int mat, K, base; size_t off;
    if (it < c0) { mat = 0; K = 1024; base = 0; off = W1GU; }
    else if (it < c1) { mat = 1; K = 2816; base = c0; off = W1D; }
    else if (it < c2) { mat = 2; K = 1024; base = c1; off = W2GU; }
    else if (it < c3) { mat = 3; K = 2816; base = c2; off = W2D; }
    else if (it < c4) { mat = 4; K = 1024; base = c3; off = WIN; }
    else if (it < c5) { mat = 5; K = 256; base = c4; off = WQ; }
    else if (it < c6) { mat = 6; K = 128; base = c5; off = WUV; }
    else if (it < c7) { mat = 7; K = 512; base = c6; off = WOA; }
    else if (it < c8) { mat = 8; K = 512; base = c7; off = WOB; }
    else { mat = 9; K = 1024; base = c8; off = WOUT; }
    prep_transpose_tile(p, true, mat, K, wb + off, it - base, lds, t);
  }
  {
    const int wid = owid(tid);
    for (int it = blockIdx.x; it < T_ / NWAVE; it += gridDim.x) {
      int row = it * NWAVE + wid;
      rmsnorm_row(p.x + (size_t)row * D_, p.g_ffn1, (bf16_t*)(p.ws + OFF_H) + (size_t)row * D_);
    }
  }
  for (int it = blockIdx.x; it < T_ * 32 / NTHR; it += gridDim.x) {
    int e = it * NTHR + tid;
    int tok = e >> 5, i = e & 31;
    float inv_freq = exp2f(-(float)i * (13.287712379549449f / 32.f));
    float ang = (float)p.pos[tok] * inv_freq;
    double rev = (double)ang * 0.15915494309189535;
    rev -= floor(rev);
    float r = (float)rev;
    float2 cs; cs.x = __builtin_amdgcn_cosf(r); cs.y = __builtin_amdgcn_sinf(r);
    ((float2*)(p.ws + OFF_ROPE))[e] = cs;
  }
}

typedef f32x4 acc8p_t[2][2][4][2];
constexpr int G_BK = 64, G_HALF = 128, G_HT = G_HALF * G_BK;
DI int lds_byte(int r, int c) {
  int st = (r >> 4) * 2 + (c >> 5), rr = r & 15, cc = c & 31, ob = rr * 64 + cc * 2;
  return st * 1024 + (ob ^ (((ob >> 9) & 1) << 5));
}
DI void stage_rc(int b, int& R, int& C) {
  int st = b / 1024, sb = b % 1024, swz = sb ^ (((sb >> 9) & 1) << 5);
  R = (st >> 1) * 16 + swz / 64; C = (st & 1) * 32 + (swz % 64) / 2;
}
template <int LDA, int LDB, int NKT>
DI void gemm8p(const bf16_t* __restrict__ A, const bf16_t* __restrict__ Bt, char* smem, acc8p_t& acc) {
  static_assert(NKT >= 4 && (NKT % 2) == 0, "K tiles");
  bf16_t* shm = (bf16_t*)smem;
  const int tid = otid();
  const int wid = owid(tid), lane = tid & 63, wr = wid >> 2, wc = wid & 3, fr = lane & 15, fq = lane >> 4;
#define SA(b, h) (shm + ((b) * 2 + (h)) * G_HT)
#define SB(b, h) (shm + (4 + (b) * 2 + (h)) * G_HT)
  unsigned sofa[2], sofb[2];
#pragma unroll
  for (int _i = 0; _i < 2; ++_i) { int _r, _c; stage_rc(tid * 16 + _i * 8192, _r, _c); sofa[_i] = (unsigned)(_r * LDA + _c); sofb[_i] = (unsigned)(_r * LDB + _c); }
#define STAGE(P, BASE, LD, br, kt, SOF) do { const bf16_t* _ub = (BASE) + ((long)(br) * (LD) + (long)(kt) * G_BK);     \
    _Pragma("unroll") for (int _i = 0; _i < 2; ++_i) { \
      __builtin_amdgcn_global_load_lds((const unsigned*)(_ub + SOF[_i]), \
        (unsigned*)((char*)(P) + tid * 16 + _i * 8192), 16, 0, 0); } } while (0)
#define LDA_(dst, b, h) _Pragma("unroll") for (int m = 0; m < 4; ++m) _Pragma("unroll") for (int k = 0; k < 2; ++k) \
    dst[m][k] = *reinterpret_cast<const bf16x8*>((char*)SA(b, h) + lds_byte(wr * 64 + m * 16 + fr, k * 32 + fq * 8))
#define LDB_(dst, b, h) _Pragma("unroll") for (int n = 0; n < 2; ++n) _Pragma("unroll") for (int k = 0; k < 2; ++k) \
    dst[n][k] = *reinterpret_cast<const bf16x8*>((char*)SB(b, h) + lds_byte(wc * 32 + n * 16 + fr, k * 32 + fq * 8))
#define MMA(ai, bj, At_, Bt_) do { __builtin_amdgcn_s_setprio(1); \
    _Pragma("unroll") for (int m = 0; m < 4; ++m) _Pragma("unroll") for (int n = 0; n < 2; ++n) _Pragma("unroll") for (int k = 0; k < 2; ++k) \
      acc[ai][bj][m][n] = __builtin_amdgcn_mfma_f32_16x16x32_bf16(At_[m][k], Bt_[n][k], acc[ai][bj][m][n], 0, 0, 0); \
    __builtin_amdgcn_s_setprio(0); } while (0)
#define WAIT_V(n) asm volatile("s_waitcnt vmcnt(" #n ")" ::: "memory")
#define WAIT_L(n) asm volatile("s_waitcnt lgkmcnt(" #n ")" ::: "memory")
#define BAR __builtin_amdgcn_s_barrier()
#define SCHED __builtin_amdgcn_sched_barrier(0)
#pragma unroll
  for (int a = 0; a < 2; ++a)
#pragma unroll
    for (int b = 0; b < 2; ++b)
#pragma unroll
      for (int m = 0; m < 4; ++m)
#pragma unroll
        for (int n = 0; n < 2; ++n) acc[a][b][m][n] = f32x4{0.f, 0.f, 0.f, 0.f};
  bf16x8 At[4][2], B0[2][2], B1[2][2];
  constexpr int nt = NKT;
  WAIT_V(0);
  SCHED;
  STAGE(SB(0, 0), Bt, LDB, 0, 0, sofb); STAGE(SA(0, 0), A, LDA, 0, 0, sofa);
  STAGE(SB(0, 1), Bt, LDB, G_HALF, 0, sofb); STAGE(SA(0, 1), A, LDA, G_HALF, 0, sofa);
  if (wr == 1) BAR;
  WAIT_V(4); BAR;
  STAGE(SB(1, 0), Bt, LDB, 0, 1, sofb); STAGE(SA(1, 0), A, LDA, 0, 1, sofa); STAGE(SB(1, 1), Bt, LDB, G_HALF, 1, sofb);
  WAIT_V(6); BAR;
  for (int t = 0; t < nt - 2; t += 2) {
    LDB_(B0, 0, 0); SCHED; LDA_(At, 0, 0); STAGE(SA(1, 1), A, LDA, G_HALF, t + 1, sofa);
    WAIT_L(8); BAR; WAIT_L(0); MMA(0, 0, At, B0); BAR; SCHED;
    LDB_(B1, 0, 1); STAGE(SB(0, 0), Bt, LDB, 0, t + 2, sofb);
    BAR; WAIT_L(0); MMA(0, 1, At, B1); BAR;
    LDA_(At, 0, 1); STAGE(SA(0, 0), A, LDA, 0, t + 2, sofa);
    BAR; WAIT_L(0); MMA(1, 0, At, B0); BAR; SCHED;
    STAGE(SB(0, 1), Bt, LDB, G_HALF, t + 2, sofb);
    WAIT_V(6); BAR; MMA(1, 1, At, B1); BAR;
    LDB_(B0, 1, 0); SCHED; LDA_(At, 1, 0); STAGE(SA(0, 1), A, LDA, G_HALF, t + 2, sofa);
    WAIT_L(8); BAR; WAIT_L(0); MMA(0, 0, At, B0); BAR; SCHED;
    LDB_(B1, 1, 1); STAGE(SB(1, 0), Bt, LDB, 0, t + 3, sofb);
    BAR; WAIT_L(0); MMA(0, 1, At, B1); BAR;
    LDA_(At, 1, 1); STAGE(SA(1, 0), A, LDA, 0, t + 3, sofa);
    BAR; WAIT_L(0); MMA(1, 0, At, B0); BAR; SCHED;
    STAGE(SB(1, 1), Bt, LDB, G_HALF, t + 3, sofb);
    WAIT_V(6); BAR; MMA(1, 1, At, B1); BAR;
  }
  { LDB_(B0, 0, 0); LDA_(At, 0, 0); STAGE(SA(1, 1), A, LDA, G_HALF, nt - 1, sofa);
    BAR; WAIT_L(0); MMA(0, 0, At, B0); BAR;
    LDB_(B1, 0, 1); BAR; WAIT_L(0); MMA(0, 1, At, B1); BAR;
    LDA_(At, 0, 1); WAIT_V(4); BAR; WAIT_L(0); MMA(1, 0, At, B0); MMA(1, 1, At, B1); BAR; }
  { LDB_(B0, 1, 0); LDA_(At, 1, 0); WAIT_V(2); BAR; WAIT_L(0); MMA(0, 0, At, B0); BAR;
    LDB_(B1, 1, 1); WAIT_V(0); BAR; WAIT_L(0); MMA(0, 1, At, B1); BAR;
    LDA_(At, 1, 1); BAR; WAIT_L(0); MMA(1, 0, At, B0); MMA(1, 1, At, B1); BAR; }
  if (wr == 0) BAR;
#undef SA
#undef SB
#undef STAGE
#undef LDA_
#undef LDB_
#undef MMA
#undef WAIT_V
#undef WAIT_L
#undef BAR
#undef SCHED
}

DI int sched_tile(int it, int MT, int NT, int& mt, int& nt) {
  const int G = gridDim.x, b = blockIdx.x;
  const int per = G >> 3, pm = per >> 2;
  if ((G & 31) == 0 && pm > 0 && (MT % pm) == 0) {
    const int x = b & 7, j = b >> 3;
    const int nsn = (NT + 3) >> 2, nsm = MT / pm;
    const int st = it * 8 + x;
    if (st >= nsm * nsn) return -1;
    const int sm = st / nsn, sn = st - sm * nsn;
    mt = sm * pm + (j % pm); nt = sn * 4 + (j / pm);
    return nt < NT ? 1 : 0;
  } else {
    const int tile = it * G + b;
    if (tile >= MT * NT) return -1;
    nt = tile % NT; mt = tile / NT;
    return 1;
  }
}

#define EPI_IDS const int tid = otid(), lane = tid & 63, wid = owid(tid), wr = wid >> 2, wc = wid & 3, fr = lane & 15, fq = lane >> 4; (void)wr; (void)wc; (void)fr; (void)fq;
#define LROW(ai, m, j) ((ai) * 128 + (m) * 16 + (j))
#define LCOL(bj, n) ((bj) * 128 + (n) * 16)
#define EPI_FOR _Pragma("unroll") for (int ai = 0; ai < 2; ++ai) _Pragma("unroll") for (int bj = 0; bj < 2; ++bj) \
    _Pragma("unroll") for (int m = 0; m < 4; ++m) _Pragma("unroll") for (int n = 0; n < 2; ++n) _Pragma("unroll") for (int j = 0; j < 4; ++j)

DI void phase_ffn_gu(const Params& p, size_t woff, char* smem) {
  const bf16_t* H = (const bf16_t*)(p.ws + OFF_H);
  const bf16_t* W = (const bf16_t*)(p.ws + OFF_WB) + woff;
  bf16_t* U = (bf16_t*)(p.ws + OFF_PA);
  for (int it = 0;; ++it) {
    int mt, nt; int s = sched_tile(it, 128, 22, mt, nt);
    if (s < 0) break; if (s == 0) continue;
    acc8p_t acc;
    gemm8p<D_, D_, 16>(H + (size_t)mt * 256 * D_, W + (size_t)nt * 256 * D_, smem, acc);
    EPI_IDS
    bf16_t* tp = U + (size_t)(mt * 256) * FF + nt * 128;
    const unsigned loff = (unsigned)((wr * 64 + fq * 4) * FF + wc * 32 + fr);
#pragma unroll
    for (int ai = 0; ai < 2; ++ai)
#pragma unroll
      for (int m = 0; m < 4; ++m)
#pragma unroll
        for (int n = 0; n < 2; ++n)
#pragma unroll
          for (int j = 0; j < 4; ++j) {
            float gv = acc[ai][0][m][n][j], uv = acc[ai][1][m][n][j];
            float sv = gv / (1.f + __expf(-gv)) * uv;
            (tp + LROW(ai, m, j) * FF + n * 16)[loff] = (bf16_t)f2bf(sv);
          }
  }
}

DI void phase_ffn_down(const Params& p, size_t woff, const float* res, char* smem) {
  const bf16_t* U = (const bf16_t*)(p.ws + OFF_PA);
  const bf16_t* W = (const bf16_t*)(p.ws + OFF_WB) + woff;
  float* out = p.out;
  for (int it = 0;; ++it) {
    int mt, nt; int s = sched_tile(it, 128, 4, mt, nt);
    if (s < 0) break; if (s == 0) continue;
    acc8p_t acc;
    gemm8p<FF, FF, 44>(U + (size_t)mt * 256 * FF, W + (size_t)nt * 256 * FF, smem, acc);
    EPI_IDS
    const size_t tb = (size_t)(mt * 256) * D_ + nt * 256;
    float* tp = out + tb; const float* rsp = res + tb;
    const unsigned loff = (unsigned)((wr * 64 + fq * 4) * D_ + wc * 32 + fr);
    EPI_FOR {
      const int ro = LROW(ai, m, j) * D_ + LCOL(bj, n);
      (tp + ro)[loff] = (rsp + ro)[loff] + 0.5f * acc[ai][bj][m][n][j];
    }
  }
}

DI void phase_win(const Params& p, char* smem) {
  const bf16_t* H = (const bf16_t*)(p.ws + OFF_H);
  const bf16_t* W = (const bf16_t*)(p.ws + OFF_WB) + WIN;
  bf16_t* PA = (bf16_t*)(p.ws + OFF_PA);
  bf16_t* VT = (bf16_t*)(p.ws + OFF_VT);
  bf16_t* GT = (bf16_t*)(p.ws + OFF_GATES);
  float* WI = (float*)(p.ws + OFF_WIDX);
  for (int it = 0;; ++it) {
    int mt, nt; int s = sched_tile(it, 128, 17, mt, nt);
    if (s < 0) break; if (s == 0) continue;
    acc8p_t acc;
    gemm8p<D_, D_, 16>(H + (size_t)mt * 256 * D_, W + (size_t)nt * 256 * D_, smem, acc);
    EPI_IDS
    if (nt < 6) {
      bf16_t* tp = PA + (size_t)(mt * 256) * PA_LD + nt * 256;
      const unsigned loff = (unsigned)((wr * 64 + fq * 4) * PA_LD + wc * 32 + fr);
      const float qsc = (nt == 2 || nt == 3) ? 0.125f * LOG2E : 1.f;
      EPI_FOR {
        const int ro = LROW(ai, m, j) * PA_LD + LCOL(bj, n);
        (tp + ro)[loff] = (bf16_t)f2bf(acc[ai][bj][m][n][j] * qsc);
      }
    } else if (nt < 8) {
      const int b = mt >> 4;
#pragma unroll
      for (int ai = 0; ai < 2; ++ai)
#pragma unroll
        for (int bj = 0; bj < 2; ++bj)
#pragma unroll
          for (int m = 0; m < 4; ++m)
#pragma unroll
            for (int n = 0; n < 2; ++n) {
              int c = (nt - 6) * 256 + bj * 128 + wc * 32 + n * 16 + fr;
              int h = c >> 6, d = c & 63;
              int tok = mt * 256 + ai * 128 + wr * 64 + m * 16 + fq * 4;
              bf16_t* dst = VT + ((size_t)(b * 8 + h) * 64 + d) * S_ + (tok & (S_ - 1));
              u32x2 w; w[0] = pack2(acc[ai][bj][m][n][0], acc[ai][bj][m][n][1]); w[1] = pack2(acc[ai][bj][m][n][2], acc[ai][bj][m][n][3]);
              *(u32x2*)dst = w;
            }
    } else if (nt < 16) {
      bf16_t* tp = GT + (size_t)(mt * 256) * 2048 + (nt - 8) * 256;
      const unsigned loff = (unsigned)((wr * 64 + fq * 4) * 2048 + wc * 32 + fr);
      EPI_FOR {
        const int ro = LROW(ai, m, j) * 2048 + LCOL(bj, n);
        float v = acc[ai][bj][m][n][j];
        float sg = 1.f / (1.f + __expf(-v));
        (tp + ro)[loff] = (bf16_t)f2bf(sg);
      }
    } else {
      if (wc == 0 && fr < 8) {
#pragma unroll
        for (int ai = 0; ai < 2; ++ai)
#pragma unroll
          for (int m = 0; m < 4; ++m)
#pragma unroll
            for (int j = 0; j < 4; ++j) {
              int row = mt * 256 + ai * 128 + wr * 64 + m * 16 + fq * 4 + j;
              WI[(size_t)row * 8 + fr] = acc[ai][0][m][0][j] * 0.04419417382415922f;
            }
      }
    }
  }
}

DI void phase_qproj(const Params& p, char* smem) {
  bf16_t* PA = (bf16_t*)(p.ws + OFF_PA);
  const bf16_t* W = (const bf16_t*)(p.ws + OFF_WB) + WQ;
  bf16_t* QA = (bf16_t*)(p.ws + OFF_H);
  bf16_t* QI = QA + (size_t)T_ * 512;
  const float2* ROPE = (const float2*)(p.ws + OFF_ROPE);
  float* rstd = (float*)(smem + 131072);
  for (int it = 0;; ++it) {
    int mt, nt; int s = sched_tile(it, 128, 4, mt, nt);
    if (s < 0) break; if (s == 0) continue;
    {
      const int tq = otid(); int row = tq >> 1, half = tq & 1;
      const bf16_t* src = PA + (size_t)(mt * 256 + row) * PA_LD + half * 128;
      float ss = 0.f;
#pragma unroll 4
      for (int i = 0; i < 16; ++i) {
        u32x4 v = *(const u32x4*)(src + i * 8);
#pragma unroll
        for (int j = 0; j < 4; ++j) { float a = bflo(v[j]), b = bfhi(v[j]); ss += a * a + b * b; }
      }
      ss += __shfl_xor(ss, 1);
      if (half == 0) rstd[row] = rsqrtf(ss * (1.f / 256.f) + EPS);
    }
    acc8p_t acc;
    gemm8p<PA_LD, 256, 4>(PA + (size_t)mt * 256 * PA_LD, W + (size_t)nt * 256 * 256, smem, acc);
    EPI_IDS
    const int head = (nt & 1) * 4 + wc;
    bf16_t* dtp = (nt < 2 ? QA : QI) + (size_t)(mt * 256) * 512 + head * 64;
    const float2* rtp = ROPE + (size_t)(mt * 256) * 32;
    const unsigned doff = (unsigned)((wr * 64 + fq * 4) * 512 + fr);
    const unsigned roff = (unsigned)((wr * 64 + fq * 4) * 32 + fr);
    const float* rsl = rstd + wr * 64 + fq * 4;
    float ga[4] = {1.f, 1.f, 1.f, 1.f};
    const bool do_norm = nt < 2;
    if (do_norm) { ga[0] = p.g_qa[fr]; ga[1] = p.g_qa[16 + fr]; ga[2] = p.g_qa[32 + fr]; ga[3] = p.g_qa[48 + fr]; }
#pragma unroll
    for (int ai = 0; ai < 2; ++ai)
#pragma unroll
      for (int m = 0; m < 4; ++m)
#pragma unroll
        for (int j = 0; j < 4; ++j) {
          const int lr = LROW(ai, m, j);
          const float rs = rsl[lr];
          float x0 = acc[ai][0][m][0][j] * rs, x1 = acc[ai][0][m][1][j] * rs;
          float y0 = acc[ai][1][m][0][j] * rs, y1 = acc[ai][1][m][1][j] * rs;
          if (do_norm) {
            float ss = x0 * x0 + x1 * x1 + y0 * y0 + y1 * y1;
#pragma unroll
            for (int o = 8; o > 0; o >>= 1) ss += __shfl_xor(ss, o);
            const float r2 = rsqrtf(ss * (1.f / 64.f) + EPS);
            x0 *= r2 * ga[0]; x1 *= r2 * ga[1]; y0 *= r2 * ga[2]; y1 *= r2 * ga[3];
          }
          const float2 c0 = (rtp + lr * 32)[roff], c1 = (rtp + lr * 32 + 16)[roff];
          bf16_t* dp = dtp + lr * 512;
          (dp)[doff] = (bf16_t)f2bf(x0 * c0.x - y0 * c0.y);
          (dp + 32)[doff] = (bf16_t)f2bf(x0 * c0.y + y0 * c0.x);
          (dp + 16)[doff] = (bf16_t)f2bf(x1 * c1.x - y1 * c1.y);
          (dp + 48)[doff] = (bf16_t)f2bf(x1 * c1.y + y1 * c1.x);
          if (j == 3) __builtin_amdgcn_sched_barrier(0);
        }
    __syncthreads();
  }
  const int tid = otid(), lane = tid & 63, wid = owid(tid);
  for (int it = blockIdx.x; it < T_ / 256; it += gridDim.x) {
    const int d = lane & 31; const bool isidx = lane >= 32;
    const float g0 = isidx ? 1.f : p.g_ka[d], g1 = isidx ? 1.f : p.g_ka[d + 32];
    for (int i = 0; i < 32; ++i) {
      int tok = it * 256 + wid * 32 + i;
      bf16_t* src = PA + (size_t)tok * PA_LD + (isidx ? PA_KI : PA_KA);
      float v0 = bf2f(src[d]), v1 = bf2f(src[d + 32]);
      float ss = v0 * v0 + v1 * v1;
#pragma unroll
      for (int o = 16; o > 0; o >>= 1) ss += __shfl_xor(ss, o);
      if (!isidx) { float r2 = rsqrtf(ss * (1.f / 64.f) + EPS); v0 *= r2 * g0; v1 *= r2 * g1; }
      float2 cs = ROPE[(size_t)tok * 32 + d];
      float o0 = v0 * cs.x - v1 * cs.y, o1 = v0 * cs.y + v1 * cs.x;
      src[d] = (bf16_t)f2bf(o0); src[d + 32] = (bf16_t)f2bf(o1);
    }
  }
}

DI void sb_item(const Params& p, int b, int h, int qb, char* smem) {
  bf16_t* PA = (bf16_t*)(p.ws + OFF_PA);
  const bf16_t* VT = (const bf16_t*)(p.ws + OFF_VT) + (size_t)(b * 8 + h) * 64 * S_;
  const int tid = otid(), lane = tid & 63, wid = owid(tid), g = lane >> 5, r = lane & 31;
  const int tw = qb * 256 + wid * 32;
  constexpr int BUFSZ = 8192 + 8704;
  bf16x8 qf[4];
  {
    const bf16_t* qp = PA + (size_t)(b * S_ + tw + r) * PA_LD + PA_QB + h * 64 + g * 8;
#pragma unroll
    for (int ks = 0; ks < 4; ++ks) qf[ks] = ld_frag_g(qp + ks * 16);
  }
  const int srow = tid >> 3, sch = tid & 7;
  const bf16_t* gk = PA + (size_t)(b * S_ + srow) * PA_LD + PA_KB + h * 64 + sch * 8;
  const bf16_t* gv = VT + (size_t)srow * S_ + sch * 8;
  const unsigned k_st = srow * 128 + ((sch ^ ((srow >> 1) & 7)) << 4);
  const unsigned v_st = 8192 + srow * 136 + sch * 16;
  const int sw = (lane >> 1) & 7;
  f32x16 o0, o1;
#pragma unroll
  for (int i = 0; i < 16; ++i) { o0[i] = 0.f; o1[i] = 0.f; }
  float R = 1.f;
  const int nkt = 4 * qb + 4;
  u32x4 rk, rv;
  {
    int kt = nkt - 1;
    rk = *(const u32x4*)(gk + (size_t)(kt * 64) * PA_LD); rv = *(const u32x4*)(gv + kt * 64);
    char* cur = smem + (kt & 1) * BUFSZ;
    *(u32x4*)(cur + k_st) = rk;
    u32x2 lo, hi; lo[0] = rv[0]; lo[1] = rv[1]; hi[0] = rv[2]; hi[1] = rv[3];
    *(u32x2*)(cur + v_st) = lo; *(u32x2*)(cur + v_st + 8) = hi;
  }
  __syncthreads();
  for (int kt = nkt - 1; kt >= 0; --kt) {
    const char* cur = smem + (kt & 1) * BUFSZ;
    char* nxt = smem + ((kt + 1) & 1) * BUFSZ;
    const bool more = kt > 0;
    if (more) { rk = *(const u32x4*)(gk + (size_t)((kt - 1) * 64) * PA_LD); rv = *(const u32x4*)(gv + (kt - 1) * 64); }
    __builtin_amdgcn_sched_barrier(0);
#pragma unroll
    for (int sub = 1; sub >= 0; --sub) {
      const int sbase = kt * 64 + sub * 32;
      if (sbase <= tw) {
        f32x16 z;
#pragma unroll
        for (int i = 0; i < 16; ++i) z[i] = 0.f;
#pragma unroll
        for (int ks = 0; ks < 4; ++ks) {
          bf16x8 kf = ld_frag_s(cur + (sub * 32 + r) * 128 + (((ks * 2 + g) ^ sw) << 4));
          z = MFMA32(kf, qf[ks], z);
        }
        const bool diag = (sbase == tw);
        float e[16], rr[16];
#pragma unroll
        for (int i = 0; i < 16; ++i) {
          float z2 = fminf(z[i], 80.f);
          float ev = fexp2(z2);
          float rv_ = frcp(1.f + ev);
          if (diag && !(crow(i, g) < r)) { ev = 0.f; rv_ = 1.f; }
          e[i] = ev; rr[i] = rv_;
        }
        float G[4], Gp[4];
#pragma unroll
        for (int q = 0; q < 4; ++q) {
          rr[4 * q + 2] *= rr[4 * q + 3];
          rr[4 * q + 1] *= rr[4 * q + 2];
          rr[4 * q + 0] *= rr[4 * q + 1];
          G[q] = rr[4 * q];
        }
#pragma unroll
        for (int q = 0; q < 4; ++q) Gp[q] = __shfl_xor(G[q], 32);
        float SO[4], SP[4];
        SO[3] = 1.f; SO[2] = G[3]; SO[1] = G[2] * G[3]; SO[0] = G[1] * SO[1];
        SP[3] = 1.f; SP[2] = Gp[3]; SP[1] = Gp[2] * Gp[3]; SP[0] = Gp[1] * SP[1];
        float a[16];
#pragma unroll
        for (int q = 0; q < 4; ++q) {
          float part = g == 0 ? SP[q] * Gp[q] : SP[q];
          float E = SO[q] * part * R;
#pragma unroll
          for (int j = 0; j < 4; ++j) a[4 * q + j] = e[4 * q + j] * rr[4 * q + j] * E;
        }
        R = R * (SO[0] * G[0]) * (SP[0] * Gp[0]);
        u32x4 pw0, pw1;
#pragma unroll
        for (int j = 0; j < 4; ++j) { pw0[j] = pack2(a[2 * j], a[2 * j + 1]); pw1[j] = pack2(a[8 + 2 * j], a[8 + 2 * j + 1]); }
        bf16x8 pf0 = __builtin_bit_cast(bf16x8, pw0), pf1 = __builtin_bit_cast(bf16x8, pw1);
#pragma unroll
        for (int ks2 = 0; ks2 < 2; ++ks2) {
          const bf16x8 pf = ks2 == 0 ? pf0 : pf1;
#pragma unroll
          for (int dt = 0; dt < 2; ++dt) {
            const char* vp = cur + 8192 + (dt * 32 + r) * 136 + (sub * 32 + 16 * ks2 + 4 * g) * 2;
            u32x2 lo = *(const u32x2*)vp, hi = *(const u32x2*)(vp + 16);
            u32x4 vv; vv[0] = lo[0]; vv[1] = lo[1]; vv[2] = hi[0]; vv[3] = hi[1];
            bf16x8 vf = __builtin_bit_cast(bf16x8, vv);
            if (dt == 0) o0 = MFMA32(vf, pf, o0); else o1 = MFMA32(vf, pf, o1);
          }
        }
      }
    }
    __builtin_amdgcn_sched_barrier(0);
    if (more) {
      *(u32x4*)(nxt + k_st) = rk;
      u32x2 lo, hi; lo[0] = rv[0]; lo[1] = rv[1]; hi[0] = rv[2]; hi[1] = rv[3];
      *(u32x2*)(nxt + v_st) = lo; *(u32x2*)(nxt + v_st + 8) = hi;
    }
    __syncthreads();
  }
  bf16_t* yp = PA + (size_t)(b * S_ + tw + r) * PA_LD + PA_QB + h * 64;
#pragma unroll
  for (int rq = 0; rq < 4; ++rq) {
    u32x2 w0, w1;
    w0[0] = pack2(o0[4 * rq], o0[4 * rq + 1]); w0[1] = pack2(o0[4 * rq + 2], o0[4 * rq + 3]);
    w1[0] = pack2(o1[4 * rq], o1[4 * rq + 1]); w1[1] = pack2(o1[4 * rq + 2], o1[4 * rq + 3]);
    *(u32x2*)(yp + 8 * rq + 4 * g) = w0;
    *(u32x2*)(yp + 32 + 8 * rq + 4 * g) = w1;
  }
}

DI unsigned tokey(float f) { unsigned u = __float_as_uint(f); return (u & 0x80000000u) ? ~u : (u | 0x80000000u); }
DI int wave_count_sum(int c) {
  int tot = 0;
#pragma unroll
  for (int bt = 0; bt < 7; ++bt) tot += __builtin_popcountll(__ballot((c >> bt) & 1)) << bt;
  return tot;
}

DI void idx_item(const Params& p, int b, int qt, char* smem) {
  bf16_t* PA = (bf16_t*)(p.ws + OFF_PA);
  const bf16_t* QI = (const bf16_t*)(p.ws + OFF_H) + (size_t)T_ * 512;
  const float* WI = (const float*)(p.ws + OFF_WIDX);
  float* slab = (float*)(p.ws + OFF_SLAB) + (size_t)blockIdx.x * 16 * 4096;
  const int tid = otid(), lane = tid & 63, wid = owid(tid), g4 = lane >> 4, r = lane & 15;
  const int t0 = qt * 16;
  {
    bf16x8 qf[8][2]; float w[8];
    const bf16_t* qp = QI + (size_t)(b * S_ + t0 + r) * 512 + g4 * 8;
#pragma unroll
    for (int hh = 0; hh < 8; ++hh) { qf[hh][0] = ld_frag_g(qp + hh * 64); qf[hh][1] = ld_frag_g(qp + hh * 64 + 32); }
    {
      const float4* wp = (const float4*)(WI + (size_t)(b * S_ + t0 + r) * 8);
      float4 wa = wp[0], wb = wp[1];
      w[0] = wa.x; w[1] = wa.y; w[2] = wa.z; w[3] = wa.w; w[4] = wb.x; w[5] = wb.y; w[6] = wb.z; w[7] = wb.w;
    }
    const int nkt = qt + 1;
    const bf16_t* kbase = PA + (size_t)(b * S_ + r) * PA_LD + PA_KI + g4 * 8;
    bf16x8 k0, k1;
    {
      int kt = wid < nkt ? wid : 0;
      const bf16_t* kp = kbase + (size_t)(kt * 16) * PA_LD;
      k0 = ld_frag_g(kp); k1 = ld_frag_g(kp + 32);
    }
    for (int kt = wid; kt < nkt; kt += NWAVE) {
      bf16x8 n0, n1;
      {
        int kn = kt + NWAVE < nkt ? kt + NWAVE : kt;
        const bf16_t* kp = kbase + (size_t)(kn * 16) * PA_LD;
        n0 = ld_frag_g(kp); n1 = ld_frag_g(kp + 32);
      }
      f32x4 sc = {0.f, 0.f, 0.f, 0.f};
#pragma unroll
      for (int hh = 0; hh < 8; ++hh) {
        f32x4 c = {0.f, 0.f, 0.f, 0.f};
        c = MFMA16(k0, qf[hh][0], c);
        c = MFMA16(k1, qf[hh][1], c);
#pragma unroll
        for (int i = 0; i < 4; ++i) sc[i] += w[hh] * fmaxf(c[i], 0.f);
      }
      *(f32x4*)(slab + (size_t)r * 4096 + kt * 16 + 4 * g4) = sc;
      k0 = n0; k1 = n1;
    }
  }
  __syncthreads();
  for (int qi = 0; qi < 2; ++qi) {
    const int q = wid * 2 + qi;
    const int t = t0 + q, n = t + 1;
    unsigned short* out = (unsigned short*)(PA + (size_t)(b * S_ + t) * PA_LD);
    if (n <= 256) {
#pragma unroll
      for (int j = 0; j < 4; ++j) { int e = j * 64 + lane; out[e] = (unsigned short)(e < n ? e : 0); }
      continue;
    }
    const float* row = slab + (size_t)q * 4096 + lane;
    const int nj = (n + 63) >> 6;
    unsigned key[64];
#pragma unroll
    for (int ch = 0; ch < 4; ++ch) {
#pragma unroll
      for (int jj = 0; jj < 16; ++jj) key[ch * 16 + jj] = 0u;
      if (nj > ch * 16) {
#pragma unroll
        for (int jj = 0; jj < 16; ++jj) { const int j = ch * 16 + jj; if (j * 64 + lane < n) key[j] = tokey(row[j * 64]); }
      }
    }
    unsigned Tthr = 0u; int need = 0; bool exact = false;
    for (int bit = 31; bit >= 0; --bit) {
      const unsigned cand = Tthr | (1u << bit);
      int c = 0;
#pragma unroll
      for (int ch = 0; ch < 4; ++ch) {
        if (nj > ch * 16) {
#pragma unroll
          for (int jj = 0; jj < 16; ++jj) c += (key[ch * 16 + jj] >= cand) ? 1 : 0;
        }
      }
      const int cnt = wave_count_sum(c);
      if (cnt >= 256) Tthr = cand;
      if (cnt == 256) { exact = true; break; }
    }
    unsigned Tgt;
    if (exact) { Tgt = Tthr - 1u; need = 0; }
    else {
      int c = 0;
#pragma unroll
      for (int j = 0; j < 64; ++j) c += (key[j] > Tthr) ? 1 : 0;
      Tgt = Tthr; need = 256 - wave_count_sum(c);
    }
    const unsigned long long lt_mask = (1ull << lane) - 1ull;
    int base = 0, ties = 0;
#pragma unroll
    for (int j = 0; j < 64; ++j) {
      if (j < nj) {
        const bool gt = key[j] > Tgt;
        const bool eq = (!exact) && (key[j] == Tthr);
        const unsigned long long meq = __ballot(eq);
        const int myrank = ties + __builtin_popcountll(meq & lt_mask);
        const bool sel = gt || (eq && myrank < need);
        ties += __builtin_popcountll(meq);
        const unsigned long long ms = __ballot(sel);
        const int pos = base + __builtin_popcountll(ms & lt_mask);
        if (sel && pos < 256) out[pos] = (unsigned short)(j * 64 + lane);
        base += __builtin_popcountll(ms);
      }
    }
  }
  __syncthreads();
}

template <bool IDX_ONLY>
DI void phase_mix(const Params& p, char* smem) {
  unsigned* cnt = (unsigned*)(p.ws + OFF_CNT) + (IDX_ONLY ? 8 : 0);
  int* s_item = (int*)(smem + SMEM_BYTES - 16);
  constexpr int NSB = 64 * 16, NIDX = 8 * 256;
  while (true) {
    if (otid() == 0) *s_item = (int)atomicAdd(cnt, 1u);
    __syncthreads();
    const int item = *s_item;
    __syncthreads();
    if (IDX_ONLY) { if (item >= NIDX) break; int qt = 255 - (item >> 3), b = item & 7; idx_item(p, b, qt, smem); continue; }
    if (item >= NSB + NIDX) break;
    if (item < NSB) {
      int qb = 15 - (item >> 6), bh = item & 63;
      sb_item(p, bh >> 3, bh & 7, qb, smem);
    } else {
      int j = item - NSB;
      int qt = 255 - (j >> 3), b = j & 7;
      idx_item(p, b, qt, smem);
    }
  }
}

DI void phase_sparse(const Params& p, char* smem) {
  const bf16_t* PA = (const bf16_t*)(p.ws + OFF_PA);
  const bf16_t* QA = (const bf16_t*)(p.ws + OFF_H);
  bf16_t* YA = (bf16_t*)(p.ws + OFF_SLAB + (size_t)64 * 1024 * 1024);
  const bf16_t* WUVb = (const bf16_t*)(p.ws + OFF_WB) + WUV;
  const int tid = otid(), lane = tid & 63, wid = owid(tid), g4 = lane >> 4, c = lane & 15;
  float* Pl = (float*)(smem + wid * 9280);
  int* Il = (int*)(smem + wid * 9280 + 8192);
  float* Sl = (float*)(smem + wid * 9280 + 9216);
  float* Pq = Pl + g4 * 32 + c;
  char* OL = smem + 8 * 9280;
  const float sc2 = 0.125f * LOG2E;
  for (int it = blockIdx.x; it < T_ / 16; it += gridDim.x) {
    const int tok0 = it * 16;
    const int b = tok0 >> 12;
    for (int qi = 0; qi < 2; ++qi) {
      const int q = wid * 2 + qi;
      const int tok = tok0 + q, t = tok & (S_ - 1);
      const int nsel = t + 1 < 256 ? t + 1 : 256;
      const unsigned short* irow = (const unsigned short*)(PA + (size_t)tok * PA_LD);
#pragma unroll
      for (int j = 0; j < 4; ++j) { int e = j * 64 + lane; int v = irow[e]; Il[e] = e < nsel ? v : 0; }
      __syncthreads();
      bf16x8 qf0, qf1;
      {
        u32x4 z4 = {0u, 0u, 0u, 0u};
        qf0 = __builtin_bit_cast(bf16x8, z4); qf1 = qf0;
        if (c < 8) { const bf16_t* qp = QA + (size_t)tok * 512 + c * 64 + g4 * 8; qf0 = ld_frag_g(qp); qf1 = ld_frag_g(qp + 32); }
      }
      float m = -INFINITY;
#pragma unroll
      for (int kg = 0; kg < 4; ++kg) {
        bf16x8 ka[4][2];
#pragma unroll
        for (int k4 = 0; k4 < 4; ++k4) {
          int key = (Il + c)[(kg * 4 + k4) * 16];
          const bf16_t* kp = PA + (size_t)(b * S_ + key) * PA_LD + PA_KA + g4 * 8;
          ka[k4][0] = ld_frag_g(kp); ka[k4][1] = ld_frag_g(kp + 32);
        }
#pragma unroll
        for (int k4 = 0; k4 < 4; ++k4) {
          f32x4 cc = {0.f, 0.f, 0.f, 0.f};
          cc = MFMA16(ka[k4][0], qf0, cc);
          cc = MFMA16(ka[k4][1], qf1, cc);
#pragma unroll
          for (int i = 0; i < 4; ++i) {
            const int ec = (kg * 4 + k4) * 16 + i;
            float v = ec + 4 * g4 < nsel ? cc[i] : -INFINITY;
            m = fmaxf(m, v);
            if (c < 8) Pq[ec * 8] = v;
          }
        }
      }
      m = fmaxf(m, __shfl_xor(m, 16)); m = fmaxf(m, __shfl_xor(m, 32));
      float sum = 0.f;
      if (c < 8) {
#pragma unroll 4
        for (int kt = 0; kt < 16; ++kt)
#pragma unroll
          for (int i = 0; i < 4; ++i) {
            const int ec = kt * 16 + i;
            float pv = fexp2((Pq[ec * 8] - m) * sc2);
            Pq[ec * 8] = pv; sum += pv;
          }
      }
      sum += __shfl_xor(sum, 16); sum += __shfl_xor(sum, 32);
      if (lane < 8) Sl[lane] = 1.f / sum;
      __syncthreads();
      float acc[8][2];
#pragma unroll
      for (int hh = 0; hh < 8; ++hh) { acc[hh][0] = 0.f; acc[hh][1] = 0.f; }
      const bf16_t* vbase = PA + (size_t)b * S_ * PA_LD + PA_VA + 2 * lane;
      const int nk8 = (nsel + 7) & ~7;
      for (int k0 = 0; k0 < nk8; k0 += 8) {
        unsigned vv[8];
#pragma unroll
        for (int kk = 0; kk < 8; ++kk) {
          int key = __builtin_amdgcn_readfirstlane(Il[k0 + kk]);
          vv[kk] = *(const unsigned*)(vbase + (size_t)key * PA_LD);
        }
#pragma unroll
        for (int kk = 0; kk < 8; ++kk) {
          const f32x4 pa = *(const f32x4*)(Pl + (k0 + kk) * 8), pb = *(const f32x4*)(Pl + (k0 + kk) * 8 + 4);
          const float v0 = bflo(vv[kk]), v1 = bfhi(vv[kk]);
#pragma unroll
          for (int hh = 0; hh < 4; ++hh) { acc[hh][0] += pa[hh] * v0; acc[hh][1] += pa[hh] * v1; acc[hh + 4][0] += pb[hh] * v0; acc[hh + 4][1] += pb[hh] * v1; }
        }
      }
#pragma unroll
      for (int hh = 0; hh < 8; ++hh) { const float iv = Sl[hh]; *(unsigned*)(OL + q * 2064 + hh * 256 + lane * 4) = pack2(acc[hh][0] * iv, acc[hh][1] * iv); }
      __syncthreads();
    }
    {
      const int h = wid;
      bf16x8 af[4];
#pragma unroll
      for (int ks = 0; ks < 4; ++ks) af[ks] = ld_frag_s(OL + c * 2064 + h * 256 + (ks * 32 + g4 * 8) * 2);
#pragma nounroll
      for (int nt = 0; nt < 4; ++nt) {
        f32x4 cc = {0.f, 0.f, 0.f, 0.f};
        const bf16_t* wp = WUVb + (size_t)(h * 64 + nt * 16 + c) * 128 + g4 * 8;
#pragma unroll
        for (int ks = 0; ks < 4; ++ks) cc = MFMA16(af[ks], ld_frag_g(wp + ks * 32), cc);
#pragma unroll
        for (int i = 0; i < 4; ++i) YA[(size_t)(tok0 + 4 * g4 + i) * 512 + h * 64 + nt * 16 + c] = (bf16_t)f2bf(cc[i]);
      }
    }
    __syncthreads();
  }
}

DI void phase_merge(const Params& p, char* smem) {
  const bf16_t* YA = (const bf16_t*)(p.ws + OFF_SLAB + (size_t)64 * 1024 * 1024);
  const bf16_t* YB = (const bf16_t*)(p.ws + OFF_PA) + PA_QB;
  const bf16_t* Wa = (const bf16_t*)(p.ws + OFF_WB) + WOA;
  const bf16_t* Wb = (const bf16_t*)(p.ws + OFF_WB) + WOB;
  const bf16_t* GT = (const bf16_t*)(p.ws + OFF_GATES);
  bf16_t* MG = (bf16_t*)(p.ws + OFF_SLAB);
  for (int it = 0;; ++it) {
    int mt, nt; int s = sched_tile(it, 128, 4, mt, nt);
    if (s < 0) break; if (s == 0) continue;
    acc8p_t acc;
    gemm8p<512, 512, 8>(YA + (size_t)mt * 256 * 512, Wa + (size_t)nt * 256 * 512, smem, acc);
    EPI_IDS
    const unsigned goff = (unsigned)((wr * 64 + fq * 4) * 2048 + wc * 32 + fr);
    const unsigned loff = (unsigned)((wr * 64 + fq * 4) * D_ + wc * 32 + fr);
    const bf16_t* gp = GT + (size_t)(mt * 256) * 2048 + nt * 256;
    bf16_t* tp = MG + (size_t)(mt * 256) * D_ + nt * 256;
    EPI_FOR {
      const int lr = LROW(ai, m, j), lc = LCOL(bj, n);
      float ga = bf2f((gp + lr * 2048 + lc)[goff]);
      (tp + lr * D_ + lc)[loff] = (bf16_t)f2bf(ga * acc[ai][bj][m][n][j]);
    }
  }
  for (int it = 0;; ++it) {
    int mt, nt; int s = sched_tile(it, 128, 4, mt, nt);
    if (s < 0) break; if (s == 0) continue;
    acc8p_t acc;
    gemm8p<PA_LD, 512, 8>(YB + (size_t)mt * 256 * PA_LD, Wb + (size_t)nt * 256 * 512, smem, acc);
    EPI_IDS
    const unsigned goff = (unsigned)((wr * 64 + fq * 4) * 2048 + wc * 32 + fr);
    const unsigned loff = (unsigned)((wr * 64 + fq * 4) * D_ + wc * 32 + fr);
    const bf16_t* gp = GT + (size_t)(mt * 256) * 2048 + 1024 + nt * 256;
    bf16_t* tp = MG + (size_t)(mt * 256) * D_ + nt * 256;
    EPI_FOR {
      const int lr = LROW(ai, m, j), lc = LCOL(bj, n);
      float gb = bf2f((gp + lr * 2048 + lc)[goff]);
      bf16_t* e = (tp + lr * D_ + lc) + loff;
      *e = (bf16_t)f2bf(bf2f(*e) + gb * acc[ai][bj][m][n][j]);
    }
  }
}

DI void phase_outproj(const Params& p, char* smem) {
  const bf16_t* MG = (const bf16_t*)(p.ws + OFF_SLAB);
  const bf16_t* W = (const bf16_t*)(p.ws + OFF_WB) + WOUT;
  float* out = p.out;
  for (int it = 0;; ++it) {
    int mt, nt; int s = sched_tile(it, 128, 4, mt, nt);
    if (s < 0) break; if (s == 0) continue;
    acc8p_t acc;
    gemm8p<D_, D_, 16>(MG + (size_t)mt * 256 * D_, W + (size_t)nt * 256 * D_, smem, acc);
    EPI_IDS
    float* tp = out + (size_t)(mt * 256) * D_ + nt * 256;
    const unsigned loff = (unsigned)((wr * 64 + fq * 4) * D_ + wc * 32 + fr);
    EPI_FOR {
      const int ro = LROW(ai, m, j) * D_ + LCOL(bj, n);
      (tp + ro)[loff] = (tp + ro)[loff] + acc[ai][bj][m][n][j];
    }
  }
}

#define XB_TMO      128
#define XB_XCNT(j)  (256  + 64 * (j))
#define XB_XSUB(j)  (1280 + 64 * (j))
#define XB_XGEN(j)  (2304 + 64 * (j))
#define XB_TOP      3328
#define XB_TOPGEN   3392
#define XCD_BAR_WORDS 3456
#define XB_SPIN_CAP (1u << 22)
#define LAS __attribute__((address_space(3)))
DI unsigned xb_ld(unsigned* p) { return __hip_atomic_load(p, __ATOMIC_RELAXED, __HIP_MEMORY_SCOPE_AGENT); }
DI unsigned xb_add(unsigned* p, unsigned v) { return __hip_atomic_fetch_add(p, v, __ATOMIC_RELAXED, __HIP_MEMORY_SCOPE_AGENT); }
DI unsigned xb_xcc_id() { return (unsigned)__builtin_amdgcn_s_getreg((3 << 11) | 20) & 0xFu; }
#define XB_SPIN(cond, bar) do { unsigned _sp = 0; while (cond) { __builtin_amdgcn_s_sleep(1); \
    if ((++_sp & 255u) == 0u) { if (xb_ld(&(bar)[XB_TMO])) break; if (_sp > XB_SPIN_CAP) { atomicAdd(&(bar)[XB_TMO], 1u); break; } } } } while (0)
struct XcdBarrier { unsigned* bar; unsigned x; volatile LAS unsigned* st; };
DI XcdBarrier xcd_barrier_post(unsigned* bar, volatile LAS unsigned* st) {
  XcdBarrier b; b.bar = bar; b.x = xb_xcc_id(); b.st = st;
  if (threadIdx.x == 0) (void)xb_add(&bar[XB_XCNT(b.x)], 1u);
  return b;
}
DI void xcd_barrier_complete(unsigned* bar, unsigned x, unsigned& nloc, unsigned& nx) {
  const unsigned G = gridDim.x * gridDim.y * gridDim.z;
  unsigned sum, cnt, mine, sp = 0u;
  for (;;) {
    sum = 0u; cnt = 0u; mine = 0u;
#pragma unroll
    for (unsigned j = 0; j < 16; ++j) { const unsigned c = xb_ld(&bar[XB_XCNT(j)]); sum += c; cnt += (c > 0u) ? 1u : 0u; mine = (j == x) ? c : mine; }
    if (sum == G) break;
    __builtin_amdgcn_s_sleep(1);
    if ((++sp & 255u) == 0u) { if (xb_ld(&bar[XB_TMO])) break; if (sp > XB_SPIN_CAP) { atomicAdd(&bar[XB_TMO], 1u); break; } }
  }
  nloc = mine > 0u ? mine : 1u; nx = cnt > 0u ? cnt : 1u;
}
DI void xcd_barrier(const XcdBarrier& b) {
  asm volatile("s_waitcnt vmcnt(0)" ::: "memory");
  __syncthreads();
  if (threadIdx.x == 0) {
    unsigned* bar = b.bar;
    __builtin_amdgcn_s_waitcnt(0);
    unsigned nloc = b.st[0], nx = b.st[1];
    if (nloc == 0u) { xcd_barrier_complete(bar, b.x, nloc, nx); b.st[0] = nloc; b.st[1] = nx; }
    const unsigned old = xb_add(&bar[XB_XSUB(b.x)], 1u);
    const unsigned gen = old / nloc;
    if (old + 1u == (gen + 1u) * nloc) {
      __builtin_amdgcn_fence(__ATOMIC_RELEASE, "agent");
      asm volatile("s_waitcnt vmcnt(0)" ::: "memory");
      const unsigned og = xb_add(&bar[XB_TOP], 1u);
      const unsigned tg = og / nx;
      if (og + 1u == (tg + 1u) * nx) xb_add(&bar[XB_TOPGEN], 1u);
      else XB_SPIN(xb_ld(&bar[XB_TOPGEN]) == tg, bar);
      __builtin_amdgcn_fence(__ATOMIC_ACQUIRE, "agent");
      xb_add(&bar[XB_XGEN(b.x)], 1u);
      asm volatile("s_waitcnt vmcnt(0)" ::: "memory");
    } else {
      XB_SPIN(xb_ld(&bar[XB_XGEN(b.x)]) == gen, bar);
      __builtin_amdgcn_fence(__ATOMIC_ACQUIRE, "agent");
      asm volatile("s_waitcnt vmcnt(0)" ::: "memory");
    }
  }
  __syncthreads();
}

DI void run_phase(const Params& p, int ph, char* smem) {
  switch (ph) {
    case 0: phase_prep(p, smem); break;
    case 1: phase_ffn_gu(p, W1GU, smem); break;
    case 2: phase_ffn_down(p, W1D, p.x, smem); break;
    case 3: phase_rmsnorm(p.out, p.g_mix, (bf16_t*)(p.ws + OFF_H)); break;
    case 4: phase_win(p, smem); break;
    case 5: phase_qproj(p, smem); break;
    case 6: phase_mix<false>(p, smem); break;
    case 13: phase_mix<true>(p, smem); break;
    case 7: phase_sparse(p, smem); break;
    case 8: phase_merge(p, smem); break;
    case 9: phase_outproj(p, smem); break;
    case 10: phase_rmsnorm(p.out, p.g_ffn2, (bf16_t*)(p.ws + OFF_H)); break;
    case 11: phase_ffn_gu(p, W2GU, smem); break;
    case 12: phase_ffn_down(p, W2D, p.out, smem); break;
  }
}
constexpr int NPHASE = 13;

#if !MULTI_LAUNCH
__global__ void __launch_bounds__(512, 2) mega_kernel(Params p) {
  __shared__ __attribute__((aligned(16))) char smem[SMEM_BYTES];
  __shared__ uint4 xb_words;
  cg::grid_group grid = cg::this_grid();
  if (threadIdx.x == 0) xb_words = make_uint4(0u, 0u, 0u, 0u);
  __syncthreads();
  XcdBarrier xb = xcd_barrier_post((unsigned*)(p.ws + OFF_CNT + 256), (volatile LAS unsigned*)&xb_words);
#pragma nounroll
  for (int ph = 0; ph < NPHASE; ++ph) {
    int phv = ph; asm volatile("" : "+s"(phv));
    run_phase(p, phv, smem);
    if (ph == 0) grid.sync();
    else if (ph + 1 < NPHASE) xcd_barrier(xb);
  }
}
#else
template <int PH>
__global__ void __launch_bounds__(512, 2) phase_kernel(Params p) {
  __shared__ __attribute__((aligned(16))) char smem[SMEM_BYTES];
  run_phase(p, PH, smem);
}
#ifndef PROBE_MASK
#define PROBE_MASK 0
#endif
template <int PH> static void launch_phases(const Params& p, hipStream_t stream) {
  hipLaunchKernelGGL(phase_kernel<PH>, dim3(256), dim3(NTHR), 0, stream, p);
  if constexpr (((PROBE_MASK >> PH) & 1) != 0 && PH != 6) hipLaunchKernelGGL(phase_kernel<PH>, dim3(256), dim3(NTHR), 0, stream, p);
  if constexpr (((PROBE_MASK >> PH) & 1) != 0 && PH == 6) hipLaunchKernelGGL(phase_kernel<13>, dim3(256), dim3(NTHR), 0, stream, p);
  if constexpr (PH + 1 < NPHASE) launch_phases<PH + 1>(p, stream);
}
#endif

extern "C" void kernel_launch(void* const* d_in, const int* in_sizes, int n_in, void* d_out, int out_size, void* d_ws,
                              size_t ws_size, hipStream_t stream) {
  Params p{};
  p.x = (const float*)d_in[0]; p.pos = (const int*)d_in[1];
  p.g_ffn1 = (const float*)d_in[2]; p.w1g = (const float*)d_in[3]; p.w1u = (const float*)d_in[4]; p.w1d = (const float*)d_in[5];
  p.g_mix = (const float*)d_in[6]; p.w_in = (const float*)d_in[7]; p.g_cq = (const float*)d_in[8]; p.w_uq = (const float*)d_in[9];
  p.w_qi = (const float*)d_in[10]; p.g_qa = (const float*)d_in[11]; p.g_ka = (const float*)d_in[12]; p.w_uv = (const float*)d_in[13];
  p.w_oa = (const float*)d_in[14]; p.w_ob = (const float*)d_in[15]; p.w_out = (const float*)d_in[16]; p.g_ffn2 = (const float*)d_in[17];
  p.w2g = (const float*)d_in[18]; p.w2u = (const float*)d_in[19]; p.w2d = (const float*)d_in[20];
  p.out = (float*)d_out; p.ws = (char*)d_ws;
  if (ws_size < WS_NEED) { fprintf(stderr, "workspace too small: %zu < %zu\n", ws_size, (size_t)WS_NEED); return; }
  (void)hipMemsetAsync((char*)d_ws + OFF_CNT, 0, 256 + 16384, stream);
#if MULTI_LAUNCH
  launch_phases<0>(p, stream);
#else
  static int grid_blocks = 0;
  if (!grid_blocks) {
    int dev = 0, cus = 0, per_cu = 0;
    (void)hipGetDevice(&dev);
    (void)hipDeviceGetAttribute(&cus, hipDeviceAttributeMultiprocessorCount, dev);
    (void)hipOccupancyMaxActiveBlocksPerMultiprocessor(&per_cu, mega_kernel, NTHR, 0);
    if (per_cu > 1) per_cu = 1;
    grid_blocks = cus * per_cu;
    if (grid_blocks > 256) grid_blocks = 256;
  }
  void* args[] = {&p};
  hipError_t e = hipLaunchCooperativeKernel((void*)mega_kernel, dim3(grid_blocks), dim3(NTHR), args, 0, stream);
  if (e != hipSuccess) fprintf(stderr, "cooperative launch failed: %s (grid %d)\n", hipGetErrorString(e), grid_blocks);
#endif
}
```

```cpp
#include <hip/hip_runtime.h>
#include <hip/hip_cooperative_groups.h>
#include <stdint.h>
#include <stdio.h>
namespace cg = cooperative_groups;

#ifndef MULTI_LAUNCH
#define MULTI_LAUNCH 0
#endif

#define DI __device__ __forceinline__
typedef unsigned short bf16_t;
typedef __attribute__((ext_vector_type(8))) short bf16x8;
typedef __attribute__((ext_vector_type(16))) float f32x16;
typedef __attribute__((ext_vector_type(4))) float f32x4;
typedef __attribute__((ext_vector_type(4))) unsigned u32x4;
typedef __attribute__((ext_vector_type(2))) unsigned u32x2;

constexpr int T_ = 32768, S_ = 4096, D_ = 1024, FF = 2816;
constexpr int PA_LD = 1536;
constexpr int PA_KA = 256, PA_VA = 320, PA_KI = 448, PA_QB = 512, PA_KB = 1024;
constexpr float EPS = 1e-6f;
constexpr float LOG2E = 1.4426950408889634f;

constexpr size_t W1GU = 0;
constexpr size_t W1D = W1GU + (size_t)5632 * 1024;
constexpr size_t W2GU = W1D + (size_t)1024 * 2816;
constexpr size_t W2D = W2GU + (size_t)5632 * 1024;
constexpr size_t WIN = W2D + (size_t)1024 * 2816;
constexpr size_t WQ = WIN + (size_t)4352 * 1024;
constexpr size_t WUV = WQ + (size_t)1024 * 256;
constexpr size_t WOA = WUV + (size_t)512 * 128;
constexpr size_t WOB = WOA + (size_t)1024 * 512;
constexpr size_t WOUT = WOB + (size_t)1024 * 512;
constexpr size_t WB_ELEMS = WOUT + (size_t)1024 * 1024;
constexpr size_t OFF_WB = 0;
constexpr size_t OFF_H = (WB_ELEMS * 2 + 255) & ~(size_t)255;
constexpr size_t OFF_PA = OFF_H + (size_t)T_ * 1024 * 2;
constexpr size_t OFF_VT = OFF_PA + (size_t)T_ * PA_LD * 2;
constexpr size_t OFF_GATES = OFF_VT + (size_t)T_ * 512 * 2;
constexpr size_t OFF_SLAB = OFF_GATES + (size_t)T_ * 2048 * 2;
constexpr size_t OFF_WIDX = OFF_SLAB + (size_t)512 * 16 * 4096 * 4;
constexpr size_t OFF_ROPE = OFF_WIDX + (size_t)T_ * 8 * 4;
constexpr size_t OFF_CNT = OFF_ROPE + (size_t)T_ * 32 * 8;
constexpr size_t WS_NEED = OFF_CNT + 256 + 16384;
static_assert(WS_NEED <= (size_t)512 * 1024 * 1024, "workspace too large");
static_assert((size_t)T_ * FF * 2 <= OFF_SLAB - OFF_PA, "U must fit in PA+VT+GATES");

constexpr int SMEM_BYTES = 131072 + 2048;
__shared__ int g_sched[4];
constexpr int NTHR = 512, NWAVE = 8;

struct Params {
  const float* x; const int* pos;
  const float *g_ffn1, *w1g, *w1u, *w1d, *g_mix, *w_in, *g_cq, *w_uq, *w_qi, *g_qa, *g_ka, *w_uv, *w_oa, *w_ob, *w_out, *g_ffn2, *w2g, *w2u, *w2d;
  float* out;
  char* ws;
};

typedef __attribute__((ext_vector_type(2))) __bf16 bf16x2_t;
typedef __attribute__((ext_vector_type(2))) float f32x2_t;
DI unsigned pack2(float a, float b) { f32x2_t v = {a, b}; return __builtin_bit_cast(unsigned, __builtin_convertvector(v, bf16x2_t)); }
DI unsigned f2bf(float x) { return pack2(x, 0.f) & 0xffffu; }
DI float bf2f(unsigned v) { return __uint_as_float(v << 16); }
DI float bflo(unsigned v) { return __uint_as_float(v << 16); }
DI float bfhi(unsigned v) { return __uint_as_float(v & 0xffff0000u); }
DI float fexp2(float x) { return __builtin_amdgcn_exp2f(x); }
DI float frcp(float x) { return __builtin_amdgcn_rcpf(x); }
DI float wave_sum(float v) {
#pragma unroll
  for (int o = 32; o > 0; o >>= 1) v += __shfl_xor(v, o);
  return v;
}
#define MFMA32(a, b, c) __builtin_amdgcn_mfma_f32_32x32x16_bf16((a), (b), (c), 0, 0, 0)
#define MFMA16(a, b, c) __builtin_amdgcn_mfma_f32_16x16x32_bf16((a), (b), (c), 0, 0, 0)
DI bf16x8 ld_frag_g(const bf16_t* p) { return __builtin_bit_cast(bf16x8, *(const u32x4*)p); }
DI bf16x8 ld_frag_s(const char* p) { return __builtin_bit_cast(bf16x8, *(const u32x4*)p); }
DI int otid() { int t = threadIdx.x; asm volatile("" : "+v"(t)); return t; }
DI int owid(int tid) { return __builtin_amdgcn_readfirstlane(tid >> 6); }
DI int crow(int reg, int g) { return (reg & 3) + 8 * (reg >> 2) + 4 * g; }

DI const float* prep_col(const Params& p, int mat, int r, int& ld) {
  switch (mat) {
    case 0: case 2: {
      int j = r >> 8, q = r & 255; int half = q >> 7, c = q & 127;
      int n = j * 128 + c; ld = FF;
      const float* g = mat == 0 ? p.w1g : p.w2g; const float* u = mat == 0 ? p.w1u : p.w2u;
      return (half ? u : g) + n;
    }
    case 1: ld = D_; return p.w1d + r;
    case 3: ld = D_; return p.w2d + r;
    case 4: {
      ld = 4104;
      if (r < 512) return p.w_in + r;
      if (r < 4096) return p.w_in + r + 8;
      if (r < 4104) return p.w_in + (r - 4096 + 512);
      return nullptr;
    }
    case 5: {
      ld = 512;
      int T = r >> 8, q = r & 255; int hl = (q & 127) >> 5, d = (q >> 7) * 32 + (q & 31);
      int col = ((T & 1) * 4 + hl) * 64 + d;
      return (T < 2 ? p.w_uq : p.w_qi) + col;
    }
    case 6: { ld = 64; int h = r >> 6, d = r & 63; return p.w_uv + h * 8192 + d; }
    case 7: ld = D_; return p.w_oa + r;
    case 8: ld = D_; return p.w_ob + r;
    default: ld = D_; return p.w_out + r;
  }
}

DI void prep_transpose_tile(const Params& p, bool valid, int mat, int K, bf16_t* dst, int tile, float* lds, int t) {
  const int nkt = K >> 6;
  const int r0 = (tile / nkt) * 32, k0 = (tile % nkt) * 64;
  const int tx = t & 31, ty = t >> 5;
  if (valid) {
    int ld; const float* col = prep_col(p, mat, r0 + tx, ld);
#pragma unroll
    for (int i = 0; i < 8; ++i) {
      int k = k0 + ty + 8 * i;
      float v = 0.f;
      if (col) { v = col[(size_t)k * ld]; if (mat == 5) v *= p.g_cq[k]; }
      lds[tx * 65 + ty + 8 * i] = v;
    }
  }
  __syncthreads();
  if (valid) {
    const int row = t >> 3, kc = (t & 7) * 8;
    const float* s = lds + row * 65 + kc;
    u32x4 o; o[0] = pack2(s[0], s[1]); o[1] = pack2(s[2], s[3]); o[2] = pack2(s[4], s[5]); o[3] = pack2(s[6], s[7]);
    *(u32x4*)(dst + (size_t)(r0 + row) * K + k0 + kc) = o;
  }
  __syncthreads();
}

DI void rmsnorm_row(const float* __restrict__ xr, const float* __restrict__ g, bf16_t* __restrict__ o) {
  const int lane = otid() & 63;
  float4 v[4]; float ss = 0.f;
#pragma unroll
  for (int j = 0; j < 4; ++j) { v[j] = *(const float4*)(xr + lane * 4 + 256 * j); ss += v[j].x * v[j].x + v[j].y * v[j].y + v[j].z * v[j].z + v[j].w * v[j].w; }
  ss = wave_sum(ss);
  const float rs = rsqrtf(ss * (1.f / 1024.f) + EPS);
#pragma unroll
  for (int j = 0; j < 4; ++j) {
    float4 gg = *(const float4*)(g + lane * 4 + 256 * j);
    u32x2 w; w[0] = pack2(v[j].x * rs * gg.x, v[j].y * rs * gg.y); w[1] = pack2(v[j].z * rs * gg.z, v[j].w * rs * gg.w);
    *(u32x2*)(o + lane * 4 + 256 * j) = w;
  }
}

DI void phase_rmsnorm(const float* __restrict__ src, const float* __restrict__ g, bf16_t* __restrict__ dst) {
  const int wid = owid(otid());
  for (int it = blockIdx.x; it < T_ / NWAVE; it += gridDim.x) {
    int row = it * NWAVE + wid;
    rmsnorm_row(src + (size_t)row * D_, g, dst + (size_t)row * D_);
  }
}

DI void phase_prep(const Params& p, char* smem) {
  bf16_t* wb = (bf16_t*)(p.ws + OFF_WB);
  const int tid = otid(), vb = tid >> 8, t = tid & 255;
  float* lds = (float*)smem + vb * 2112;
  constexpr int c0 = 2816, c1 = c0 + 1408, c2 = c1 + 2816, c3 = c2 + 1408, c4 = c3 + 2176, c5 = c4 + 128, c6 = c5 + 32, c7 = c6 + 256, c8 = c7 + 256, c9 = c8 + 512;
  static_assert((c9 & 1) == 0, "pairs");
  for (int it0 = blockIdx.x; it0 < c9 / 2; it0 += gridDim.x) {
    const int it = it0 * 2 + vb;
    int mat, K, base; size_t off;
    if (it < c0) { mat = 0; K = 1024; base = 0; off = W1GU; }
    else if (it < c1) { mat = 1; K = 2816; base = c0; off = W1D; }
    else if (it < c2) { mat = 2; K = 1024; base = c1; off = W2GU; }
    else if (it < c3) { mat = 3; K = 2816; base = c2; off = W2D; }
    else if (it < c4) { mat = 4; K = 1024; base = c3; off = WIN; }
    else if (it < c5) { mat = 5; K = 256; base = c4; off = WQ; }
    else if (it < c6) { mat = 6; K = 128; base = c5; off = WUV; }
    else if (it < c7) { mat = 7; K = 512; base = c6; off = WOA; }
    else if (it < c8) { mat = 8; K = 512; base = c7; off = WOB; }
    else { mat = 9; K = 1024; base = c8; off = WOUT; }
    prep_transpose_tile(p, true, mat, K, wb + off, it - base, lds, t);
  }
  {
    const int wid = owid(tid);
    for (int it = blockIdx.x; it < T_ / NWAVE; it += gridDim.x) {
      int row = it * NWAVE + wid;
      rmsnorm_row(p.x + (size_t)row * D_, p.g_ffn1, (bf16_t*)(p.ws + OFF_H) + (size_t)row * D_);
    }
  }
  for (int it = blockIdx.x; it < T_ * 32 / NTHR; it += gridDim.x) {
    int e = it * NTHR + tid;
    int tok = e >> 5, i = e & 31;
    float inv_freq = exp2f(-(float)i * (13.287712379549449f / 32.f));
    float ang = (float)p.pos[tok] * inv_freq;
    double rev = (double)ang * 0.15915494309189535;
    rev -= floor(rev);
    float r = (float)rev;
    float2 cs; cs.x = __builtin_amdgcn_cosf(r); cs.y = __builtin_amdgcn_sinf(r);
    ((float2*)(p.ws + OFF_ROPE))[e] = cs;
  }
}

typedef f32x4 acc8p_t[2][2][4][2];
constexpr int G_BK = 64, G_HALF = 128, G_HT = G_HALF * G_BK;
DI int lds_byte(int r, int c) {
  int st = (r >> 4) * 2 + (c >> 5), rr = r & 15, cc = c & 31, ob = rr * 64 + cc * 2;
  return st * 1024 + (ob ^ (((ob >> 9) & 1) << 5));
}
DI void stage_rc(int b, int& R, int& C) {
  int st = b / 1024, sb = b % 1024, swz = sb ^ (((sb >> 9) & 1) << 5);
  R = (st >> 1) * 16 + swz / 64; C = (st & 1) * 32 + (swz % 64) / 2;
}
template <int LDA, int LDB, int NKT>
DI void gemm8p(const bf16_t* __restrict__ A, const bf16_t* __restrict__ Bt, char* smem, acc8p_t& acc) {
  static_assert(NKT >= 4 && (NKT % 2) == 0, "K tiles");
  bf16_t* shm = (bf16_t*)smem;
  const int tid = otid();
  const int wid = owid(tid), lane = tid & 63, wr = wid >> 2, wc = wid & 3, fr = lane & 15, fq = lane >> 4;
#define SA(b, h) (shm + ((b) * 2 + (h)) * G_HT)
#define SB(b, h) (shm + (4 + (b) * 2 + (h)) * G_HT)
  unsigned sofa[2], sofb[2];
#pragma unroll
  for (int _i = 0; _i < 2; ++_i) { int _r, _c; stage_rc(tid * 16 + _i * 8192, _r, _c); sofa[_i] = (unsigned)(_r * LDA + _c); sofb[_i] = (unsigned)(_r * LDB + _c); }
#define STAGE(P, BASE, LD, br, kt, SOF) do { const bf16_t* _ub = (BASE) + ((long)(br) * (LD) + (long)(kt) * G_BK);     \
    _Pragma("unroll") for (int _i = 0; _i < 2; ++_i) { \
      __builtin_amdgcn_global_load_lds((const unsigned*)(_ub + SOF[_i]), \
        (unsigned*)((char*)(P) + tid * 16 + _i * 8192), 16, 0, 0); } } while (0)
#define LDA_(dst, b, h) _Pragma("unroll") for (int m = 0; m < 4; ++m) _Pragma("unroll") for (int k = 0; k < 2; ++k) \
    dst[m][k] = *reinterpret_cast<const bf16x8*>((char*)SA(b, h) + lds_byte(wr * 64 + m * 16 + fr, k * 32 + fq * 8))
#define LDB_(dst, b, h) _Pragma("unroll") for (int n = 0; n < 2; ++n) _Pragma("unroll") for (int k = 0; k < 2; ++k) \
    dst[n][k] = *reinterpret_cast<const bf16x8*>((char*)SB(b, h) + lds_byte(wc * 32 + n * 16 + fr, k * 32 + fq * 8))
#define MMA(ai, bj, At_, Bt_) do { __builtin_amdgcn_s_setprio(1); \
    _Pragma("unroll") for (int m = 0; m < 4; ++m) _Pragma("unroll") for (int n = 0; n < 2; ++n) _Pragma("unroll") for (int k = 0; k < 2; ++k) \
      acc[ai][bj][m][n] = __builtin_amdgcn_mfma_f32_16x16x32_bf16(At_[m][k], Bt_[n][k], acc[ai][bj][m][n], 0, 0, 0); \
    __builtin_amdgcn_s_setprio(0); } while (0)
#define WAIT_V(n) asm volatile("s_waitcnt vmcnt(" #n ")" ::: "memory")
#define WAIT_L(n) asm volatile("s_waitcnt lgkmcnt(" #n ")" ::: "memory")
#define BAR __builtin_amdgcn_s_barrier()
#define SCHED __builtin_amdgcn_sched_barrier(0)
#pragma unroll
  for (int a = 0; a < 2; ++a)
#pragma unroll
    for (int b = 0; b < 2; ++b)
#pragma unroll
      for (int m = 0; m < 4; ++m)
#pragma unroll
        for (int n = 0; n < 2; ++n) acc[a][b][m][n] = f32x4{0.f, 0.f, 0.f, 0.f};
  bf16x8 At[4][2], B0[2][2], B1[2][2];
  constexpr int nt = NKT;
  WAIT_V(0);
  SCHED;
  STAGE(SB(0, 0), Bt, LDB, 0, 0, sofb); STAGE(SA(0, 0), A, LDA, 0, 0, sofa);
  STAGE(SB(0, 1), Bt, LDB, G_HALF, 0, sofb); STAGE(SA(0, 1), A, LDA, G_HALF, 0, sofa);
  if (wr == 1) BAR;
  WAIT_V(4); BAR;
  STAGE(SB(1, 0), Bt, LDB, 0, 1, sofb); STAGE(SA(1, 0), A, LDA, 0, 1, sofa); STAGE(SB(1, 1), Bt, LDB, G_HALF, 1, sofb);
  WAIT_V(6); BAR;
  for (int t = 0; t < nt - 2; t += 2) {
    LDB_(B0, 0, 0); SCHED; LDA_(At, 0, 0); STAGE(SA(1, 1), A, LDA, G_HALF, t + 1, sofa);
    WAIT_L(8); BAR; WAIT_L(0); MMA(0, 0, At, B0); BAR; SCHED;
    LDB_(B1, 0, 1); STAGE(SB(0, 0), Bt, LDB, 0, t + 2, sofb);
    BAR; WAIT_L(0); MMA(0, 1, At, B1); BAR;
    LDA_(At, 0, 1); STAGE(SA(0, 0), A, LDA, 0, t + 2, sofa);
    BAR; WAIT_L(0); MMA(1, 0, At, B0); BAR; SCHED;
    STAGE(SB(0, 1), Bt, LDB, G_HALF, t + 2, sofb);
    WAIT_V(6); BAR; MMA(1, 1, At, B1); BAR;
    LDB_(B0, 1, 0); SCHED; LDA_(At, 1, 0); STAGE(SA(0, 1), A, LDA, G_HALF, t + 2, sofa);
    WAIT_L(8); BAR; WAIT_L(0); MMA(0, 0, At, B0); BAR; SCHED;
    LDB_(B1, 1, 1); STAGE(SB(1, 0), Bt, LDB, 0, t + 3, sofb);
    BAR; WAIT_L(0); MMA(0, 1, At, B1); BAR;
    LDA_(At, 1, 1); STAGE(SA(1, 0), A, LDA, 0, t + 3, sofa);
    BAR; WAIT_L(0); MMA(1, 0, At, B0); BAR; SCHED;
    STAGE(SB(1, 1), Bt, LDB, G_HALF, t + 3, sofb);
    WAIT_V(6); BAR; MMA(1, 1, At, B1); BAR;
  }
  { LDB_(B0, 0, 0); LDA_(At, 0, 0); STAGE(SA(1, 1), A, LDA, G_HALF, nt - 1, sofa);
    BAR; WAIT_L(0); MMA(0, 0, At, B0); BAR;
    LDB_(B1, 0, 1); BAR; WAIT_L(0); MMA(0, 1, At, B1); BAR;
    LDA_(At, 0, 1); WAIT_V(4); BAR; WAIT_L(0); MMA(1, 0, At, B0); MMA(1, 1, At, B1); BAR; }
  { LDB_(B0, 1, 0); LDA_(At, 1, 0); WAIT_V(2); BAR; WAIT_L(0); MMA(0, 0, At, B0); BAR;
    LDB_(B1, 1, 1); WAIT_V(0); BAR; WAIT_L(0); MMA(0, 1, At, B1); BAR;
    LDA_(At, 1, 1); BAR; WAIT_L(0); MMA(1, 0, At, B0); MMA(1, 1, At, B1); BAR; }
  if (wr == 0) BAR;
#undef SA
#undef SB
#undef STAGE
#undef LDA_
#undef LDB_
#undef MMA
#undef WAIT_V
#undef WAIT_L
#undef BAR
#undef SCHED
}

DI int sched_tile(int it, int MT, int NT, int& mt, int& nt) {
  const int G = gridDim.x, b = blockIdx.x;
  const int per = G >> 3, pm = per >> 2;
  if ((G & 31) == 0 && pm > 0 && (MT % pm) == 0) {
    const int x = g_sched[0], j = g_sched[1];
    const int nsn = (NT + 3) >> 2, nsm = MT / pm;
    const int st = it * 8 + x;
    if (st >= nsm * nsn) return -1;
    const int sm = st / nsn, sn = st - sm * nsn;
    mt = sm * pm + (j % pm); nt = sn * 4 + (j / pm);
    return nt < NT ? 1 : 0;
  } else {
    const int tile = it * G + b;
    if (tile >= MT * NT) return -1;
    nt = tile % NT; mt = tile / NT;
    return 1;
  }
}

#define EPI_IDS const int tid = otid(), lane = tid & 63, wid = owid(tid), wr = wid >> 2, wc = wid & 3, fr = lane & 15, fq = lane >> 4; (void)wr; (void)wc; (void)fr; (void)fq;
#define LROW(ai, m, j) ((ai) * 128 + (m) * 16 + (j))
#define LCOL(bj, n) ((bj) * 128 + (n) * 16)
#define EPI_FOR _Pragma("unroll") for (int ai = 0; ai < 2; ++ai) _Pragma("unroll") for (int bj = 0; bj < 2; ++bj) \
    _Pragma("unroll") for (int m = 0; m < 4; ++m) _Pragma("unroll") for (int n = 0; n < 2; ++n) _Pragma("unroll") for (int j = 0; j < 4; ++j)

DI void phase_ffn_gu(const Params& p, size_t woff, char* smem) {
  const bf16_t* H = (const bf16_t*)(p.ws + OFF_H);
  const bf16_t* W = (const bf16_t*)(p.ws + OFF_WB) + woff;
  bf16_t* U = (bf16_t*)(p.ws + OFF_PA);
  for (int it = 0;; ++it) {
    int mt, nt; int s = sched_tile(it, 128, 22, mt, nt);
    if (s < 0) break; if (s == 0) continue;
    acc8p_t acc;
    gemm8p<D_, D_, 16>(H + (size_t)mt * 256 * D_, W + (size_t)nt * 256 * D_, smem, acc);
    EPI_IDS
    bf16_t* tp = U + (size_t)(mt * 256) * FF + nt * 128;
    const unsigned loff = (unsigned)((wr * 64 + fq * 4) * FF + wc * 32 + fr);
#pragma unroll
    for (int ai = 0; ai < 2; ++ai)
#pragma unroll
      for (int m = 0; m < 4; ++m)
#pragma unroll
        for (int n = 0; n < 2; ++n)
#pragma unroll
          for (int j = 0; j < 4; ++j) {
            float gv = acc[ai][0][m][n][j], uv = acc[ai][1][m][n][j];
            float sv = gv * frcp(1.f + fexp2(-LOG2E * gv)) * uv;
            (tp + LROW(ai, m, j) * FF + n * 16)[loff] = (bf16_t)f2bf(sv);
          }
  }
}

DI void phase_ffn_down(const Params& p, size_t woff, const float* res, char* smem) {
  const bf16_t* U = (const bf16_t*)(p.ws + OFF_PA);
  const bf16_t* W = (const bf16_t*)(p.ws + OFF_WB) + woff;
  float* out = p.out;
  for (int it = 0;; ++it) {
    int mt, nt; int s = sched_tile(it, 128, 4, mt, nt);
    if (s < 0) break; if (s == 0) continue;
    acc8p_t acc;
    gemm8p<FF, FF, 44>(U + (size_t)mt * 256 * FF, W + (size_t)nt * 256 * FF, smem, acc);
    EPI_IDS
    const size_t tb = (size_t)(mt * 256) * D_ + nt * 256;
    float* tp = out + tb; const float* rsp = res + tb;
    const unsigned loff = (unsigned)((wr * 64 + fq * 4) * D_ + wc * 32 + fr);
    EPI_FOR {
      const int ro = LROW(ai, m, j) * D_ + LCOL(bj, n);
      (tp + ro)[loff] = (rsp + ro)[loff] + 0.5f * acc[ai][bj][m][n][j];
    }
  }
}

DI void phase_win(const Params& p, char* smem) {
  const bf16_t* H = (const bf16_t*)(p.ws + OFF_H);
  const bf16_t* W = (const bf16_t*)(p.ws + OFF_WB) + WIN;
  bf16_t* PA = (bf16_t*)(p.ws + OFF_PA);
  bf16_t* VT = (bf16_t*)(p.ws + OFF_VT);
  bf16_t* GT = (bf16_t*)(p.ws + OFF_GATES);
  float* WI = (float*)(p.ws + OFF_WIDX);
  for (int it = 0;; ++it) {
    int mt, nt; int s = sched_tile(it, 128, 17, mt, nt);
    if (s < 0) break; if (s == 0) continue;
    acc8p_t acc;
    gemm8p<D_, D_, 16>(H + (size_t)mt * 256 * D_, W + (size_t)nt * 256 * D_, smem, acc);
    EPI_IDS
    if (nt < 6) {
      bf16_t* tp = PA + (size_t)(mt * 256) * PA_LD + nt * 256;
      const unsigned loff = (unsigned)((wr * 64 + fq * 4) * PA_LD + wc * 32 + fr);
      const float qsc = (nt == 2 || nt == 3) ? 0.125f * LOG2E : 1.f;
      EPI_FOR {
        const int ro = LROW(ai, m, j) * PA_LD + LCOL(bj, n);
        (tp + ro)[loff] = (bf16_t)f2bf(acc[ai][bj][m][n][j] * qsc);
      }
    } else if (nt < 8) {
      const int b = mt >> 4;
#pragma unroll
      for (int ai = 0; ai < 2; ++ai)
#pragma unroll
        for (int bj = 0; bj < 2; ++bj)
#pragma unroll
          for (int m = 0; m < 4; ++m)
#pragma unroll
            for (int n = 0; n < 2; ++n) {
              int c = (nt - 6) * 256 + bj * 128 + wc * 32 + n * 16 + fr;
              int h = c >> 6, d = c & 63;
              int tok = mt * 256 + ai * 128 + wr * 64 + m * 16 + fq * 4;
              bf16_t* dst = VT + ((size_t)(b * 8 + h) * 64 + d) * S_ + (tok & (S_ - 1));
              u32x2 w; w[0] = pack2(acc[ai][bj][m][n][0], acc[ai][bj][m][n][1]); w[1] = pack2(acc[ai][bj][m][n][2], acc[ai][bj][m][n][3]);
              *(u32x2*)dst = w;
            }
    } else if (nt < 16) {
      bf16_t* tp = GT + (size_t)(mt * 256) * 2048 + (nt - 8) * 256;
      const unsigned loff = (unsigned)((wr * 64 + fq * 4) * 2048 + wc * 32 + fr);
      EPI_FOR {
        const int ro = LROW(ai, m, j) * 2048 + LCOL(bj, n);
        float v = acc[ai][bj][m][n][j];
        float sg = frcp(1.f + fexp2(-LOG2E * v));
        (tp + ro)[loff] = (bf16_t)f2bf(sg);
      }
    } else {
      if (wc == 0 && fr < 8) {
#pragma unroll
        for (int ai = 0; ai < 2; ++ai)
#pragma unroll
          for (int m = 0; m < 4; ++m)
#pragma unroll
            for (int j = 0; j < 4; ++j) {
              int row = mt * 256 + ai * 128 + wr * 64 + m * 16 + fq * 4 + j;
              WI[(size_t)row * 8 + fr] = acc[ai][0][m][0][j] * 0.04419417382415922f;
            }
      }
    }
  }
}

DI void phase_qproj(const Params& p, char* smem) {
  bf16_t* PA = (bf16_t*)(p.ws + OFF_PA);
  const bf16_t* W = (const bf16_t*)(p.ws + OFF_WB) + WQ;
  bf16_t* QA = (bf16_t*)(p.ws + OFF_H);
  bf16_t* QI = QA + (size_t)T_ * 512;
  const float2* ROPE = (const float2*)(p.ws + OFF_ROPE);
  float* rstd = (float*)(smem + 131072);
  for (int it = 0;; ++it) {
    int mt, nt; int s = sched_tile(it, 128, 4, mt, nt);
    if (s < 0) break; if (s == 0) continue;
    {
      const int tq = otid(); int row = tq >> 1, half = tq & 1;
      const bf16_t* src = PA + (size_t)(mt * 256 + row) * PA_LD + half * 128;
      float ss = 0.f;
#pragma unroll 4
      for (int i = 0; i < 16; ++i) {
        u32x4 v = *(const u32x4*)(src + i * 8);
#pragma unroll
        for (int j = 0; j < 4; ++j) { float a = bflo(v[j]), b = bfhi(v[j]); ss += a * a + b * b; }
      }
      ss += __shfl_xor(ss, 1);
      if (half == 0) rstd[row] = rsqrtf(ss * (1.f / 256.f) + EPS);
    }
    acc8p_t acc;
    gemm8p<PA_LD, 256, 4>(PA + (size_t)mt * 256 * PA_LD, W + (size_t)nt * 256 * 256, smem, acc);
    EPI_IDS
    const int head = (nt & 1) * 4 + wc;
    bf16_t* dtp = (nt < 2 ? QA : QI) + (size_t)(mt * 256) * 512 + head * 64;
    const float2* rtp = ROPE + (size_t)(mt * 256) * 32;
    const unsigned doff = (unsigned)((wr * 64 + fq * 4) * 512 + fr);
    const unsigned roff = (unsigned)((wr * 64 + fq * 4) * 32 + fr);
    const float* rsl = rstd + wr * 64 + fq * 4;
    float ga[4] = {1.f, 1.f, 1.f, 1.f};
    const bool do_norm = nt < 2;
    if (do_norm) { ga[0] = p.g_qa[fr]; ga[1] = p.g_qa[16 + fr]; ga[2] = p.g_qa[32 + fr]; ga[3] = p.g_qa[48 + fr]; }
#pragma unroll
    for (int ai = 0; ai < 2; ++ai)
#pragma unroll
      for (int m = 0; m < 4; ++m)
#pragma unroll
        for (int j = 0; j < 4; ++j) {
          const int lr = LROW(ai, m, j);
          const float rs = rsl[lr];
          float x0 = acc[ai][0][m][0][j] * rs, x1 = acc[ai][0][m][1][j] * rs;
          float y0 = acc[ai][1][m][0][j] * rs, y1 = acc[ai][1][m][1][j] * rs;
          if (do_norm) {
            float ss = x0 * x0 + x1 * x1 + y0 * y0 + y1 * y1;
#pragma unroll
            for (int o = 8; o > 0; o >>= 1) ss += __shfl_xor(ss, o);
            const float r2 = rsqrtf(ss * (1.f / 64.f) + EPS);
            x0 *= r2 * ga[0]; x1 *= r2 * ga[1]; y0 *= r2 * ga[2]; y1 *= r2 * ga[3];
          }
          const float2 c0 = (rtp + lr * 32)[roff], c1 = (rtp + lr * 32 + 16)[roff];
          bf16_t* dp = dtp + lr * 512;
          (dp)[doff] = (bf16_t)f2bf(x0 * c0.x - y0 * c0.y);
          (dp + 32)[doff] = (bf16_t)f2bf(x0 * c0.y + y0 * c0.x);
          (dp + 16)[doff] = (bf16_t)f2bf(x1 * c1.x - y1 * c1.y);
          (dp + 48)[doff] = (bf16_t)f2bf(x1 * c1.y + y1 * c1.x);
          if (j == 3) __builtin_amdgcn_sched_barrier(0);
        }
    __syncthreads();
  }
  const int tid = otid(), lane = tid & 63, wid = owid(tid);
  for (int it = blockIdx.x; it < T_ / 256; it += gridDim.x) {
    const int d = lane & 31; const bool isidx = lane >= 32;
    const float g0 = isidx ? 1.f : p.g_ka[d], g1 = isidx ? 1.f : p.g_ka[d + 32];
    for (int i = 0; i < 32; ++i) {
      int tok = it * 256 + wid * 32 + i;
      bf16_t* src = PA + (size_t)tok * PA_LD + (isidx ? PA_KI : PA_KA);
      float v0 = bf2f(src[d]), v1 = bf2f(src[d + 32]);
      float ss = v0 * v0 + v1 * v1;
#pragma unroll
      for (int o = 16; o > 0; o >>= 1) ss += __shfl_xor(ss, o);
      if (!isidx) { float r2 = rsqrtf(ss * (1.f / 64.f) + EPS); v0 *= r2 * g0; v1 *= r2 * g1; }
      float2 cs = ROPE[(size_t)tok * 32 + d];
      float o0 = v0 * cs.x - v1 * cs.y, o1 = v0 * cs.y + v1 * cs.x;
      src[d] = (bf16_t)f2bf(o0); src[d + 32] = (bf16_t)f2bf(o1);
    }
  }
}

DI f32x16 sb_qk(const char* cur, int sub, int r, int g, int sw, const bf16x8 (&qf)[4]) {
  f32x16 z;
#pragma unroll
  for (int i = 0; i < 16; ++i) z[i] = 0.f;
#pragma unroll
  for (int ks = 0; ks < 4; ++ks) {
    bf16x8 kf = ld_frag_s(cur + (sub * 32 + r) * 128 + (((ks * 2 + g) ^ sw) << 4));
    z = MFMA32(kf, qf[ks], z);
  }
  return z;
}
template <bool DIAG>
DI void sb_elem(const f32x16& z, int r, int g, float& R, bf16x8& pf0, bf16x8& pf1) {
  float e[16], rr[16];
#pragma unroll
  for (int i = 0; i < 16; ++i) {
    float z2 = fminf(z[i], 80.f);
    float ev = fexp2(z2);
    float rv_ = frcp(1.f + ev);
    if (DIAG && !(crow(i, g) < r)) { ev = 0.f; rv_ = 1.f; }
    e[i] = ev; rr[i] = rv_;
  }
  float G[4], Gp[4];
#pragma unroll
  for (int q = 0; q < 4; ++q) {
    rr[4 * q + 2] *= rr[4 * q + 3];
    rr[4 * q + 1] *= rr[4 * q + 2];
    rr[4 * q + 0] *= rr[4 * q + 1];
    G[q] = rr[4 * q];
  }
#pragma unroll
  for (int q = 0; q < 4; ++q) Gp[q] = __shfl_xor(G[q], 32);
  float SO[4], SP[4];
  SO[3] = 1.f; SO[2] = G[3]; SO[1] = G[2] * G[3]; SO[0] = G[1] * SO[1];
  SP[3] = 1.f; SP[2] = Gp[3]; SP[1] = Gp[2] * Gp[3]; SP[0] = Gp[1] * SP[1];
  float a[16];
#pragma unroll
  for (int q = 0; q < 4; ++q) {
    float part = g == 0 ? SP[q] * Gp[q] : SP[q];
    float E = SO[q] * part * R;
#pragma unroll
    for (int j = 0; j < 4; ++j) a[4 * q + j] = e[4 * q + j] * rr[4 * q + j] * E;
  }
  R = R * (SO[0] * G[0]) * (SP[0] * Gp[0]);
  u32x4 pw0, pw1;
#pragma unroll
  for (int j = 0; j < 4; ++j) { pw0[j] = pack2(a[2 * j], a[2 * j + 1]); pw1[j] = pack2(a[8 + 2 * j], a[8 + 2 * j + 1]); }
  pf0 = __builtin_bit_cast(bf16x8, pw0); pf1 = __builtin_bit_cast(bf16x8, pw1);
}
DI void sb_pv(const char* cur, int sub, int r, int g, const bf16x8& pf0, const bf16x8& pf1, f32x16& o0, f32x16& o1) {
#pragma unroll
  for (int ks2 = 0; ks2 < 2; ++ks2) {
    const bf16x8 pf = ks2 == 0 ? pf0 : pf1;
#pragma unroll
    for (int dt = 0; dt < 2; ++dt) {
      const char* vp = cur + 8192 + (dt * 32 + r) * 136 + (sub * 32 + 16 * ks2 + 4 * g) * 2;
      u32x2 lo = *(const u32x2*)vp, hi = *(const u32x2*)(vp + 16);
      u32x4 vv; vv[0] = lo[0]; vv[1] = lo[1]; vv[2] = hi[0]; vv[3] = hi[1];
      bf16x8 vf = __builtin_bit_cast(bf16x8, vv);
      if (dt == 0) o0 = MFMA32(vf, pf, o0); else o1 = MFMA32(vf, pf, o1);
    }
  }
}

template <bool DUMMY>
DI void sb_item(const Params& p, int b, int h, int qb, char* smem) {
  bf16_t* PA = (bf16_t*)(p.ws + OFF_PA);
  const bf16_t* VT = (const bf16_t*)(p.ws + OFF_VT) + (size_t)(b * 8 + h) * 64 * S_;
  const int tid = otid(), lane = tid & 63, wid = owid(tid), g = lane >> 5, r = lane & 31;
  const int tw = qb * 256 + wid * 32;
  constexpr int BUFSZ = 8192 + 8704;
  bf16x8 qf[4];
  {
    const bf16_t* qp = PA + (size_t)(b * S_ + tw + r) * PA_LD + PA_QB + h * 64 + g * 8;
#pragma unroll
    for (int ks = 0; ks < 4; ++ks) qf[ks] = ld_frag_g(qp + ks * 16);
  }
  const int srow = tid >> 3, sch = tid & 7;
  const bf16_t* gk = PA + (size_t)(b * S_ + srow) * PA_LD + PA_KB + h * 64 + sch * 8;
  const bf16_t* gv = VT + (size_t)srow * S_ + sch * 8;
  const unsigned k_st = srow * 128 + ((sch ^ ((srow >> 1) & 7)) << 4);
  const unsigned v_st = 8192 + srow * 136 + sch * 16;
  const int sw = (lane >> 1) & 7;
  f32x16 o0, o1;
#pragma unroll
  for (int i = 0; i < 16; ++i) { o0[i] = 0.f; o1[i] = 0.f; }
  float R = 1.f;
  const int nkt = 4 * qb + 4;
  u32x4 rk, rv;
  {
    int kt = nkt - 1;
    rk = *(const u32x4*)(gk + (size_t)(kt * 64) * PA_LD); rv = *(const u32x4*)(gv + kt * 64);
    char* cur = smem + (kt & 1) * BUFSZ;
    *(u32x4*)(cur + k_st) = rk;
    u32x2 lo, hi; lo[0] = rv[0]; lo[1] = rv[1]; hi[0] = rv[2]; hi[1] = rv[3];
    *(u32x2*)(cur + v_st) = lo; *(u32x2*)(cur + v_st + 8) = hi;
  }
  __syncthreads();
  for (int kt = nkt - 1; kt >= 0; --kt) {
    const char* cur = smem + (kt & 1) * BUFSZ;
    char* nxt = smem + ((kt + 1) & 1) * BUFSZ;
    const bool more = kt > 0;
    if (more) { rk = *(const u32x4*)(gk + (size_t)((kt - 1) * 64) * PA_LD); rv = *(const u32x4*)(gv + (kt - 1) * 64); }
    __builtin_amdgcn_sched_barrier(0);
    if (kt * 64 + 32 < tw) {
      const f32x16 z1 = sb_qk(cur, 1, r, g, sw, qf);
      const f32x16 z0 = sb_qk(cur, 0, r, g, sw, qf);
      bf16x8 p1a, p1b, p0a, p0b;
      sb_elem<false>(z1, r, g, R, p1a, p1b);
      sb_pv(cur, 1, r, g, p1a, p1b, o0, o1);
      sb_elem<false>(z0, r, g, R, p0a, p0b);
      sb_pv(cur, 0, r, g, p0a, p0b, o0, o1);
    } else {
#pragma unroll
      for (int sub = 1; sub >= 0; --sub) {
        const int sbase = kt * 64 + sub * 32;
        if (sbase <= tw) {
          const f32x16 z = sb_qk(cur, sub, r, g, sw, qf);
          bf16x8 pa, pb;
          if (sbase == tw) sb_elem<true>(z, r, g, R, pa, pb); else sb_elem<false>(z, r, g, R, pa, pb);
          sb_pv(cur, sub, r, g, pa, pb, o0, o1);
        }
      }
    }
    __builtin_amdgcn_sched_barrier(0);
    if (more) {
      *(u32x4*)(nxt + k_st) = rk;
      u32x2 lo, hi; lo[0] = rv[0]; lo[1] = rv[1]; hi[0] = rv[2]; hi[1] = rv[3];
      *(u32x2*)(nxt + v_st) = lo; *(u32x2*)(nxt + v_st + 8) = hi;
    }
    __syncthreads();
  }
  bf16_t* yp = DUMMY ? (bf16_t*)(p.ws + OFF_SLAB) + (size_t)(b * S_ + tw + r) * 512 + h * 64 : PA + (size_t)(b * S_ + tw + r) * PA_LD + PA_QB + h * 64;
#pragma unroll
  for (int rq = 0; rq < 4; ++rq) {
    u32x2 w0, w1;
    w0[0] = pack2(o0[4 * rq], o0[4 * rq + 1]); w0[1] = pack2(o0[4 * rq + 2], o0[4 * rq + 3]);
    w1[0] = pack2(o1[4 * rq], o1[4 * rq + 1]); w1[1] = pack2(o1[4 * rq + 2], o1[4 * rq + 3]);
    *(u32x2*)(yp + 8 * rq + 4 * g) = w0;
    *(u32x2*)(yp + 32 + 8 * rq + 4 * g) = w1;
  }
}

DI unsigned tokey(float f) { unsigned u = __float_as_uint(f); return (u & 0x80000000u) ? ~u : (u | 0x80000000u); }
DI int wave_count_sum(int c) {
  int tot = 0;
#pragma unroll
  for (int bt = 0; bt < 7; ++bt) tot += __builtin_popcountll(__ballot((c >> bt) & 1)) << bt;
  return tot;
}

DI void idx_item(const Params& p, int b, int qt, char* smem) {
  bf16_t* PA = (bf16_t*)(p.ws + OFF_PA);
  const bf16_t* QI = (const bf16_t*)(p.ws + OFF_H) + (size_t)T_ * 512;
  const float* WI = (const float*)(p.ws + OFF_WIDX);
  float* slab = (float*)(p.ws + OFF_SLAB) + (size_t)blockIdx.x * 16 * 4096;
  const int tid = otid(), lane = tid & 63, wid = owid(tid), g4 = lane >> 4, r = lane & 15;
  const int t0 = qt * 16;
  {
    bf16x8 qf[8][2]; float w[8];
    const bf16_t* qp = QI + (size_t)(b * S_ + t0 + r) * 512 + g4 * 8;
#pragma unroll
    for (int hh = 0; hh < 8; ++hh) { qf[hh][0] = ld_frag_g(qp + hh * 64); qf[hh][1] = ld_frag_g(qp + hh * 64 + 32); }
    {
      const float4* wp = (const float4*)(WI + (size_t)(b * S_ + t0 + r) * 8);
      float4 wa = wp[0], wb = wp[1];
      w[0] = wa.x; w[1] = wa.y; w[2] = wa.z; w[3] = wa.w; w[4] = wb.x; w[5] = wb.y; w[6] = wb.z; w[7] = wb.w;
    }
    const int nkt = qt + 1;
    const bf16_t* kbase = PA + (size_t)(b * S_ + r) * PA_LD + PA_KI + g4 * 8;
    bf16x8 k0, k1;
    {
      int kt = wid < nkt ? wid : 0;
      const bf16_t* kp = kbase + (size_t)(kt * 16) * PA_LD;
      k0 = ld_frag_g(kp); k1 = ld_frag_g(kp + 32);
    }
    for (int kt = wid; kt < nkt; kt += NWAVE) {
      bf16x8 n0, n1;
      {
        int kn = kt + NWAVE < nkt ? kt + NWAVE : kt;
        const bf16_t* kp = kbase + (size_t)(kn * 16) * PA_LD;
        n0 = ld_frag_g(kp); n1 = ld_frag_g(kp + 32);
      }
      f32x4 sc = {0.f, 0.f, 0.f, 0.f};
#pragma unroll
      for (int hh = 0; hh < 8; ++hh) {
        f32x4 c = {0.f, 0.f, 0.f, 0.f};
        c = MFMA16(k0, qf[hh][0], c);
        c = MFMA16(k1, qf[hh][1], c);
#pragma unroll
        for (int i = 0; i < 4; ++i) sc[i] += w[hh] * fmaxf(c[i], 0.f);
      }
      *(f32x4*)(slab + (size_t)r * 4096 + kt * 16 + 4 * g4) = sc;
      k0 = n0; k1 = n1;
    }
  }
  __syncthreads();
  for (int qi = 0; qi < 2; ++qi) {
    const int q = wid * 2 + qi;
    const int t = t0 + q, n = t + 1;
    unsigned short* out = (unsigned short*)(PA + (size_t)(b * S_ + t) * PA_LD);
    if (n <= 256) {
#pragma unroll
      for (int j = 0; j < 4; ++j) { int e = j * 64 + lane; out[e] = (unsigned short)(e < n ? e : 0); }
      continue;
    }
    const float* row = slab + (size_t)q * 4096 + lane;
    const int nj = (n + 63) >> 6;
    unsigned key[64];
#pragma unroll
    for (int ch = 0; ch < 4; ++ch) {
#pragma unroll
      for (int jj = 0; jj < 16; ++jj) key[ch * 16 + jj] = 0u;
      if (nj > ch * 16) {
#pragma unroll
        for (int jj = 0; jj < 16; ++jj) { const int j = ch * 16 + jj; if (j * 64 + lane < n) key[j] = tokey(row[j * 64]); }
      }
    }
    unsigned Tthr = 0u; int need = 0; bool exact = false;
    for (int bit = 31; bit >= 0; --bit) {
      const unsigned cand = Tthr | (1u << bit);
      int c = 0;
#pragma unroll
      for (int ch = 0; ch < 4; ++ch) {
        if (nj > ch * 16) {
#pragma unroll
          for (int jj = 0; jj < 16; ++jj) c += (key[ch * 16 + jj] >= cand) ? 1 : 0;
        }
      }
      const int cnt = wave_count_sum(c);
      if (cnt >= 256) Tthr = cand;
      if (cnt == 256) { exact = true; break; }
    }
    unsigned Tgt;
    if (exact) { Tgt = Tthr - 1u; need = 0; }
    else {
      int c = 0;
#pragma unroll
      for (int j = 0; j < 64; ++j) c += (key[j] > Tthr) ? 1 : 0;
      Tgt = Tthr; need = 256 - wave_count_sum(c);
    }
    const unsigned long long lt_mask = (1ull << lane) - 1ull;
    int base = 0, ties = 0;
#pragma unroll
    for (int j = 0; j < 64; ++j) {
      if (j < nj) {
        const bool gt = key[j] > Tgt;
        const bool eq = (!exact) && (key[j] == Tthr);
        const unsigned long long meq = __ballot(eq);
        const int myrank = ties + __builtin_popcountll(meq & lt_mask);
        const bool sel = gt || (eq && myrank < need);
        ties += __builtin_popcountll(meq);
        const unsigned long long ms = __ballot(sel);
        const int pos = base + __builtin_popcountll(ms & lt_mask);
        if (sel && pos < 256) out[pos] = (unsigned short)(j * 64 + lane);
        base += __builtin_popcountll(ms);
      }
    }
  }
  __syncthreads();
}

DI void phase_sb_dummy(const Params& p, char* smem) {
  unsigned* cnt = (unsigned*)(p.ws + OFF_CNT) + 16;
  int* s_item = (int*)(smem + SMEM_BYTES - 16);
  while (true) {
    if (otid() == 0) *s_item = (int)atomicAdd(cnt, 1u);
    __syncthreads();
    const int item = *s_item;
    __syncthreads();
    if (item >= 64 * 16) break;
    int qb = 15 - (item >> 6), bh = item & 63;
    sb_item<true>(p, bh >> 3, bh & 7, qb, smem);
  }
}

template <bool IDX_ONLY>
DI void phase_mix(const Params& p, char* smem) {
  unsigned* cnt = (unsigned*)(p.ws + OFF_CNT) + (IDX_ONLY ? 8 : 0);
  int* s_item = (int*)(smem + SMEM_BYTES - 16);
  constexpr int NSB = 64 * 16, NIDX = 8 * 256;
  while (true) {
    if (otid() == 0) *s_item = (int)atomicAdd(cnt, 1u);
    __syncthreads();
    const int item = *s_item;
    __syncthreads();
    if (IDX_ONLY) { if (item >= NIDX) break; int qt = 255 - (item >> 3), b = item & 7; idx_item(p, b, qt, smem); continue; }
    if (item >= NSB + NIDX) break;
    if (item < NSB) {
      int qb = 15 - (item >> 6), bh = item & 63;
      sb_item<false>(p, bh >> 3, bh & 7, qb, smem);
    } else {
      int j = item - NSB;
      int qt = 255 - (j >> 3), b = j & 7;
      idx_item(p, b, qt, smem);
    }
  }
}

DI void phase_sparse(const Params& p, char* smem) {
  const bf16_t* PA = (const bf16_t*)(p.ws + OFF_PA);
  const bf16_t* QA = (const bf16_t*)(p.ws + OFF_H);
  bf16_t* YA = (bf16_t*)(p.ws + OFF_SLAB + (size_t)64 * 1024 * 1024);
  const bf16_t* WUVb = (const bf16_t*)(p.ws + OFF_WB) + WUV;
  const int tid = otid(), lane = tid & 63, wid = owid(tid), g4 = lane >> 4, c = lane & 15;
  float* Pl = (float*)(smem + wid * 9280);
  int* Il = (int*)(smem + wid * 9280 + 8192);
  float* Sl = (float*)(smem + wid * 9280 + 9216);
  float* Pq = Pl + g4 * 32 + c;
  char* OL = smem + 8 * 9280;
  const float sc2 = 0.125f * LOG2E;
  for (int it = blockIdx.x; it < T_ / 16; it += gridDim.x) {
    const int tok0 = it * 16;
    const int b = tok0 >> 12;
    for (int qi = 0; qi < 2; ++qi) {
      const int q = wid * 2 + qi;
      const int tok = tok0 + q, t = tok & (S_ - 1);
      const int nsel = t + 1 < 256 ? t + 1 : 256;
      const unsigned short* irow = (const unsigned short*)(PA + (size_t)tok * PA_LD);
#pragma unroll
      for (int j = 0; j < 4; ++j) { int e = j * 64 + lane; int v = irow[e]; Il[e] = e < nsel ? v : 0; }
      __syncthreads();
      bf16x8 qf0, qf1;
      {
        u32x4 z4 = {0u, 0u, 0u, 0u};
        qf0 = __builtin_bit_cast(bf16x8, z4); qf1 = qf0;
        if (c < 8) { const bf16_t* qp = QA + (size_t)tok * 512 + c * 64 + g4 * 8; qf0 = ld_frag_g(qp); qf1 = ld_frag_g(qp + 32); }
      }
      float m = -INFINITY;
#pragma unroll
      for (int kg = 0; kg < 4; ++kg) {
        bf16x8 ka[4][2];
#pragma unroll
        for (int k4 = 0; k4 < 4; ++k4) {
          int key = (Il + c)[(kg * 4 + k4) * 16];
          const bf16_t* kp = PA + (size_t)(b * S_ + key) * PA_LD + PA_KA + g4 * 8;
          ka[k4][0] = ld_frag_g(kp); ka[k4][1] = ld_frag_g(kp + 32);
        }
#pragma unroll
        for (int k4 = 0; k4 < 4; ++k4) {
          f32x4 cc = {0.f, 0.f, 0.f, 0.f};
          cc = MFMA16(ka[k4][0], qf0, cc);
          cc = MFMA16(ka[k4][1], qf1, cc);
#pragma unroll
          for (int i = 0; i < 4; ++i) {
            const int ec = (kg * 4 + k4) * 16 + i;
            float v = ec + 4 * g4 < nsel ? cc[i] : -INFINITY;
            m = fmaxf(m, v);
            if (c < 8) Pq[ec * 8] = v;
          }
        }
      }
      m = fmaxf(m, __shfl_xor(m, 16)); m = fmaxf(m, __shfl_xor(m, 32));
      float sum = 0.f;
      if (c < 8) {
#pragma unroll 4
        for (int kt = 0; kt < 16; ++kt)
#pragma unroll
          for (int i = 0; i < 4; ++i) {
            const int ec = kt * 16 + i;
            float pv = fexp2((Pq[ec * 8] - m) * sc2);
            Pq[ec * 8] = pv; sum += pv;
          }
      }
      sum += __shfl_xor(sum, 16); sum += __shfl_xor(sum, 32);
      if (lane < 8) Sl[lane] = 1.f / sum;
      __syncthreads();
      f32x2_t acc[8];
#pragma unroll
      for (int hh = 0; hh < 8; ++hh) acc[hh] = f32x2_t{0.f, 0.f};
      const bf16_t* vbase = PA + (size_t)b * S_ * PA_LD + PA_VA + 2 * lane;
      const int nk16 = (nsel + 15) & ~15;
      for (int k0 = 0; k0 < nk16; k0 += 16) {
        unsigned vv[16];
#pragma unroll
        for (int kk = 0; kk < 16; ++kk) {
          int key = __builtin_amdgcn_readfirstlane(Il[k0 + kk]);
          vv[kk] = *(const unsigned*)(vbase + (size_t)key * PA_LD);
        }
#pragma unroll
        for (int kk = 0; kk < 16; ++kk) {
          const f32x4 pa = *(const f32x4*)(Pl + (k0 + kk) * 8), pb = *(const f32x4*)(Pl + (k0 + kk) * 8 + 4);
          const f32x2_t v2 = {bflo(vv[kk]), bfhi(vv[kk])};
#pragma unroll
          for (int hh = 0; hh < 4; ++hh) { acc[hh] += pa[hh] * v2; acc[hh + 4] += pb[hh] * v2; }
        }
      }
#pragma unroll
      for (int hh = 0; hh < 8; ++hh) { const float iv = Sl[hh]; *(unsigned*)(OL + q * 2064 + hh * 256 + lane * 4) = pack2(acc[hh][0] * iv, acc[hh][1] * iv); }
      __syncthreads();
    }
    {
      const int h = wid;
      bf16x8 af[4];
#pragma unroll
      for (int ks = 0; ks < 4; ++ks) af[ks] = ld_frag_s(OL + c * 2064 + h * 256 + (ks * 32 + g4 * 8) * 2);
#pragma nounroll
      for (int nt = 0; nt < 4; ++nt) {
        f32x4 cc = {0.f, 0.f, 0.f, 0.f};
        const bf16_t* wp = WUVb + (size_t)(h * 64 + nt * 16 + c) * 128 + g4 * 8;
#pragma unroll
        for (int ks = 0; ks < 4; ++ks) cc = MFMA16(af[ks], ld_frag_g(wp + ks * 32), cc);
#pragma unroll
        for (int i = 0; i < 4; ++i) YA[(size_t)(tok0 + 4 * g4 + i) * 512 + h * 64 + nt * 16 + c] = (bf16_t)f2bf(cc[i]);
      }
    }
    __syncthreads();
  }
}

DI void phase_merge(const Params& p, char* smem) {
  const bf16_t* YA = (const bf16_t*)(p.ws + OFF_SLAB + (size_t)64 * 1024 * 1024);
  const bf16_t* YB = (const bf16_t*)(p.ws + OFF_PA) + PA_QB;
  const bf16_t* Wa = (const bf16_t*)(p.ws + OFF_WB) + WOA;
  const bf16_t* Wb = (const bf16_t*)(p.ws + OFF_WB) + WOB;
  const bf16_t* GT = (const bf16_t*)(p.ws + OFF_GATES);
  bf16_t* MG = (bf16_t*)(p.ws + OFF_SLAB);
  for (int it = 0;; ++it) {
    int mt, nt; int s = sched_tile(it, 128, 4, mt, nt);
    if (s < 0) break; if (s == 0) continue;
    acc8p_t acc;
    gemm8p<512, 512, 8>(YA + (size_t)mt * 256 * 512, Wa + (size_t)nt * 256 * 512, smem, acc);
    EPI_IDS
    const unsigned goff = (unsigned)((wr * 64 + fq * 4) * 2048 + wc * 32 + fr);
    const unsigned loff = (unsigned)((wr * 64 + fq * 4) * D_ + wc * 32 + fr);
    const bf16_t* gp = GT + (size_t)(mt * 256) * 2048 + nt * 256;
    bf16_t* tp = MG + (size_t)(mt * 256) * D_ + nt * 256;
    EPI_FOR {
      const int lr = LROW(ai, m, j), lc = LCOL(bj, n);
      float ga = bf2f((gp + lr * 2048 + lc)[goff]);
      (tp + lr * D_ + lc)[loff] = (bf16_t)f2bf(ga * acc[ai][bj][m][n][j]);
    }
  }
  for (int it = 0;; ++it) {
    int mt, nt; int s = sched_tile(it, 128, 4, mt, nt);
    if (s < 0) break; if (s == 0) continue;
    acc8p_t acc;
    gemm8p<PA_LD, 512, 8>(YB + (size_t)mt * 256 * PA_LD, Wb + (size_t)nt * 256 * 512, smem, acc);
    EPI_IDS
    const unsigned goff = (unsigned)((wr * 64 + fq * 4) * 2048 + wc * 32 + fr);
    const unsigned loff = (unsigned)((wr * 64 + fq * 4) * D_ + wc * 32 + fr);
    const bf16_t* gp = GT + (size_t)(mt * 256) * 2048 + 1024 + nt * 256;
    bf16_t* tp = MG + (size_t)(mt * 256) * D_ + nt * 256;
    EPI_FOR {
      const int lr = LROW(ai, m, j), lc = LCOL(bj, n);
      float gb = bf2f((gp + lr * 2048 + lc)[goff]);
      bf16_t* e = (tp + lr * D_ + lc) + loff;
      *e = (bf16_t)f2bf(bf2f(*e) + gb * acc[ai][bj][m][n][j]);
    }
  }
}

DI void phase_outproj(const Params& p, char* smem) {
  const bf16_t* MG = (const bf16_t*)(p.ws + OFF_SLAB);
  const bf16_t* W = (const bf16_t*)(p.ws + OFF_WB) + WOUT;
  float* out = p.out;
  for (int it = 0;; ++it) {
    int mt, nt; int s = sched_tile(it, 128, 4, mt, nt);
    if (s < 0) break; if (s == 0) continue;
    acc8p_t acc;
    gemm8p<D_, D_, 16>(MG + (size_t)mt * 256 * D_, W + (size_t)nt * 256 * D_, smem, acc);
    EPI_IDS
    float* tp = out + (size_t)(mt * 256) * D_ + nt * 256;
    const unsigned loff = (unsigned)((wr * 64 + fq * 4) * D_ + wc * 32 + fr);
    EPI_FOR {
      const int ro = LROW(ai, m, j) * D_ + LCOL(bj, n);
      (tp + ro)[loff] = (tp + ro)[loff] + acc[ai][bj][m][n][j];
    }
  }
}

#define XB_TMO      128
#define XB_XCNT(j)  (256  + 64 * (j))
#define XB_XSUB(j)  (1280 + 64 * (j))
#define XB_XGEN(j)  (2304 + 64 * (j))
#define XB_TOP      3328
#define XB_TOPGEN   3392
#define XCD_BAR_WORDS 3456
#define XB_SPIN_CAP (1u << 22)
#define LAS __attribute__((address_space(3)))
DI unsigned xb_ld(unsigned* p) { return __hip_atomic_load(p, __ATOMIC_RELAXED, __HIP_MEMORY_SCOPE_AGENT); }
DI unsigned xb_add(unsigned* p, unsigned v) { return __hip_atomic_fetch_add(p, v, __ATOMIC_RELAXED, __HIP_MEMORY_SCOPE_AGENT); }
DI unsigned xb_xcc_id() { return (unsigned)__builtin_amdgcn_s_getreg((3 << 11) | 20) & 0xFu; }
#define XB_SPIN(cond, bar) do { unsigned _sp = 0; while (cond) { __builtin_amdgcn_s_sleep(1); \
    if ((++_sp & 255u) == 0u) { if (xb_ld(&(bar)[XB_TMO])) break; if (_sp > XB_SPIN_CAP) { atomicAdd(&(bar)[XB_TMO], 1u); break; } } } } while (0)
struct XcdBarrier { unsigned* bar; unsigned x; volatile LAS unsigned* st; };
DI XcdBarrier xcd_barrier_post(unsigned* bar, volatile LAS unsigned* st) {
  XcdBarrier b; b.bar = bar; b.x = xb_xcc_id(); b.st = st;
  if (threadIdx.x == 0) (void)xb_add(&bar[XB_XCNT(b.x)], 1u);
  return b;
}
DI void xcd_barrier_complete(unsigned* bar, unsigned x, unsigned& nloc, unsigned& nx) {
  const unsigned G = gridDim.x * gridDim.y * gridDim.z;
  unsigned sum, cnt, mine, sp = 0u;
  for (;;) {
    sum = 0u; cnt = 0u; mine = 0u;
#pragma unroll
    for (unsigned j = 0; j < 16; ++j) { const unsigned c = xb_ld(&bar[XB_XCNT(j)]); sum += c; cnt += (c > 0u) ? 1u : 0u; mine = (j == x) ? c : mine; }
    if (sum == G) break;
    __builtin_amdgcn_s_sleep(1);
    if ((++sp & 255u) == 0u) { if (xb_ld(&bar[XB_TMO])) break; if (sp > XB_SPIN_CAP) { atomicAdd(&bar[XB_TMO], 1u); break; } }
  }
  nloc = mine > 0u ? mine : 1u; nx = cnt > 0u ? cnt : 1u;
}
DI void xcd_barrier(const XcdBarrier& b) {
  asm volatile("s_waitcnt vmcnt(0)" ::: "memory");
  __syncthreads();
  if (threadIdx.x == 0) {
    unsigned* bar = b.bar;
    __builtin_amdgcn_s_waitcnt(0);
    unsigned nloc = b.st[0], nx = b.st[1];
    if (nloc == 0u) { xcd_barrier_complete(bar, b.x, nloc, nx); b.st[0] = nloc; b.st[1] = nx; }
    const unsigned old = xb_add(&bar[XB_XSUB(b.x)], 1u);
    const unsigned gen = old / nloc;
    if (old + 1u == (gen + 1u) * nloc) {
      __builtin_amdgcn_fence(__ATOMIC_RELEASE, "agent");
      asm volatile("s_waitcnt vmcnt(0)" ::: "memory");
      const unsigned og = xb_add(&bar[XB_TOP], 1u);
      const unsigned tg = og / nx;
      if (og + 1u == (tg + 1u) * nx) xb_add(&bar[XB_TOPGEN], 1u);
      else XB_SPIN(xb_ld(&bar[XB_TOPGEN]) == tg, bar);
      __builtin_amdgcn_fence(__ATOMIC_ACQUIRE, "agent");
      xb_add(&bar[XB_XGEN(b.x)], 1u);
      asm volatile("s_waitcnt vmcnt(0)" ::: "memory");
    } else {
      XB_SPIN(xb_ld(&bar[XB_XGEN(b.x)]) == gen, bar);
      __builtin_amdgcn_fence(__ATOMIC_ACQUIRE, "agent");
      asm volatile("s_waitcnt vmcnt(0)" ::: "memory");
    }
  }
  __syncthreads();
}

DI void run_phase(const Params& p, int ph, char* smem) {
  switch (ph) {
    case 0: phase_prep(p, smem); break;
    case 1: phase_ffn_gu(p, W1GU, smem); break;
    case 2: phase_ffn_down(p, W1D, p.x, smem); break;
    case 3: phase_rmsnorm(p.out, p.g_mix, (bf16_t*)(p.ws + OFF_H)); break;
    case 4: phase_win(p, smem); break;
    case 5: phase_qproj(p, smem); break;
    case 6: phase_mix<false>(p, smem); break;
    case 13: phase_mix<true>(p, smem); break;
    case 14: phase_sb_dummy(p, smem); break;
    case 7: phase_sparse(p, smem); break;
    case 8: phase_merge(p, smem); break;
    case 9: phase_outproj(p, smem); break;
    case 10: phase_rmsnorm(p.out, p.g_ffn2, (bf16_t*)(p.ws + OFF_H)); break;
    case 11: phase_ffn_gu(p, W2GU, smem); break;
    case 12: phase_ffn_down(p, W2D, p.out, smem); break;
  }
}
constexpr int NPHASE = 13;

#if !MULTI_LAUNCH
__global__ void __launch_bounds__(512, 2) mega_kernel(Params p) {
  __shared__ __attribute__((aligned(16))) char smem[SMEM_BYTES];
  __shared__ uint4 xb_words;
  cg::grid_group grid = cg::this_grid();
  if (threadIdx.x == 0) xb_words = make_uint4(0u, 0u, 0u, 0u);
  __syncthreads();
  XcdBarrier xb = xcd_barrier_post((unsigned*)(p.ws + OFF_CNT + 256), (volatile LAS unsigned*)&xb_words);
  unsigned* bar0 = (unsigned*)(p.ws + OFF_CNT + 256);
  if (threadIdx.x == 0) g_sched[3] = (int)xb_add(&bar0[XB_XCNT(xb.x) + 16], 1u);
  grid.sync();
  if (threadIdx.x == 0) {
    const unsigned per = gridDim.x >> 3; bool ok = (gridDim.x & 7) == 0 && xb.x < 8;
    for (unsigned jx = 0; jx < 16; ++jx) { const unsigned c = xb_ld(&bar0[XB_XCNT(jx) + 16]); ok = ok && (c == (jx < 8 ? per : 0u)); }
    g_sched[0] = ok ? (int)xb.x : (int)(blockIdx.x & 7);
    g_sched[1] = ok ? g_sched[3] : (int)(blockIdx.x >> 3);
  }
  __syncthreads();
#pragma nounroll
  for (int ph = 0; ph < NPHASE; ++ph) {
    int phv = ph; asm volatile("" : "+s"(phv));
    run_phase(p, phv, smem);
    if (ph + 1 < NPHASE) xcd_barrier(xb);
  }
}
#else
template <int PH>
__global__ void __launch_bounds__(512, 2) phase_kernel(Params p) {
  __shared__ __attribute__((aligned(16))) char smem[SMEM_BYTES];
  if (threadIdx.x == 0) { g_sched[0] = blockIdx.x & 7; g_sched[1] = blockIdx.x >> 3; }
  __syncthreads();
  run_phase(p, PH, smem);
}
#ifndef PROBE_MASK
#define PROBE_MASK 0
#endif
template <int PH> static void launch_phases(const Params& p, hipStream_t stream) {
  hipLaunchKernelGGL(phase_kernel<PH>, dim3(256), dim3(NTHR), 0, stream, p);
  if constexpr (((PROBE_MASK >> PH) & 1) != 0 && PH != 6) hipLaunchKernelGGL(phase_kernel<PH>, dim3(256), dim3(NTHR), 0, stream, p);
  if constexpr (((PROBE_MASK >> PH) & 1) != 0 && PH == 6) hipLaunchKernelGGL(phase_kernel<13>, dim3(256), dim3(NTHR), 0, stream, p);
  if constexpr (((PROBE_MASK >> 14) & 1) != 0 && PH == 5) hipLaunchKernelGGL(phase_kernel<14>, dim3(256), dim3(NTHR), 0, stream, p);
  if constexpr (PH + 1 < NPHASE) launch_phases<PH + 1>(p, stream);
}
#endif

extern "C" void kernel_launch(void* const* d_in, const int* in_sizes, int n_in, void* d_out, int out_size, void* d_ws,
                              size_t ws_size, hipStream_t stream) {
  Params p{};
  p.x = (const float*)d_in[0]; p.pos = (const int*)d_in[1];
  p.g_ffn1 = (const float*)d_in[2]; p.w1g = (const float*)d_in[3]; p.w1u = (const float*)d_in[4]; p.w1d = (const float*)d_in[5];
  p.g_mix = (const float*)d_in[6]; p.w_in = (const float*)d_in[7]; p.g_cq = (const float*)d_in[8]; p.w_uq = (const float*)d_in[9];
  p.w_qi = (const float*)d_in[10]; p.g_qa = (const float*)d_in[11]; p.g_ka = (const float*)d_in[12]; p.w_uv = (const float*)d_in[13];
  p.w_oa = (const float*)d_in[14]; p.w_ob = (const float*)d_in[15]; p.w_out = (const float*)d_in[16]; p.g_ffn2 = (const float*)d_in[17];
  p.w2g = (const float*)d_in[18]; p.w2u = (const float*)d_in[19]; p.w2d = (const float*)d_in[20];
  p.out = (float*)d_out; p.ws = (char*)d_ws;
  if (ws_size < WS_NEED) { fprintf(stderr, "workspace too small: %zu < %zu\n", ws_size, (size_t)WS_NEED); return; }
  (void)hipMemsetAsync((char*)d_ws + OFF_CNT, 0, 256 + 16384, stream);
#if MULTI_LAUNCH
  launch_phases<0>(p, stream);
#else
  static int grid_blocks = 0;
  if (!grid_blocks) {
    int dev = 0, cus = 0, per_cu = 0;
    (void)hipGetDevice(&dev);
    (void)hipDeviceGetAttribute(&cus, hipDeviceAttributeMultiprocessorCount, dev);
    (void)hipOccupancyMaxActiveBlocksPerMultiprocessor(&per_cu, mega_kernel, NTHR, 0);
    if (per_cu > 1) per_cu = 1;
    grid_blocks = cus * per_cu;
    if (grid_blocks > 256) grid_blocks = 256;
  }
  void* args[] = {&p};
  hipError_t e = hipLaunchCooperativeKernel((void*)mega_kernel, dim3(grid_blocks), dim3(NTHR), args, 0, stream);
  if (e != hipSuccess) fprintf(stderr, "cooperative launch failed: %s (grid %d)\n", hipGetErrorString(e), grid_blocks);
#endif
}
```

```cpp
#include <hip/hip_runtime.h>
#include <hip/hip_cooperative_groups.h>
#include <stdint.h>
#include <stdio.h>
namespace cg = cooperative_groups;

#ifndef MULTI_LAUNCH
#define MULTI_LAUNCH 0
#endif

#define DI __device__ __forceinline__
typedef unsigned short bf16_t;
typedef __attribute__((ext_vector_type(8))) short bf16x8;
typedef __attribute__((ext_vector_type(16))) float f32x16;
typedef __attribute__((ext_vector_type(4))) float f32x4;
typedef __attribute__((ext_vector_type(4))) unsigned u32x4;
typedef __attribute__((ext_vector_type(2))) unsigned u32x2;

constexpr int T_ = 32768, S_ = 4096, D_ = 1024, FF = 2816;
constexpr int PA_LD = 1536;
constexpr int PA_KA = 256, PA_VA = 320, PA_KI = 448, PA_QB = 512, PA_KB = 1024;
constexpr float EPS = 1e-6f;
constexpr float LOG2E = 1.4426950408889634f;

constexpr size_t W1GU = 0;
constexpr size_t W1D = W1GU + (size_t)5632 * 1024;
constexpr size_t W2GU = W1D + (size_t)1024 * 2816;
constexpr size_t W2D = W2GU + (size_t)5632 * 1024;
constexpr size_t WIN = W2D + (size_t)1024 * 2816;
constexpr size_t WQ = WIN + (size_t)4352 * 1024;
constexpr size_t WUV = WQ + (size_t)1024 * 256;
constexpr size_t WOA = WUV + (size_t)512 * 128;
constexpr size_t WOB = WOA + (size_t)1024 * 512;
constexpr size_t WOUT = WOB + (size_t)1024 * 512;
constexpr size_t WB_ELEMS = WOUT + (size_t)1024 * 1024;
constexpr size_t OFF_WB = 0;
constexpr size_t OFF_H = (WB_ELEMS * 2 + 255) & ~(size_t)255;
constexpr size_t OFF_PA = OFF_H + (size_t)T_ * 1024 * 2;
constexpr size_t OFF_VT = OFF_PA + (size_t)T_ * PA_LD * 2;
constexpr size_t OFF_GATES = OFF_VT + (size_t)T_ * 512 * 2;
constexpr size_t OFF_SLAB = OFF_GATES + (size_t)T_ * 2048 * 2;
constexpr size_t OFF_WIDX = OFF_SLAB + (size_t)512 * 16 * 4096 * 4;
constexpr size_t OFF_ROPE = OFF_WIDX + (size_t)T_ * 8 * 4;
constexpr size_t OFF_CNT = OFF_ROPE + (size_t)T_ * 32 * 8;
constexpr size_t WS_NEED = OFF_CNT + 256 + 16384;
static_assert(WS_NEED <= (size_t)512 * 1024 * 1024, "workspace too large");
static_assert((size_t)T_ * FF * 2 <= OFF_SLAB - OFF_PA, "U must fit in PA+VT+GATES");

constexpr int SMEM_BYTES = 131072 + 2048;
__shared__ int g_sched[4];
constexpr int NTHR = 512, NWAVE = 8;

struct Params {
  const float* x; const int* pos;
  const float *g_ffn1, *w1g, *w1u, *w1d, *g_mix, *w_in, *g_cq, *w_uq, *w_qi, *g_qa, *g_ka, *w_uv, *w_oa, *w_ob, *w_out, *g_ffn2, *w2g, *w2u, *w2d;
  float* out;
  char* ws;
};

typedef __attribute__((ext_vector_type(2))) __bf16 bf16x2_t;
typedef __attribute__((ext_vector_type(2))) float f32x2_t;
DI unsigned pack2(float a, float b) { f32x2_t v = {a, b}; return __builtin_bit_cast(unsigned, __builtin_convertvector(v, bf16x2_t)); }
DI unsigned f2bf(float x) { return pack2(x, 0.f) & 0xffffu; }
DI float bf2f(unsigned v) { return __uint_as_float(v << 16); }
DI float bflo(unsigned v) { return __uint_as_float(v << 16); }
DI float bfhi(unsigned v) { return __uint_as_float(v & 0xffff0000u); }
DI float fexp2(float x) { return __builtin_amdgcn_exp2f(x); }
DI float frcp(float x) { return __builtin_amdgcn_rcpf(x); }
DI float wave_sum(float v) {
#pragma unroll
  for (int o = 32; o > 0; o >>= 1) v += __shfl_xor(v, o);
  return v;
}
#define MFMA32(a, b, c) __builtin_amdgcn_mfma_f32_32x32x16_bf16((a), (b), (c), 0, 0, 0)
#define MFMA16(a, b, c) __builtin_amdgcn_mfma_f32_16x16x32_bf16((a), (b), (c), 0, 0, 0)
DI bf16x8 ld_frag_g(const bf16_t* p) { return __builtin_bit_cast(bf16x8, *(const u32x4*)p); }
DI bf16x8 ld_frag_s(const char* p) { return __builtin_bit_cast(bf16x8, *(const u32x4*)p); }
DI int otid() { int t = threadIdx.x; asm volatile("" : "+v"(t)); return t; }
DI int owid(int tid) { return __builtin_amdgcn_readfirstlane(tid >> 6); }
DI int crow(int reg, int g) { return (reg & 3) + 8 * (reg >> 2) + 4 * g; }

DI const float* prep_col(const Params& p, int mat, int r, int& ld) {
  switch (mat) {
    case 0: case 2: {
      int j = r >> 8, q = r & 255; int half = q >> 7, c = q & 127;
      int n = j * 128 + c; ld = FF;
      const float* g = mat == 0 ? p.w1g : p.w2g; const float* u = mat == 0 ? p.w1u : p.w2u;
      return (half ? u : g) + n;
    }
    case 1: ld = D_; return p.w1d + r;
    case 3: ld = D_; return p.w2d + r;
    case 4: {
      ld = 4104;
      if (r < 512) return p.w_in + r;
      if (r < 4096) return p.w_in + r + 8;
      if (r < 4104) return p.w_in + (r - 4096 + 512);
      return nullptr;
    }
    case 5: {
      ld = 512;
      int T = r >> 8, q = r & 255; int hl = (q & 127) >> 5, d = (q >> 7) * 32 + (q & 31);
      int col = ((T & 1) * 4 + hl) * 64 + d;
      return (T < 2 ? p.w_uq : p.w_qi) + col;
    }
    case 6: { ld = 64; int h = r >> 6, d = r & 63; return p.w_uv + h * 8192 + d; }
    case 7: ld = D_; return p.w_oa + r;
    case 8: ld = D_; return p.w_ob + r;
    default: ld = D_; return p.w_out + r;
  }
}

DI void prep_transpose_tile(const Params& p, bool valid, int mat, int K, bf16_t* dst, int tile, float* lds, int t) {
  const int nkt = K >> 6;
  const int r0 = (tile / nkt) * 32, k0 = (tile % nkt) * 64;
  const int tx = t & 31, ty = t >> 5;
  if (valid) {
    int ld; const float* col = prep_col(p, mat, r0 + tx, ld);
#pragma unroll
    for (int i = 0; i < 8; ++i) {
      int k = k0 + ty + 8 * i;
      float v = 0.f;
      if (col) { v = col[(size_t)k * ld]; if (mat == 5) v *= p.g_cq[k]; }
      lds[tx * 65 + ty + 8 * i] = v;
    }
  }
  __syncthreads();
  if (valid) {
    const int row = t >> 3, kc = (t & 7) * 8;
    const float* s = lds + row * 65 + kc;
    u32x4 o; o[0] = pack2(s[0], s[1]); o[1] = pack2(s[2], s[3]); o[2] = pack2(s[4], s[5]); o[3] = pack2(s[6], s[7]);
    *(u32x4*)(dst + (size_t)(r0 + row) * K + k0 + kc) = o;
  }
  __syncthreads();
}

DI void rmsnorm_row(const float* __restrict__ xr, const float* __restrict__ g, bf16_t* __restrict__ o) {
  const int lane = otid() & 63;
  float4 v[4]; float ss = 0.f;
#pragma unroll
  for (int j = 0; j < 4; ++j) { v[j] = *(const float4*)(xr + lane * 4 + 256 * j); ss += v[j].x * v[j].x + v[j].y * v[j].y + v[j].z * v[j].z + v[j].w * v[j].w; }
  ss = wave_sum(ss);
  const float rs = rsqrtf(ss * (1.f / 1024.f) + EPS);
#pragma unroll
  for (int j = 0; j < 4; ++j) {
    float4 gg = *(const float4*)(g + lane * 4 + 256 * j);
    u32x2 w; w[0] = pack2(v[j].x * rs * gg.x, v[j].y * rs * gg.y); w[1] = pack2(v[j].z * rs * gg.z, v[j].w * rs * gg.w);
    *(u32x2*)(o + lane * 4 + 256 * j) = w;
  }
}

DI void phase_rmsnorm(const float* __restrict__ src, const float* __restrict__ g, bf16_t* __restrict__ dst) {
  const int wid = owid(otid());
  for (int it = blockIdx.x; it < T_ / NWAVE; it += gridDim.x) {
    int row = it * NWAVE + wid;
    rmsnorm_row(src + (size_t)row * D_, g, dst + (size_t)row * D_);
  }
}

DI void phase_prep(const Params& p, char* smem) {
  bf16_t* wb = (bf16_t*)(p.ws + OFF_WB);
  const int tid = otid(), vb = tid >> 8, t = tid & 255;
  float* lds = (float*)smem + vb * 2112;
  constexpr int c0 = 2816, c1 = c0 + 1408, c2 = c1 + 2816, c3 = c2 + 1408, c4 = c3 + 2176, c5 = c4 + 128, c6 = c5 + 32, c7 = c6 + 256, c8 = c7 + 256, c9 = c8 + 512;
  static_assert((c9 & 1) == 0, "pairs");
  for (int it0 = blockIdx.x; it0 < c9 / 2; it0 += gridDim.x) {
    const int it = it0 * 2 + vb;
    int mat, K, base; size_t off;
    if (it < c0) { mat = 0; K = 1024; base = 0; off = W1GU; }
    else if (it < c1) { mat = 1; K = 2816; base = c0; off = W1D; }
    else if (it < c2) { mat = 2; K = 1024; base = c1; off = W2GU; }
    else if (it < c3) { mat = 3; K = 2816; base = c2; off = W2D; }
    else if (it < c4) { mat = 4; K = 1024; base = c3; off = WIN; }
    else if (it < c5) { mat = 5; K = 256; base = c4; off = WQ; }
    else if (it < c6) { mat = 6; K = 128; base = c5; off = WUV; }
    else if (it < c7) { mat = 7; K = 512; base = c6; off = WOA; }
    else if (it < c8) { mat = 8; K = 512; base = c7; off = WOB; }
    else { mat = 9; K = 1024; base = c8; off = WOUT; }
    prep_transpose_tile(p, true, mat, K, wb + off, it - base, lds, t);
  }
  {
    const int wid = owid(tid);
    for (int it = blockIdx.x; it < T_ / NWAVE; it += gridDim.x) {
      int row = it * NWAVE + wid;
      rmsnorm_row(p.x + (size_t)row * D_, p.g_ffn1, (bf16_t*)(p.ws + OFF_H) + (size_t)row * D_);
    }
  }
  for (int it = blockIdx.x; it < T_ * 32 / NTHR; it += gridDim.x) {
    int e = it * NTHR + tid;
    int tok = e >> 5, i = e & 31;
    float inv_freq = exp2f(-(float)i * (13.287712379549449f / 32.f));
    float ang = (float)p.pos[tok] * inv_freq;
    double rev = (double)ang * 0.15915494309189535;
    rev -= floor(rev);
    float r = (float)rev;
    float2 cs; cs.x = __builtin_amdgcn_cosf(r); cs.y = __builtin_amdgcn_sinf(r);
    ((float2*)(p.ws + OFF_ROPE))[e] = cs;
  }
}

typedef f32x4 acc8p_t[2][2][4][2];
constexpr int G_BK = 64, G_HALF = 128, G_HT = G_HALF * G_BK;
DI int lds_byte(int r, int c) {
  int st = (r >> 4) * 2 + (c >> 5), rr = r & 15, cc = c & 31, ob = rr * 64 + cc * 2;
  return st * 1024 + (ob ^ (((ob >> 9) & 1) << 5));
}
DI void stage_rc(int b, int& R, int& C) {
  int st = b / 1024, sb = b % 1024, swz = sb ^ (((sb >> 9) & 1) << 5);
  R = (st >> 1) * 16 + swz / 64; C = (st & 1) * 32 + (swz % 64) / 2;
}
template <int LDA, int LDB, int NKT>
DI void gemm8p(const bf16_t* __restrict__ A, const bf16_t* __restrict__ Bt, char* smem, acc8p_t& acc) {
  static_assert(NKT >= 4 && (NKT % 2) == 0, "K tiles");
  bf16_t* shm = (bf16_t*)smem;
  const int tid = otid();
  const int wid = owid(tid), lane = tid & 63, wr = wid >> 2, wc = wid & 3, fr = lane & 15, fq = lane >> 4;
#define SA(b, h) (shm + ((b) * 2 + (h)) * G_HT)
#define SB(b, h) (shm + (4 + (b) * 2 + (h)) * G_HT)
  unsigned sofa[2], sofb[2];
#pragma unroll
  for (int _i = 0; _i < 2; ++_i) { int _r, _c; stage_rc(tid * 16 + _i * 8192, _r, _c); sofa[_i] = (unsigned)(_r * LDA + _c); sofb[_i] = (unsigned)(_r * LDB + _c); }
#define STAGE(P, BASE, LD, br, kt, SOF) do { const bf16_t* _ub = (BASE) + ((long)(br) * (LD) + (long)(kt) * G_BK);     \
    _Pragma("unroll") for (int _i = 0; _i < 2; ++_i) { \
      __builtin_amdgcn_global_load_lds((const unsigned*)(_ub + SOF[_i]), \
        (unsigned*)((char*)(P) + tid * 16 + _i * 8192), 16, 0, 0); } } while (0)
#define LDA_(dst, b, h) _Pragma("unroll") for (int m = 0; m < 4; ++m) _Pragma("unroll") for (int k = 0; k < 2; ++k) \
    dst[m][k] = *reinterpret_cast<const bf16x8*>((char*)SA(b, h) + lds_byte(wr * 64 + m * 16 + fr, k * 32 + fq * 8))
#define LDB_(dst, b, h) _Pragma("unroll") for (int n = 0; n < 2; ++n) _Pragma("unroll") for (int k = 0; k < 2; ++k) \
    dst[n][k] = *reinterpret_cast<const bf16x8*>((char*)SB(b, h) + lds_byte(wc * 32 + n * 16 + fr, k * 32 + fq * 8))
#define MMA(ai, bj, At_, Bt_) do { __builtin_amdgcn_s_setprio(1); \
    _Pragma("unroll") for (int m = 0; m < 4; ++m) _Pragma("unroll") for (int n = 0; n < 2; ++n) _Pragma("unroll") for (int k = 0; k < 2; ++k) \
      acc[ai][bj][m][n] = __builtin_amdgcn_mfma_f32_16x16x32_bf16(At_[m][k], Bt_[n][k], acc[ai][bj][m][n], 0, 0, 0); \
    __builtin_amdgcn_s_setprio(0); } while (0)
#define WAIT_V(n) asm volatile("s_waitcnt vmcnt(" #n ")" ::: "memory")
#define WAIT_L(n) asm volatile("s_waitcnt lgkmcnt(" #n ")" ::: "memory")
#define BAR __builtin_amdgcn_s_barrier()
#define SCHED __builtin_amdgcn_sched_barrier(0)
#pragma unroll
  for (int a = 0; a < 2; ++a)
#pragma unroll
    for (int b = 0; b < 2; ++b)
#pragma unroll
      for (int m = 0; m < 4; ++m)
#pragma unroll
        for (int n = 0; n < 2; ++n) acc[a][b][m][n] = f32x4{0.f, 0.f, 0.f, 0.f};
  bf16x8 At[4][2], B0[2][2], B1[2][2];
  constexpr int nt = NKT;
  WAIT_V(0);
  SCHED;
  STAGE(SB(0, 0), Bt, LDB, 0, 0, sofb); STAGE(SA(0, 0), A, LDA, 0, 0, sofa);
  STAGE(SB(0, 1), Bt, LDB, G_HALF, 0, sofb); STAGE(SA(0, 1), A, LDA, G_HALF, 0, sofa);
  if (wr == 1) BAR;
  WAIT_V(4); BAR;
  STAGE(SB(1, 0), Bt, LDB, 0, 1, sofb); STAGE(SA(1, 0), A, LDA, 0, 1, sofa); STAGE(SB(1, 1), Bt, LDB, G_HALF, 1, sofb);
  WAIT_V(6); BAR;
  for (int t = 0; t < nt - 2; t += 2) {
    LDB_(B0, 0, 0); SCHED; LDA_(At, 0, 0); STAGE(SA(1, 1), A, LDA, G_HALF, t + 1, sofa);
    WAIT_L(8); BAR; WAIT_L(0); MMA(0, 0, At, B0); BAR; SCHED;
    LDB_(B1, 0, 1); STAGE(SB(0, 0), Bt, LDB, 0, t + 2, sofb);
    BAR; WAIT_L(0); MMA(0, 1, At, B1); BAR;
    LDA_(At, 0, 1); STAGE(SA(0, 0), A, LDA, 0, t + 2, sofa);
    BAR; WAIT_L(0); MMA(1, 0, At, B0); BAR; SCHED;
    STAGE(SB(0, 1), Bt, LDB, G_HALF, t + 2, sofb);
    WAIT_V(6); BAR; MMA(1, 1, At, B1); BAR;
    LDB_(B0, 1, 0); SCHED; LDA_(At, 1, 0); STAGE(SA(0, 1), A, LDA, G_HALF, t + 2, sofa);
    WAIT_L(8); BAR; WAIT_L(0); MMA(0, 0, At, B0); BAR; SCHED;
    LDB_(B1, 1, 1); STAGE(SB(1, 0), Bt, LDB, 0, t + 3, sofb);
    BAR; WAIT_L(0); MMA(0, 1, At, B1); BAR;
    LDA_(At, 1, 1); STAGE(SA(1, 0), A, LDA, 0, t + 3, sofa);
    BAR; WAIT_L(0); MMA(1, 0, At, B0); BAR; SCHED;
    STAGE(SB(1, 1), Bt, LDB, G_HALF, t + 3, sofb);
    WAIT_V(6); BAR; MMA(1, 1, At, B1); BAR;
  }
  { LDB_(B0, 0, 0); LDA_(At, 0, 0); STAGE(SA(1, 1), A, LDA, G_HALF, nt - 1, sofa);
    BAR; WAIT_L(0); MMA(0, 0, At, B0); BAR;
    LDB_(B1, 0, 1); BAR; WAIT_L(0); MMA(0, 1, At, B1); BAR;
    LDA_(At, 0, 1); WAIT_V(4); BAR; WAIT_L(0); MMA(1, 0, At, B0); MMA(1, 1, At, B1); BAR; }
  { LDB_(B0, 1, 0); LDA_(At, 1, 0); WAIT_V(2); BAR; WAIT_L(0); MMA(0, 0, At, B0); BAR;
    LDB_(B1, 1, 1); WAIT_V(0); BAR; WAIT_L(0); MMA(0, 1, At, B1); BAR;
    LDA_(At, 1, 1); BAR; WAIT_L(0); MMA(1, 0, At, B0); MMA(1, 1, At, B1); BAR; }
  if (wr == 0) BAR;
#undef SA
#undef SB
#undef STAGE
#undef LDA_
#undef LDB_
#undef MMA
#undef WAIT_V
#undef WAIT_L
#undef BAR
#undef SCHED
}

DI int sched_tile(int it, int MT, int NT, int& mt, int& nt) {
  const int G = gridDim.x, b = blockIdx.x;
  const int per = G >> 3, pm = per >> 2;
  if ((G & 31) == 0 && pm > 0 && (MT % pm) == 0) {
    const int x = g_sched[0], j = g_sched[1];
    const int nsn = (NT + 3) >> 2, nsm = MT / pm;
    const int st = it * 8 + x;
    if (st >= nsm * nsn) return -1;
    const int sm = st / nsn, sn = st - sm * nsn;
    mt = sm * pm + (j % pm); nt = sn * 4 + (j / pm);
    return nt < NT ? 1 : 0;
  } else {
    const int tile = it * G + b;
    if (tile >= MT * NT) return -1;
    nt = tile % NT; mt = tile / NT;
    return 1;
  }
}

#define EPI_IDS const int tid = otid(), lane = tid & 63, wid = owid(tid), wr = wid >> 2, wc = wid & 3, fr = lane & 15, fq = lane >> 4; (void)wr; (void)wc; (void)fr; (void)fq;
#define LROW(ai, m, j) ((ai) * 128 + (m) * 16 + (j))
#define LCOL(bj, n) ((bj) * 128 + (n) * 16)
#define EPI_FOR _Pragma("unroll") for (int ai = 0; ai < 2; ++ai) _Pragma("unroll") for (int bj = 0; bj < 2; ++bj) \
    _Pragma("unroll") for (int m = 0; m < 4; ++m) _Pragma("unroll") for (int n = 0; n < 2; ++n) _Pragma("unroll") for (int j = 0; j < 4; ++j)

DI void phase_ffn_gu(const Params& p, size_t woff, char* smem) {
  const bf16_t* H = (const bf16_t*)(p.ws + OFF_H);
  const bf16_t* W = (const bf16_t*)(p.ws + OFF_WB) + woff;
  bf16_t* U = (bf16_t*)(p.ws + OFF_PA);
  for (int it = 0;; ++it) {
    int mt, nt; int s = sched_tile(it, 128, 22, mt, nt);
    if (s < 0) break; if (s == 0) continue;
    acc8p_t acc;
    gemm8p<D_, D_, 16>(H + (size_t)mt * 256 * D_, W + (size_t)nt * 256 * D_, smem, acc);
    EPI_IDS
    bf16_t* tp = U + (size_t)(mt * 256) * FF + nt * 128;
    const unsigned loff = (unsigned)((wr * 64 + fq * 4) * FF + wc * 32 + fr);
#pragma unroll
    for (int ai = 0; ai < 2; ++ai)
#pragma unroll
      for (int m = 0; m < 4; ++m)
#pragma unroll
        for (int n = 0; n < 2; ++n)
#pragma unroll
          for (int j = 0; j < 4; ++j) {
            float gv = acc[ai][0][m][n][j], uv = acc[ai][1][m][n][j];
            float sv = gv * frcp(1.f + fexp2(-LOG2E * gv)) * uv;
            (tp + LROW(ai, m, j) * FF + n * 16)[loff] = (bf16_t)f2bf(sv);
          }
  }
}

DI void phase_ffn_down(const Params& p, size_t woff, const float* res, char* smem) {
  const bf16_t* U = (const bf16_t*)(p.ws + OFF_PA);
  const bf16_t* W = (const bf16_t*)(p.ws + OFF_WB) + woff;
  float* out = p.out;
  for (int it = 0;; ++it) {
    int mt, nt; int s = sched_tile(it, 128, 4, mt, nt);
    if (s < 0) break; if (s == 0) continue;
    acc8p_t acc;
    gemm8p<FF, FF, 44>(U + (size_t)mt * 256 * FF, W + (size_t)nt * 256 * FF, smem, acc);
    EPI_IDS
    const size_t tb = (size_t)(mt * 256) * D_ + nt * 256;
    float* tp = out + tb; const float* rsp = res + tb;
    const unsigned loff = (unsigned)((wr * 64 + fq * 4) * D_ + wc * 32 + fr);
    EPI_FOR {
      const int ro = LROW(ai, m, j) * D_ + LCOL(bj, n);
      (tp + ro)[loff] = (rsp + ro)[loff] + 0.5f * acc[ai][bj][m][n][j];
    }
  }
}

DI void phase_win(const Params& p, char* smem) {
  const bf16_t* H = (const bf16_t*)(p.ws + OFF_H);
  const bf16_t* W = (const bf16_t*)(p.ws + OFF_WB) + WIN;
  bf16_t* PA = (bf16_t*)(p.ws + OFF_PA);
  bf16_t* VT = (bf16_t*)(p.ws + OFF_VT);
  bf16_t* GT = (bf16_t*)(p.ws + OFF_GATES);
  float* WI = (float*)(p.ws + OFF_WIDX);
  for (int it = 0;; ++it) {
    int mt, nt; int s = sched_tile(it, 128, 17, mt, nt);
    if (s < 0) break; if (s == 0) continue;
    acc8p_t acc;
    gemm8p<D_, D_, 16>(H + (size_t)mt * 256 * D_, W + (size_t)nt * 256 * D_, smem, acc);
    EPI_IDS
    if (nt < 6) {
      bf16_t* tp = PA + (size_t)(mt * 256) * PA_LD + nt * 256;
      const unsigned loff = (unsigned)((wr * 64 + fq * 4) * PA_LD + wc * 32 + fr);
      const float qsc = (nt == 2 || nt == 3) ? 0.125f * LOG2E : 1.f;
      EPI_FOR {
        const int ro = LROW(ai, m, j) * PA_LD + LCOL(bj, n);
        (tp + ro)[loff] = (bf16_t)f2bf(acc[ai][bj][m][n][j] * qsc);
      }
    } else if (nt < 8) {
      const int b = mt >> 4;
#pragma unroll
      for (int ai = 0; ai < 2; ++ai)
#pragma unroll
        for (int bj = 0; bj < 2; ++bj)
#pragma unroll
          for (int m = 0; m < 4; ++m)
#pragma unroll
            for (int n = 0; n < 2; ++n) {
              int c = (nt - 6) * 256 + bj * 128 + wc * 32 + n * 16 + fr;
              int h = c >> 6, d = c & 63;
              int tok = mt * 256 + ai * 128 + wr * 64 + m * 16 + fq * 4;
              bf16_t* dst = VT + ((size_t)(b * 8 + h) * 64 + d) * S_ + (tok & (S_ - 1));
              u32x2 w; w[0] = pack2(acc[ai][bj][m][n][0], acc[ai][bj][m][n][1]); w[1] = pack2(acc[ai][bj][m][n][2], acc[ai][bj][m][n][3]);
              *(u32x2*)dst = w;
            }
    } else if (nt < 16) {
      bf16_t* tp = GT + (size_t)(mt * 256) * 2048 + (nt - 8) * 256;
      const unsigned loff = (unsigned)((wr * 64 + fq * 4) * 2048 + wc * 32 + fr);
      EPI_FOR {
        const int ro = LROW(ai, m, j) * 2048 + LCOL(bj, n);
        float v = acc[ai][bj][m][n][j];
        float sg = frcp(1.f + fexp2(-LOG2E * v));
        (tp + ro)[loff] = (bf16_t)f2bf(sg);
      }
    } else {
      if (wc == 0 && fr < 8) {
#pragma unroll
        for (int ai = 0; ai < 2; ++ai)
#pragma unroll
          for (int m = 0; m < 4; ++m)
#pragma unroll
            for (int j = 0; j < 4; ++j) {
              int row = mt * 256 + ai * 128 + wr * 64 + m * 16 + fq * 4 + j;
              WI[(size_t)row * 8 + fr] = acc[ai][0][m][0][j] * 0.04419417382415922f;
            }
      }
    }
  }
}

DI void phase_qproj(const Params& p, char* smem) {
  bf16_t* PA = (bf16_t*)(p.ws + OFF_PA);
  const bf16_t* W = (const bf16_t*)(p.ws + OFF_WB) + WQ;
  bf16_t* QA = (bf16_t*)(p.ws + OFF_H);
  bf16_t* QI = QA + (size_t)T_ * 512;
  const float2* ROPE = (const float2*)(p.ws + OFF_ROPE);
  float* rstd = (float*)(smem + 131072);
  for (int it = 0;; ++it) {
    int mt, nt; int s = sched_tile(it, 128, 4, mt, nt);
    if (s < 0) break; if (s == 0) continue;
    {
      const int tq = otid(); int row = tq >> 1, half = tq & 1;
      const bf16_t* src = PA + (size_t)(mt * 256 + row) * PA_LD + half * 128;
      float ss = 0.f;
#pragma unroll 4
      for (int i = 0; i < 16; ++i) {
        u32x4 v = *(const u32x4*)(src + i * 8);
#pragma unroll
        for (int j = 0; j < 4; ++j) { float a = bflo(v[j]), b = bfhi(v[j]); ss += a * a + b * b; }
      }
      ss += __shfl_xor(ss, 1);
      if (half == 0) rstd[row] = rsqrtf(ss * (1.f / 256.f) + EPS);
    }
    acc8p_t acc;
    gemm8p<PA_LD, 256, 4>(PA + (size_t)mt * 256 * PA_LD, W + (size_t)nt * 256 * 256, smem, acc);
    EPI_IDS
    const int head = (nt & 1) * 4 + wc;
    bf16_t* dtp = (nt < 2 ? QA : QI) + (size_t)(mt * 256) * 512 + head * 64;
    const float2* rtp = ROPE + (size_t)(mt * 256) * 32;
    const unsigned doff = (unsigned)((wr * 64 + fq * 4) * 512 + fr);
    const unsigned roff = (unsigned)((wr * 64 + fq * 4) * 32 + fr);
    const float* rsl = rstd + wr * 64 + fq * 4;
    float ga[4] = {1.f, 1.f, 1.f, 1.f};
    const bool do_norm = nt < 2;
    if (do_norm) { ga[0] = p.g_qa[fr]; ga[1] = p.g_qa[16 + fr]; ga[2] = p.g_qa[32 + fr]; ga[3] = p.g_qa[48 + fr]; }
#pragma unroll
    for (int ai = 0; ai < 2; ++ai)
#pragma unroll
      for (int m = 0; m < 4; ++m)
#pragma unroll
        for (int j = 0; j < 4; ++j) {
          const int lr = LROW(ai, m, j);
          const float rs = rsl[lr];
          float x0 = acc[ai][0][m][0][j] * rs, x1 = acc[ai][0][m][1][j] * rs;
          float y0 = acc[ai][1][m][0][j] * rs, y1 = acc[ai][1][m][1][j] * rs;
          if (do_norm) {
            float ss = x0 * x0 + x1 * x1 + y0 * y0 + y1 * y1;
#pragma unroll
            for (int o = 8; o > 0; o >>= 1) ss += __shfl_xor(ss, o);
            const float r2 = rsqrtf(ss * (1.f / 64.f) + EPS);
            x0 *= r2 * ga[0]; x1 *= r2 * ga[1]; y0 *= r2 * ga[2]; y1 *= r2 * ga[3];
          }
          const float2 c0 = (rtp + lr * 32)[roff], c1 = (rtp + lr * 32 + 16)[roff];
          bf16_t* dp = dtp + lr * 512;
          (dp)[doff] = (bf16_t)f2bf(x0 * c0.x - y0 * c0.y);
          (dp + 32)[doff] = (bf16_t)f2bf(x0 * c0.y + y0 * c0.x);
          (dp + 16)[doff] = (bf16_t)f2bf(x1 * c1.x - y1 * c1.y);
          (dp + 48)[doff] = (bf16_t)f2bf(x1 * c1.y + y1 * c1.x);
          if (j == 3) __builtin_amdgcn_sched_barrier(0);
        }
    __syncthreads();
  }
  const int tid = otid(), lane = tid & 63, wid = owid(tid);
  for (int it = blockIdx.x; it < T_ / 64; it += gridDim.x) {
    const int d = lane & 31; const bool isidx = lane >= 32;
    const float g0 = isidx ? 1.f : p.g_ka[d], g1 = isidx ? 1.f : p.g_ka[d + 32];
    for (int i = 0; i < 8; ++i) {
      int tok = it * 64 + wid * 8 + i;
      bf16_t* src = PA + (size_t)tok * PA_LD + (isidx ? PA_KI : PA_KA);
      float v0 = bf2f(src[d]), v1 = bf2f(src[d + 32]);
      float ss = v0 * v0 + v1 * v1;
#pragma unroll
      for (int o = 16; o > 0; o >>= 1) ss += __shfl_xor(ss, o);
      if (!isidx) { float r2 = rsqrtf(ss * (1.f / 64.f) + EPS); v0 *= r2 * g0; v1 *= r2 * g1; }
      float2 cs = ROPE[(size_t)tok * 32 + d];
      float o0 = v0 * cs.x - v1 * cs.y, o1 = v0 * cs.y + v1 * cs.x;
      src[d] = (bf16_t)f2bf(o0); src[d + 32] = (bf16_t)f2bf(o1);
    }
  }
}

DI f32x16 sb_qk(const char* cur, int sub, int r, int g, int sw, const bf16x8 (&qf)[4]) {
  f32x16 z;
#pragma unroll
  for (int i = 0; i < 16; ++i) z[i] = 0.f;
#pragma unroll
  for (int ks = 0; ks < 4; ++ks) {
    bf16x8 kf = ld_frag_s(cur + (sub * 32 + r) * 128 + (((ks * 2 + g) ^ sw) << 4));
    z = MFMA32(kf, qf[ks], z);
  }
  return z;
}
template <bool DIAG>
DI void sb_elem(const f32x16& z, int r, int g, float& R, bf16x8& pf0, bf16x8& pf1) {
  float e[16], rr[16];
#pragma unroll
  for (int i = 0; i < 16; ++i) {
    float z2 = fminf(z[i], 80.f);
    float ev = fexp2(z2);
    float rv_ = frcp(1.f + ev);
    if (DIAG && !(crow(i, g) < r)) { ev = 0.f; rv_ = 1.f; }
    e[i] = ev; rr[i] = rv_;
  }
  float G[4], Gp[4];
#pragma unroll
  for (int q = 0; q < 4; ++q) {
    rr[4 * q + 2] *= rr[4 * q + 3];
    rr[4 * q + 1] *= rr[4 * q + 2];
    rr[4 * q + 0] *= rr[4 * q + 1];
    G[q] = rr[4 * q];
  }
#pragma unroll
  for (int q = 0; q < 4; ++q) Gp[q] = __shfl_xor(G[q], 32);
  float SO[4], SP[4];
  SO[3] = 1.f; SO[2] = G[3]; SO[1] = G[2] * G[3]; SO[0] = G[1] * SO[1];
  SP[3] = 1.f; SP[2] = Gp[3]; SP[1] = Gp[2] * Gp[3]; SP[0] = Gp[1] * SP[1];
  float a[16];
#pragma unroll
  for (int q = 0; q < 4; ++q) {
    float part = g == 0 ? SP[q] * Gp[q] : SP[q];
    float E = SO[q] * part * R;
#pragma unroll
    for (int j = 0; j < 4; ++j) a[4 * q + j] = e[4 * q + j] * rr[4 * q + j] * E;
  }
  R = R * (SO[0] * G[0]) * (SP[0] * Gp[0]);
  u32x4 pw0, pw1;
#pragma unroll
  for (int j = 0; j < 4; ++j) { pw0[j] = pack2(a[2 * j], a[2 * j + 1]); pw1[j] = pack2(a[8 + 2 * j], a[8 + 2 * j + 1]); }
  pf0 = __builtin_bit_cast(bf16x8, pw0); pf1 = __builtin_bit_cast(bf16x8, pw1);
}
DI void sb_pv(const char* cur, int sub, int r, int g, const bf16x8& pf0, const bf16x8& pf1, f32x16& o0, f32x16& o1) {
#pragma unroll
  for (int ks2 = 0; ks2 < 2; ++ks2) {
    const bf16x8 pf = ks2 == 0 ? pf0 : pf1;
#pragma unroll
    for (int dt = 0; dt < 2; ++dt) {
      const char* vp = cur + 8192 + (dt * 32 + r) * 136 + (sub * 32 + 16 * ks2 + 4 * g) * 2;
      u32x2 lo = *(const u32x2*)vp, hi = *(const u32x2*)(vp + 16);
      u32x4 vv; vv[0] = lo[0]; vv[1] = lo[1]; vv[2] = hi[0]; vv[3] = hi[1];
      bf16x8 vf = __builtin_bit_cast(bf16x8, vv);
      if (dt == 0) o0 = MFMA32(vf, pf, o0); else o1 = MFMA32(vf, pf, o1);
    }
  }
}

template <bool DUMMY>
DI void sb_item(const Params& p, int b, int h, int qb, char* smem) {
  bf16_t* PA = (bf16_t*)(p.ws + OFF_PA);
  const bf16_t* VT = (const bf16_t*)(p.ws + OFF_VT) + (size_t)(b * 8 + h) * 64 * S_;
  const int tid = otid(), lane = tid & 63, wid = owid(tid), g = lane >> 5, r = lane & 31;
  const int tw = qb * 256 + wid * 32;
  constexpr int BUFSZ = 8192 + 8704;
  bf16x8 qf[4];
  {
    const bf16_t* qp = PA + (size_t)(b * S_ + tw + r) * PA_LD + PA_QB + h * 64 + g * 8;
#pragma unroll
    for (int ks = 0; ks < 4; ++ks) qf[ks] = ld_frag_g(qp + ks * 16);
  }
  const int srow = tid >> 3, sch = tid & 7;
  const bf16_t* gk = PA + (size_t)(b * S_ + srow) * PA_LD + PA_KB + h * 64 + sch * 8;
  const bf16_t* gv = VT + (size_t)srow * S_ + sch * 8;
  const unsigned k_st = srow * 128 + ((sch ^ ((srow >> 1) & 7)) << 4);
  const unsigned v_st = 8192 + srow * 136 + sch * 16;
  const int sw = (lane >> 1) & 7;
  f32x16 o0, o1;
#pragma unroll
  for (int i = 0; i < 16; ++i) { o0[i] = 0.f; o1[i] = 0.f; }
  float R = 1.f;
  const int nkt = 4 * qb + 4;
  u32x4 rk, rv;
  {
    int kt = nkt - 1;
    rk = *(const u32x4*)(gk + (size_t)(kt * 64) * PA_LD); rv = *(const u32x4*)(gv + kt * 64);
    char* cur = smem + (kt & 1) * BUFSZ;
    *(u32x4*)(cur + k_st) = rk;
    u32x2 lo, hi; lo[0] = rv[0]; lo[1] = rv[1]; hi[0] = rv[2]; hi[1] = rv[3];
    *(u32x2*)(cur + v_st) = lo; *(u32x2*)(cur + v_st + 8) = hi;
  }
  __syncthreads();
  for (int kt = nkt - 1; kt >= 0; --kt) {
    const char* cur = smem + (kt & 1) * BUFSZ;
    char* nxt = smem + ((kt + 1) & 1) * BUFSZ;
    const bool more = kt > 0;
    if (more) { rk = *(const u32x4*)(gk + (size_t)((kt - 1) * 64) * PA_LD); rv = *(const u32x4*)(gv + (kt - 1) * 64); }
    __builtin_amdgcn_sched_barrier(0);
    if (kt * 64 + 32 < tw) {
      const f32x16 z1 = sb_qk(cur, 1, r, g, sw, qf);
      const f32x16 z0 = sb_qk(cur, 0, r, g, sw, qf);
      bf16x8 p1a, p1b, p0a, p0b;
      sb_elem<false>(z1, r, g, R, p1a, p1b);
      sb_pv(cur, 1, r, g, p1a, p1b, o0, o1);
      sb_elem<false>(z0, r, g, R, p0a, p0b);
      sb_pv(cur, 0, r, g, p0a, p0b, o0, o1);
    } else {
#pragma unroll
      for (int sub = 1; sub >= 0; --sub) {
        const int sbase = kt * 64 + sub * 32;
        if (sbase <= tw) {
          const f32x16 z = sb_qk(cur, sub, r, g, sw, qf);
          bf16x8 pa, pb;
          if (sbase == tw) sb_elem<true>(z, r, g, R, pa, pb); else sb_elem<false>(z, r, g, R, pa, pb);
          sb_pv(cur, sub, r, g, pa, pb, o0, o1);
        }
      }
    }
    __builtin_amdgcn_sched_barrier(0);
    if (more) {
      *(u32x4*)(nxt + k_st) = rk;
      u32x2 lo, hi; lo[0] = rv[0]; lo[1] = rv[1]; hi[0] = rv[2]; hi[1] = rv[3];
      *(u32x2*)(nxt + v_st) = lo; *(u32x2*)(nxt + v_st + 8) = hi;
    }
    __syncthreads();
  }
  bf16_t* yp = DUMMY ? (bf16_t*)(p.ws + OFF_SLAB) + (size_t)(b * S_ + tw + r) * 512 + h * 64 : PA + (size_t)(b * S_ + tw + r) * PA_LD + PA_QB + h * 64;
#pragma unroll
  for (int rq = 0; rq < 4; ++rq) {
    u32x2 w0, w1;
    w0[0] = pack2(o0[4 * rq], o0[4 * rq + 1]); w0[1] = pack2(o0[4 * rq + 2], o0[4 * rq + 3]);
    w1[0] = pack2(o1[4 * rq], o1[4 * rq + 1]); w1[1] = pack2(o1[4 * rq + 2], o1[4 * rq + 3]);
    *(u32x2*)(yp + 8 * rq + 4 * g) = w0;
    *(u32x2*)(yp + 32 + 8 * rq + 4 * g) = w1;
  }
}

DI unsigned tokey(float f) { unsigned u = __float_as_uint(f); return (u & 0x80000000u) ? ~u : (u | 0x80000000u); }
DI int wave_count_sum(int c) {
  int tot = 0;
#pragma unroll
  for (int bt = 0; bt < 7; ++bt) tot += __builtin_popcountll(__ballot((c >> bt) & 1)) << bt;
  return tot;
}

DI void idx_item(const Params& p, int b, int qt, char* smem) {
  bf16_t* PA = (bf16_t*)(p.ws + OFF_PA);
  const bf16_t* QI = (const bf16_t*)(p.ws + OFF_H) + (size_t)T_ * 512;
  const float* WI = (const float*)(p.ws + OFF_WIDX);
  float* slab = (float*)(p.ws + OFF_SLAB) + (size_t)blockIdx.x * 16 * 4096;
  const int tid = otid(), lane = tid & 63, wid = owid(tid), g4 = lane >> 4, r = lane & 15;
  const int t0 = qt * 16;
  {
    bf16x8 qf[8][2]; float w[8];
    const bf16_t* qp = QI + (size_t)(b * S_ + t0 + r) * 512 + g4 * 8;
#pragma unroll
    for (int hh = 0; hh < 8; ++hh) { qf[hh][0] = ld_frag_g(qp + hh * 64); qf[hh][1] = ld_frag_g(qp + hh * 64 + 32); }
    {
      const float4* wp = (const float4*)(WI + (size_t)(b * S_ + t0 + r) * 8);
      float4 wa = wp[0], wb = wp[1];
      w[0] = wa.x; w[1] = wa.y; w[2] = wa.z; w[3] = wa.w; w[4] = wb.x; w[5] = wb.y; w[6] = wb.z; w[7] = wb.w;
    }
    const int nkt = qt + 1;
    const bf16_t* kbase = PA + (size_t)(b * S_ + r) * PA_LD + PA_KI + g4 * 8;
    bf16x8 k0, k1;
    {
      int kt = wid < nkt ? wid : 0;
      const bf16_t* kp = kbase + (size_t)(kt * 16) * PA_LD;
      k0 = ld_frag_g(kp); k1 = ld_frag_g(kp + 32);
    }
    for (int kt = wid; kt < nkt; kt += NWAVE) {
      bf16x8 n0, n1;
      {
        int kn = kt + NWAVE < nkt ? kt + NWAVE : kt;
        const bf16_t* kp = kbase + (size_t)(kn * 16) * PA_LD;
        n0 = ld_frag_g(kp); n1 = ld_frag_g(kp + 32);
      }
      f32x4 sc = {0.f, 0.f, 0.f, 0.f};
#pragma unroll
      for (int hh = 0; hh < 8; ++hh) {
        f32x4 c = {0.f, 0.f, 0.f, 0.f};
        c = MFMA16(k0, qf[hh][0], c);
        c = MFMA16(k1, qf[hh][1], c);
#pragma unroll
        for (int i = 0; i < 4; ++i) sc[i] += w[hh] * fmaxf(c[i], 0.f);
      }
      *(f32x4*)(slab + (size_t)r * 4096 + kt * 16 + 4 * g4) = sc;
      k0 = n0; k1 = n1;
    }
  }
  __syncthreads();
  for (int qi = 0; qi < 2; ++qi) {
    const int q = wid * 2 + qi;
    const int t = t0 + q, n = t + 1;
    unsigned short* out = (unsigned short*)(PA + (size_t)(b * S_ + t) * PA_LD);
    if (n <= 256) {
#pragma unroll
      for (int j = 0; j < 4; ++j) { int e = j * 64 + lane; out[e] = (unsigned short)(e < n ? e : 0); }
      continue;
    }
    const float* row = slab + (size_t)q * 4096 + lane;
    const int nj = (n + 63) >> 6;
    unsigned key[64];
#pragma unroll
    for (int ch = 0; ch < 4; ++ch) {
#pragma unroll
      for (int jj = 0; jj < 16; ++jj) key[ch * 16 + jj] = 0u;
      if (nj > ch * 16) {
#pragma unroll
        for (int jj = 0; jj < 16; ++jj) { const int j = ch * 16 + jj; if (j * 64 + lane < n) key[j] = tokey(row[j * 64]); }
      }
    }
    unsigned Tthr = 0u; int need = 0; bool exact = false;
    for (int bit = 31; bit >= 0; --bit) {
      const unsigned cand = Tthr | (1u << bit);
      int c = 0;
#pragma unroll
      for (int ch = 0; ch < 4; ++ch) {
        if (nj > ch * 16) {
#pragma unroll
          for (int jj = 0; jj < 16; ++jj) c += (key[ch * 16 + jj] >= cand) ? 1 : 0;
        }
      }
      const int cnt = wave_count_sum(c);
      if (cnt >= 256) Tthr = cand;
      if (cnt == 256) { exact = true; break; }
    }
    unsigned Tgt;
    if (exact) { Tgt = Tthr - 1u; need = 0; }
    else {
      int c = 0;
#pragma unroll
      for (int j = 0; j < 64; ++j) c += (key[j] > Tthr) ? 1 : 0;
      Tgt = Tthr; need = 256 - wave_count_sum(c);
    }
    const unsigned long long lt_mask = (1ull << lane) - 1ull;
    int base = 0, ties = 0;
#pragma unroll
    for (int j = 0; j < 64; ++j) {
      if (j < nj) {
        const bool gt = key[j] > Tgt;
        const bool eq = (!exact) && (key[j] == Tthr);
        const unsigned long long meq = __ballot(eq);
        const int myrank = ties + __builtin_popcountll(meq & lt_mask);
        const bool sel = gt || (eq && myrank < need);
        ties += __builtin_popcountll(meq);
        const unsigned long long ms = __ballot(sel);
        const int pos = base + __builtin_popcountll(ms & lt_mask);
        if (sel && pos < 256) out[pos] = (unsigned short)(j * 64 + lane);
        base += __builtin_popcountll(ms);
      }
    }
  }
  __syncthreads();
}

DI void phase_sb_dummy(const Params& p, char* smem) {
  unsigned* cnt = (unsigned*)(p.ws + OFF_CNT) + 16;
  int* s_item = (int*)(smem + SMEM_BYTES - 16);
  while (true) {
    if (otid() == 0) *s_item = (int)atomicAdd(cnt, 1u);
    __syncthreads();
    const int item = *s_item;
    __syncthreads();
    if (item >= 64 * 16) break;
    int qb = 15 - (item >> 6), bh = item & 63;
    sb_item<true>(p, bh >> 3, bh & 7, qb, smem);
  }
}

template <bool IDX_ONLY>
DI void phase_mix(const Params& p, char* smem) {
  unsigned* cnt = (unsigned*)(p.ws + OFF_CNT) + (IDX_ONLY ? 8 : 0);
  int* s_item = (int*)(smem + SMEM_BYTES - 16);
  constexpr int NSB = 64 * 16, NIDX = 8 * 256;
  while (true) {
    if (otid() == 0) *s_item = (int)atomicAdd(cnt, 1u);
    __syncthreads();
    const int item = *s_item;
    __syncthreads();
    if (IDX_ONLY) { if (item >= NIDX) break; int qt = 255 - (item >> 3), b = item & 7; idx_item(p, b, qt, smem); continue; }
    if (item >= NSB + NIDX) break;
    if (item < NSB) {
      int qb = 15 - (item >> 6), bh = item & 63;
      sb_item<false>(p, bh >> 3, bh & 7, qb, smem);
    } else {
      int j = item - NSB;
      int qt = 255 - (j >> 3), b = j & 7;
      idx_item(p, b, qt, smem);
    }
  }
}

DI void phase_sparse(const Params& p, char* smem) {
  const bf16_t* PA = (const bf16_t*)(p.ws + OFF_PA);
  const bf16_t* QA = (const bf16_t*)(p.ws + OFF_H);
  bf16_t* YA = (bf16_t*)(p.ws + OFF_SLAB + (size_t)64 * 1024 * 1024);
  const bf16_t* WUVb = (const bf16_t*)(p.ws + OFF_WB) + WUV;
  const int tid = otid(), lane = tid & 63, wid = owid(tid), g4 = lane >> 4, c = lane & 15;
  float* Pl = (float*)(smem + wid * 9280);
  int* Il = (int*)(smem + wid * 9280 + 8192);
  float* Sl = (float*)(smem + wid * 9280 + 9216);
  float* Pq = Pl + g4 * 32 + c;
  char* OL = smem + 8 * 9280;
  const float sc2 = 0.125f * LOG2E;
  for (int it = blockIdx.x; it < T_ / 16; it += gridDim.x) {
    const int tok0 = it * 16;
    const int b = tok0 >> 12;
    for (int qi = 0; qi < 2; ++qi) {
      const int q = wid * 2 + qi;
      const int tok = tok0 + q, t = tok & (S_ - 1);
      const int nsel = t + 1 < 256 ? t + 1 : 256;
      const unsigned short* irow = (const unsigned short*)(PA + (size_t)tok * PA_LD);
#pragma unroll
      for (int j = 0; j < 4; ++j) { int e = j * 64 + lane; int v = irow[e]; Il[e] = e < nsel ? v : 0; }
      __syncthreads();
      bf16x8 qf0, qf1;
      {
        u32x4 z4 = {0u, 0u, 0u, 0u};
        qf0 = __builtin_bit_cast(bf16x8, z4); qf1 = qf0;
        if (c < 8) { const bf16_t* qp = QA + (size_t)tok * 512 + c * 64 + g4 * 8; qf0 = ld_frag_g(qp); qf1 = ld_frag_g(qp + 32); }
      }
      float m = -INFINITY;
#pragma nounroll
      for (int kg = 0; kg < 4; ++kg) {
        bf16x8 ka[4][2];
#pragma unroll
        for (int k4 = 0; k4 < 4; ++k4) {
          int key = (Il + c)[(kg * 4 + k4) * 16];
          const bf16_t* kp = PA + (size_t)(b * S_ + key) * PA_LD + PA_KA + g4 * 8;
          ka[k4][0] = ld_frag_g(kp); ka[k4][1] = ld_frag_g(kp + 32);
        }
#pragma unroll
        for (int k4 = 0; k4 < 4; ++k4) {
          f32x4 cc = {0.f, 0.f, 0.f, 0.f};
          cc = MFMA16(ka[k4][0], qf0, cc);
          cc = MFMA16(ka[k4][1], qf1, cc);
#pragma unroll
          for (int i = 0; i < 4; ++i) {
            const int ec = (kg * 4 + k4) * 16 + i;
            float v = ec + 4 * g4 < nsel ? cc[i] : -INFINITY;
            m = fmaxf(m, v);
            if (c < 8) Pq[ec * 8] = v;
          }
        }
        __builtin_amdgcn_sched_barrier(0);
      }
      m = fmaxf(m, __shfl_xor(m, 16)); m = fmaxf(m, __shfl_xor(m, 32));
      float sum = 0.f;
      if (c < 8) {
#pragma unroll 4
        for (int kt = 0; kt < 16; ++kt)
#pragma unroll
          for (int i = 0; i < 4; ++i) {
            const int ec = kt * 16 + i;
            float pv = fexp2((Pq[ec * 8] - m) * sc2);
            Pq[ec * 8] = pv; sum += pv;
          }
      }
      sum += __shfl_xor(sum, 16); sum += __shfl_xor(sum, 32);
      if (lane < 8) Sl[lane] = 1.f / sum;
      __syncthreads();
      f32x2_t acc[8];
#pragma unroll
      for (int hh = 0; hh < 8; ++hh) acc[hh] = f32x2_t{0.f, 0.f};
      const char* vrow = (const char*)(PA + (size_t)b * S_ * PA_LD + PA_VA);
      const unsigned voff = (unsigned)lane * 4u;
      const int nk16 = (nsel + 15) & ~15;
      unsigned va[16], vb[16];
#define PV_LOAD(dst, k0_) _Pragma("unroll") for (int kk = 0; kk < 16; ++kk) { \
          int key = __builtin_amdgcn_readfirstlane(Il[(k0_) + kk]); dst[kk] = *(const unsigned*)((vrow + (size_t)key * (PA_LD * 2)) + voff); }
#define PV_ACC(srcv, k0_) _Pragma("unroll") for (int kk = 0; kk < 16; ++kk) { \
          const f32x4 pa = *(const f32x4*)(Pl + ((k0_) + kk) * 8), pb = *(const f32x4*)(Pl + ((k0_) + kk) * 8 + 4); \
          const f32x2_t v2 = {bflo(srcv[kk]), bfhi(srcv[kk])}; \
          _Pragma("unroll") for (int hh = 0; hh < 4; ++hh) { acc[hh] += pa[hh] * v2; acc[hh + 4] += pb[hh] * v2; } }
      PV_LOAD(va, 0);
      for (int k0 = 0; k0 < nk16; k0 += 32) {
        const bool m1 = k0 + 16 < nk16, m2 = k0 + 32 < nk16;
        if (m1) { PV_LOAD(vb, k0 + 16); }
        PV_ACC(va, k0);
        if (m2) { PV_LOAD(va, k0 + 32); }
        if (m1) { PV_ACC(vb, k0 + 16); }
      }
#undef PV_LOAD
#undef PV_ACC
#pragma unroll
      for (int hh = 0; hh < 8; ++hh) { const float iv = Sl[hh]; *(unsigned*)(OL + q * 2064 + hh * 256 + lane * 4) = pack2(acc[hh][0] * iv, acc[hh][1] * iv); }
      __syncthreads();
    }
    {
      const int h = wid;
      bf16x8 af[4];
#pragma unroll
      for (int ks = 0; ks < 4; ++ks) af[ks] = ld_frag_s(OL + c * 2064 + h * 256 + (ks * 32 + g4 * 8) * 2);
#pragma nounroll
      for (int nt = 0; nt < 4; ++nt) {
        f32x4 cc = {0.f, 0.f, 0.f, 0.f};
        const bf16_t* wp = WUVb + (size_t)(h * 64 + nt * 16 + c) * 128 + g4 * 8;
#pragma unroll
        for (int ks = 0; ks < 4; ++ks) cc = MFMA16(af[ks], ld_frag_g(wp + ks * 32), cc);
#pragma unroll
        for (int i = 0; i < 4; ++i) YA[(size_t)(tok0 + 4 * g4 + i) * 512 + h * 64 + nt * 16 + c] = (bf16_t)f2bf(cc[i]);
      }
    }
    __syncthreads();
  }
}

DI void phase_merge(const Params& p, char* smem) {
  const bf16_t* YA = (const bf16_t*)(p.ws + OFF_SLAB + (size_t)64 * 1024 * 1024);
  const bf16_t* YB = (const bf16_t*)(p.ws + OFF_PA) + PA_QB;
  const bf16_t* Wa = (const bf16_t*)(p.ws + OFF_WB) + WOA;
  const bf16_t* Wb = (const bf16_t*)(p.ws + OFF_WB) + WOB;
  const bf16_t* GT = (const bf16_t*)(p.ws + OFF_GATES);
  bf16_t* MG = (bf16_t*)(p.ws + OFF_SLAB);
  for (int it = 0;; ++it) {
    int mt, nt; int s = sched_tile(it, 128, 4, mt, nt);
    if (s < 0) break; if (s == 0) continue;
    acc8p_t acc;
    gemm8p<512, 512, 8>(YA + (size_t)mt * 256 * 512, Wa + (size_t)nt * 256 * 512, smem, acc);
    EPI_IDS
    const unsigned goff = (unsigned)((wr * 64 + fq * 4) * 2048 + wc * 32 + fr);
    const unsigned loff = (unsigned)((wr * 64 + fq * 4) * D_ + wc * 32 + fr);
    const bf16_t* gp = GT + (size_t)(mt * 256) * 2048 + nt * 256;
    bf16_t* tp = MG + (size_t)(mt * 256) * D_ + nt * 256;
    EPI_FOR {
      const int lr = LROW(ai, m, j), lc = LCOL(bj, n);
      float ga = bf2f((gp + lr * 2048 + lc)[goff]);
      (tp + lr * D_ + lc)[loff] = (bf16_t)f2bf(ga * acc[ai][bj][m][n][j]);
    }
  }
  for (int it = 0;; ++it) {
    int mt, nt; int s = sched_tile(it, 128, 4, mt, nt);
    if (s < 0) break; if (s == 0) continue;
    acc8p_t acc;
    gemm8p<PA_LD, 512, 8>(YB + (size_t)mt * 256 * PA_LD, Wb + (size_t)nt * 256 * 512, smem, acc);
    EPI_IDS
    const unsigned goff = (unsigned)((wr * 64 + fq * 4) * 2048 + wc * 32 + fr);
    const unsigned loff = (unsigned)((wr * 64 + fq * 4) * D_ + wc * 32 + fr);
    const bf16_t* gp = GT + (size_t)(mt * 256) * 2048 + 1024 + nt * 256;
    bf16_t* tp = MG + (size_t)(mt * 256) * D_ + nt * 256;
    EPI_FOR {
      const int lr = LROW(ai, m, j), lc = LCOL(bj, n);
      float gb = bf2f((gp + lr * 2048 + lc)[goff]);
      bf16_t* e = (tp + lr * D_ + lc) + loff;
      *e = (bf16_t)f2bf(bf2f(*e) + gb * acc[ai][bj][m][n][j]);
    }
  }
}

DI void phase_outproj(const Params& p, char* smem) {
  const bf16_t* MG = (const bf16_t*)(p.ws + OFF_SLAB);
  const bf16_t* W = (const bf16_t*)(p.ws + OFF_WB) + WOUT;
  float* out = p.out;
  for (int it = 0;; ++it) {
    int mt, nt; int s = sched_tile(it, 128, 4, mt, nt);
    if (s < 0) break; if (s == 0) continue;
    acc8p_t acc;
    gemm8p<D_, D_, 16>(MG + (size_t)mt * 256 * D_, W + (size_t)nt * 256 * D_, smem, acc);
    EPI_IDS
    float* tp = out + (size_t)(mt * 256) * D_ + nt * 256;
    const unsigned loff = (unsigned)((wr * 64 + fq * 4) * D_ + wc * 32 + fr);
    EPI_FOR {
      const int ro = LROW(ai, m, j) * D_ + LCOL(bj, n);
      (tp + ro)[loff] = (tp + ro)[loff] + acc[ai][bj][m][n][j];
    }
  }
}

#define XB_TMO      128
#define XB_XCNT(j)  (256  + 64 * (j))
#define XB_XSUB(j)  (1280 + 64 * (j))
#define XB_XGEN(j)  (2304 + 64 * (j))
#define XB_TOP      3328
#define XB_TOPGEN   3392
#define XCD_BAR_WORDS 3456
#define XB_SPIN_CAP (1u << 22)
#define LAS __attribute__((address_space(3)))
DI unsigned xb_ld(unsigned* p) { return __hip_atomic_load(p, __ATOMIC_RELAXED, __HIP_MEMORY_SCOPE_AGENT); }
DI unsigned xb_add(unsigned* p, unsigned v) { return __hip_atomic_fetch_add(p, v, __ATOMIC_RELAXED, __HIP_MEMORY_SCOPE_AGENT); }
DI unsigned xb_xcc_id() { return (unsigned)__builtin_amdgcn_s_getreg((3 << 11) | 20) & 0xFu; }
#define XB_SPIN(cond, bar) do { unsigned _sp = 0; while (cond) { __builtin_amdgcn_s_sleep(1); \
    if ((++_sp & 255u) == 0u) { if (xb_ld(&(bar)[XB_TMO])) break; if (_sp > XB_SPIN_CAP) { atomicAdd(&(bar)[XB_TMO], 1u); break; } } } } while (0)
struct XcdBarrier { unsigned* bar; unsigned x; volatile LAS unsigned* st; };
DI XcdBarrier xcd_barrier_post(unsigned* bar, volatile LAS unsigned* st) {
  XcdBarrier b; b.bar = bar; b.x = xb_xcc_id(); b.st = st;
  if (threadIdx.x == 0) (void)xb_add(&bar[XB_XCNT(b.x)], 1u);
  return b;
}
DI void xcd_barrier_complete(unsigned* bar, unsigned x, unsigned& nloc, unsigned& nx) {
  const unsigned G = gridDim.x * gridDim.y * gridDim.z;
  unsigned sum, cnt, mine, sp = 0u;
  for (;;) {
    sum = 0u; cnt = 0u; mine = 0u;
#pragma unroll
    for (unsigned j = 0; j < 16; ++j) { const unsigned c = xb_ld(&bar[XB_XCNT(j)]); sum += c; cnt += (c > 0u) ? 1u : 0u; mine = (j == x) ? c : mine; }
    if (sum == G) break;
    __builtin_amdgcn_s_sleep(1);
    if ((++sp & 255u) == 0u) { if (xb_ld(&bar[XB_TMO])) break; if (sp > XB_SPIN_CAP) { atomicAdd(&bar[XB_TMO], 1u); break; } }
  }
  nloc = mine > 0u ? mine : 1u; nx = cnt > 0u ? cnt : 1u;
}
DI void xcd_barrier(const XcdBarrier& b) {
  asm volatile("s_waitcnt vmcnt(0)" ::: "memory");
  __syncthreads();
  if (threadIdx.x == 0) {
    unsigned* bar = b.bar;
    __builtin_amdgcn_s_waitcnt(0);
    unsigned nloc = b.st[0], nx = b.st[1];
    if (nloc == 0u) { xcd_barrier_complete(bar, b.x, nloc, nx); b.st[0] = nloc; b.st[1] = nx; }
    const unsigned old = xb_add(&bar[XB_XSUB(b.x)], 1u);
    const unsigned gen = old / nloc;
    if (old + 1u == (gen + 1u) * nloc) {
      __builtin_amdgcn_fence(__ATOMIC_RELEASE, "agent");
      asm volatile("s_waitcnt vmcnt(0)" ::: "memory");
      const unsigned og = xb_add(&bar[XB_TOP], 1u);
      const unsigned tg = og / nx;
      if (og + 1u == (tg + 1u) * nx) xb_add(&bar[XB_TOPGEN], 1u);
      else XB_SPIN(xb_ld(&bar[XB_TOPGEN]) == tg, bar);
      __builtin_amdgcn_fence(__ATOMIC_ACQUIRE, "agent");
      xb_add(&bar[XB_XGEN(b.x)], 1u);
      asm volatile("s_waitcnt vmcnt(0)" ::: "memory");
    } else {
      XB_SPIN(xb_ld(&bar[XB_XGEN(b.x)]) == gen, bar);
      __builtin_amdgcn_fence(__ATOMIC_ACQUIRE, "agent");
      asm volatile("s_waitcnt vmcnt(0)" ::: "memory");
    }
  }
  __syncthreads();
}

DI void run_phase(const Params& p, int ph, char* smem) {
  switch (ph) {
    case 0: phase_prep(p, smem); break;
    case 1: phase_ffn_gu(p, W1GU, smem); break;
    case 2: phase_ffn_down(p, W1D, p.x, smem); break;
    case 3: phase_rmsnorm(p.out, p.g_mix, (bf16_t*)(p.ws + OFF_H)); break;
    case 4: phase_win(p, smem); break;
    case 5: phase_qproj(p, smem); break;
    case 6: phase_mix<false>(p, smem); break;
    case 13: phase_mix<true>(p, smem); break;
    case 14: phase_sb_dummy(p, smem); break;
    case 7: phase_sparse(p, smem); break;
    case 8: phase_merge(p, smem); break;
    case 9: phase_outproj(p, smem); break;
    case 10: phase_rmsnorm(p.out, p.g_ffn2, (bf16_t*)(p.ws + OFF_H)); break;
    case 11: phase_ffn_gu(p, W2GU, smem); break;
    case 12: phase_ffn_down(p, W2D, p.out, smem); break;
  }
}
constexpr int NPHASE = 13;

#if !MULTI_LAUNCH
__global__ void __launch_bounds__(512, 2) mega_kernel(Params p) {
  __shared__ __attribute__((aligned(16))) char smem[SMEM_BYTES];
  __shared__ uint4 xb_words;
  cg::grid_group grid = cg::this_grid();
  if (threadIdx.x == 0) xb_words = make_uint4(0u, 0u, 0u, 0u);
  __syncthreads();
  XcdBarrier xb = xcd_barrier_post((unsigned*)(p.ws + OFF_CNT + 256), (volatile LAS unsigned*)&xb_words);
  unsigned* bar0 = (unsigned*)(p.ws + OFF_CNT + 256);
  if (threadIdx.x == 0) g_sched[3] = (int)xb_add(&bar0[XB_XCNT(xb.x) + 16], 1u);
  grid.sync();
  if (threadIdx.x == 0) {
    const unsigned per = gridDim.x >> 3; bool ok = (gridDim.x & 7) == 0 && xb.x < 8;
    for (unsigned jx = 0; jx < 16; ++jx) { const unsigned c = xb_ld(&bar0[XB_XCNT(jx) + 16]); ok = ok && (c == (jx < 8 ? per : 0u)); }
    g_sched[0] = ok ? (int)xb.x : (int)(blockIdx.x & 7);
    g_sched[1] = ok ? g_sched[3] : (int)(blockIdx.x >> 3);
  }
  __syncthreads();
#pragma nounroll
  for (int ph = 0; ph < NPHASE; ++ph) {
    int phv = ph; asm volatile("" : "+s"(phv));
    run_phase(p, phv, smem);
    if (ph + 1 < NPHASE) xcd_barrier(xb);
  }
}
#else
template <int PH>
__global__ void __launch_bounds__(512, 2) phase_kernel(Params p) {
  __shared__ __attribute__((aligned(16))) char smem[SMEM_BYTES];
  if (threadIdx.x == 0) { g_sched[0] = blockIdx.x & 7; g_sched[1] = blockIdx.x >> 3; }
  __syncthreads();
  run_phase(p, PH, smem);
}
#ifndef PROBE_MASK
#define PROBE_MASK 0
#endif
template <int PH> static void launch_phases(const Params& p, hipStream_t stream) {
  hipLaunchKernelGGL(phase_kernel<PH>, dim3(256), dim3(NTHR), 0, stream, p);
  if constexpr (((PROBE_MASK >> PH) & 1) != 0 && PH != 6) hipLaunchKernelGGL(phase_kernel<PH>, dim3(256), dim3(NTHR), 0, stream, p);
  if constexpr (((PROBE_MASK >> PH) & 1) != 0 && PH == 6) hipLaunchKernelGGL(phase_kernel<13>, dim3(256), dim3(NTHR), 0, stream, p);
  if constexpr (((PROBE_MASK >> 14) & 1) != 0 && PH == 5) hipLaunchKernelGGL(phase_kernel<14>, dim3(256), dim3(NTHR), 0, stream, p);
  if constexpr (PH + 1 < NPHASE) launch_phases<PH + 1>(p, stream);
}
#endif

extern "C" void kernel_launch(void* const* d_in, const int* in_sizes, int n_in, void* d_out, int out_size, void* d_ws,
                              size_t ws_size, hipStream_t stream) {
  Params p{};
  p.x = (const float*)d_in[0]; p.pos = (const int*)d_in[1];
  p.g_ffn1 = (const float*)d_in[2]; p.w1g = (const float*)d_in[3]; p.w1u = (const float*)d_in[4]; p.w1d = (const float*)d_in[5];
  p.g_mix = (const float*)d_in[6]; p.w_in = (const float*)d_in[7]; p.g_cq = (const float*)d_in[8]; p.w_uq = (const float*)d_in[9];
  p.w_qi = (const float*)d_in[10]; p.g_qa = (const float*)d_in[11]; p.g_ka = (const float*)d_in[12]; p.w_uv = (const float*)d_in[13];
  p.w_oa = (const float*)d_in[14]; p.w_ob = (const float*)d_in[15]; p.w_out = (const float*)d_in[16]; p.g_ffn2 = (const float*)d_in[17];
  p.w2g = (const float*)d_in[18]; p.w2u = (const float*)d_in[19]; p.w2d = (const float*)d_in[20];
  p.out = (float*)d_out; p.ws = (char*)d_ws;
  if (ws_size < WS_NEED) { fprintf(stderr, "workspace too small: %zu < %zu\n", ws_size, (size_t)WS_NEED); return; }
  (void)hipMemsetAsync((char*)d_ws + OFF_CNT, 0, 256 + 16384, stream);
#if MULTI_LAUNCH
  launch_phases<0>(p, stream);
#else
  static int grid_blocks = 0;
  if (!grid_blocks) {
    int dev = 0, cus = 0, per_cu = 0;
    (void)hipGetDevice(&dev);
    (void)hipDeviceGetAttribute(&cus, hipDeviceAttributeMultiprocessorCount, dev);
    (void)hipOccupancyMaxActiveBlocksPerMultiprocessor(&per_cu, mega_kernel, NTHR, 0);
    if (per_cu > 1) per_cu = 1;
    grid_blocks = cus * per_cu;
    if (grid_blocks > 256) grid_blocks = 256;
  }
  void* args[] = {&p};
  hipError_t e = hipLaunchCooperativeKernel((void*)mega_kernel, dim3(grid_blocks), dim3(NTHR), args, 0, stream);
  if (e != hipSuccess) fprintf(stderr, "cooperative launch failed: %s (grid %d)\n", hipGetErrorString(e), grid_blocks);
#endif
}
```

```cpp
#include <hip/hip_runtime.h>
#include <hip/hip_cooperative_groups.h>
#include <stdint.h>
#include <stdio.h>
namespace cg = cooperative_groups;

#ifndef MULTI_LAUNCH
#define MULTI_LAUNCH 0
#endif

#define DI __device__ __forceinline__
typedef unsigned short bf16_t;
typedef __attribute__((ext_vector_type(8))) short bf16x8;
typedef __attribute__((ext_vector_type(16))) float f32x16;
typedef __attribute__((ext_vector_type(4))) float f32x4;
typedef __attribute__((ext_vector_type(4))) unsigned u32x4;
typedef __attribute__((ext_vector_type(2))) unsigned u32x2;

constexpr int T_ = 32768, S_ = 4096, D_ = 1024, FF = 2816;
constexpr int PA_LD = 1536;
constexpr int PA_KA = 256, PA_VA = 320, PA_KI = 448, PA_QB = 512, PA_KB = 1024;
constexpr float EPS = 1e-6f;
constexpr float LOG2E = 1.4426950408889634f;

constexpr size_t W1GU = 0;
constexpr size_t W1D = W1GU + (size_t)5632 * 1024;
constexpr size_t W2GU = W1D + (size_t)1024 * 2816;
constexpr size_t W2D = W2GU + (size_t)5632 * 1024;
constexpr size_t WIN = W2D + (size_t)1024 * 2816;
constexpr size_t WQ = WIN + (size_t)4096 * 1024;
constexpr size_t WUV = WQ + (size_t)1024 * 256;
constexpr size_t WOA = WUV + (size_t)512 * 128;
constexpr size_t WOB = WOA + (size_t)1024 * 512;
constexpr size_t WOUT = WOB + (size_t)1024 * 512;
constexpr size_t WB_ELEMS = WOUT + (size_t)1024 * 1024;
constexpr size_t OFF_WB = 0;
constexpr size_t OFF_H = (WB_ELEMS * 2 + 255) & ~(size_t)255;
constexpr size_t OFF_PA = OFF_H + (size_t)T_ * 1024 * 2;
constexpr size_t OFF_VT = OFF_PA + (size_t)T_ * PA_LD * 2;
constexpr size_t OFF_GATES = OFF_VT + (size_t)T_ * 512 * 2;
constexpr size_t OFF_SLAB = OFF_GATES + (size_t)T_ * 2048 * 2;
constexpr size_t OFF_WIDX = OFF_SLAB + (size_t)512 * 16 * 4096 * 4;
constexpr size_t OFF_ROPE = OFF_WIDX + (size_t)T_ * 8 * 4;
constexpr size_t OFF_CNT = OFF_ROPE + (size_t)T_ * 32 * 8;
constexpr size_t WS_NEED = OFF_CNT + 256 + 16384;
static_assert(WS_NEED <= (size_t)512 * 1024 * 1024, "workspace too large");
static_assert((size_t)T_ * FF * 2 <= OFF_SLAB - OFF_PA, "U must fit in PA+VT+GATES");

constexpr int SMEM_BYTES = 131072 + 2048;
__shared__ int g_sched[4];
constexpr int NTHR = 512, NWAVE = 8;

struct Params {
  const float* x; const int* pos;
  const float *g_ffn1, *w1g, *w1u, *w1d, *g_mix, *w_in, *g_cq, *w_uq, *w_qi, *g_qa, *g_ka, *w_uv, *w_oa, *w_ob, *w_out, *g_ffn2, *w2g, *w2u, *w2d;
  float* out;
  char* ws;
};

typedef __attribute__((ext_vector_type(2))) __bf16 bf16x2_t;
typedef __attribute__((ext_vector_type(2))) float f32x2_t;
DI unsigned pack2(float a, float b) { f32x2_t v = {a, b}; return __builtin_bit_cast(unsigned, __builtin_convertvector(v, bf16x2_t)); }
DI unsigned f2bf(float x) { return pack2(x, 0.f) & 0xffffu; }
DI float bf2f(unsigned v) { return __uint_as_float(v << 16); }
DI float bflo(unsigned v) { return __uint_as_float(v << 16); }
DI float bfhi(unsigned v) { return __uint_as_float(v & 0xffff0000u); }
DI float fexp2(float x) { return __builtin_amdgcn_exp2f(x); }
DI float frcp(float x) { return __builtin_amdgcn_rcpf(x); }
DI float wave_sum(float v) {
#pragma unroll
  for (int o = 32; o > 0; o >>= 1) v += __shfl_xor(v, o);
  return v;
}
#define MFMA32(a, b, c) __builtin_amdgcn_mfma_f32_32x32x16_bf16((a), (b), (c), 0, 0, 0)
#define MFMA16(a, b, c) __builtin_amdgcn_mfma_f32_16x16x32_bf16((a), (b), (c), 0, 0, 0)
DI bf16x8 ld_frag_g(const bf16_t* p) { return __builtin_bit_cast(bf16x8, *(const u32x4*)p); }
DI bf16x8 ld_frag_s(const char* p) { return __builtin_bit_cast(bf16x8, *(const u32x4*)p); }
DI int otid() { int t = threadIdx.x; asm volatile("" : "+v"(t)); return t; }
DI int owid(int tid) { return __builtin_amdgcn_readfirstlane(tid >> 6); }
DI int crow(int reg, int g) { return (reg & 3) + 8 * (reg >> 2) + 4 * g; }

DI const float* prep_col(const Params& p, int mat, int r, int& ld) {
  switch (mat) {
    case 0: case 2: {
      int j = r >> 8, q = r & 255; int half = q >> 7, c = q & 127;
      int n = j * 128 + c; ld = FF;
      const float* g = mat == 0 ? p.w1g : p.w2g; const float* u = mat == 0 ? p.w1u : p.w2u;
      return (half ? u : g) + n;
    }
    case 1: ld = D_; return p.w1d + r;
    case 3: ld = D_; return p.w2d + r;
    case 4: {
      ld = 4104;
      if (r < 512) return p.w_in + r;
      return p.w_in + r + 8;
    }
    case 5: {
      ld = 512;
      int T = r >> 8, q = r & 255; int hl = (q & 127) >> 5, d = (q >> 7) * 32 + (q & 31);
      int col = ((T & 1) * 4 + hl) * 64 + d;
      return (T < 2 ? p.w_uq : p.w_qi) + col;
    }
    case 6: { ld = 64; int h = r >> 6, d = r & 63; return p.w_uv + h * 8192 + d; }
    case 7: ld = D_; return p.w_oa + r;
    case 8: ld = D_; return p.w_ob + r;
    default: ld = D_; return p.w_out + r;
  }
}

DI void prep_transpose_tile(const Params& p, bool valid, int mat, int K, bf16_t* dst, int tile, float* lds, int t) {
  const int nkt = K >> 6;
  const int r0 = (tile / nkt) * 32, k0 = (tile % nkt) * 64;
  const int tx = t & 31, ty = t >> 5;
  if (valid) {
    int ld; const float* col = prep_col(p, mat, r0 + tx, ld);
#pragma unroll
    for (int i = 0; i < 8; ++i) {
      int k = k0 + ty + 8 * i;
      float v = 0.f;
      if (col) { v = col[(size_t)k * ld]; if (mat == 5) v *= p.g_cq[k]; }
      lds[tx * 65 + ty + 8 * i] = v;
    }
  }
  __syncthreads();
  if (valid) {
    const int row = t >> 3, kc = (t & 7) * 8;
    const float* s = lds + row * 65 + kc;
    u32x4 o; o[0] = pack2(s[0], s[1]); o[1] = pack2(s[2], s[3]); o[2] = pack2(s[4], s[5]); o[3] = pack2(s[6], s[7]);
    *(u32x4*)(dst + (size_t)(r0 + row) * K + k0 + kc) = o;
  }
  __syncthreads();
}

DI void rmsnorm_row(const float* __restrict__ xr, const float* __restrict__ g, bf16_t* __restrict__ o) {
  const int lane = otid() & 63;
  float4 v[4]; float ss = 0.f;
#pragma unroll
  for (int j = 0; j < 4; ++j) { v[j] = *(const float4*)(xr + lane * 4 + 256 * j); ss += v[j].x * v[j].x + v[j].y * v[j].y + v[j].z * v[j].z + v[j].w * v[j].w; }
  ss = wave_sum(ss);
  const float rs = rsqrtf(ss * (1.f / 1024.f) + EPS);
#pragma unroll
  for (int j = 0; j < 4; ++j) {
    float4 gg = *(const float4*)(g + lane * 4 + 256 * j);
    u32x2 w; w[0] = pack2(v[j].x * rs * gg.x, v[j].y * rs * gg.y); w[1] = pack2(v[j].z * rs * gg.z, v[j].w * rs * gg.w);
    *(u32x2*)(o + lane * 4 + 256 * j) = w;
  }
}

DI void phase_rmsnorm(const float* __restrict__ src, const float* __restrict__ g, bf16_t* __restrict__ dst) {
  const int wid = owid(otid());
  for (int it = blockIdx.x; it < T_ / NWAVE; it += gridDim.x) {
    int row = it * NWAVE + wid;
    rmsnorm_row(src + (size_t)row * D_, g, dst + (size_t)row * D_);
  }
}

DI void phase_rmsnorm_widx(const Params& p, char* smem) {
  const int tid = otid(), lane = tid & 63, wid = owid(tid);
  float* wl = (float*)smem;
  for (int e = tid; e < 8 * 1024; e += NTHR) { int k = e >> 3, h = e & 7; wl[h * 1024 + k] = p.w_in[(size_t)k * 4104 + 512 + h]; }
  __syncthreads();
  const float* src = p.out; const float* g = p.g_mix;
  bf16_t* dst = (bf16_t*)(p.ws + OFF_H);
  float* WI = (float*)(p.ws + OFF_WIDX);
  for (int it = blockIdx.x; it < T_ / NWAVE; it += gridDim.x) {
    const int row = it * NWAVE + wid;
    const float* xr = src + (size_t)row * D_;
    float4 v[4]; float ss = 0.f;
#pragma unroll
    for (int j = 0; j < 4; ++j) { v[j] = *(const float4*)(xr + lane * 4 + 256 * j); ss += v[j].x * v[j].x + v[j].y * v[j].y + v[j].z * v[j].z + v[j].w * v[j].w; }
    ss = wave_sum(ss);
    const float rs = rsqrtf(ss * (1.f / 1024.f) + EPS);
    float acc[8];
#pragma unroll
    for (int h = 0; h < 8; ++h) acc[h] = 0.f;
#pragma unroll
    for (int j = 0; j < 4; ++j) {
      float4 gg = *(const float4*)(g + lane * 4 + 256 * j);
      const float y0 = v[j].x * rs * gg.x, y1 = v[j].y * rs * gg.y, y2 = v[j].z * rs * gg.z, y3 = v[j].w * rs * gg.w;
      u32x2 w; w[0] = pack2(y0, y1); w[1] = pack2(y2, y3);
      *(u32x2*)(dst + (size_t)row * D_ + lane * 4 + 256 * j) = w;
#pragma unroll
      for (int h = 0; h < 8; ++h) {
        const f32x4 ww = *(const f32x4*)(wl + h * 1024 + lane * 4 + 256 * j);
        acc[h] += y0 * ww[0] + y1 * ww[1] + y2 * ww[2] + y3 * ww[3];
      }
    }
#pragma unroll
    for (int h = 0; h < 8; ++h) acc[h] = wave_sum(acc[h]);
    if (lane < 8) {
      float r = acc[0];
#pragma unroll
      for (int h = 1; h < 8; ++h) r = lane == h ? acc[h] : r;
      WI[(size_t)row * 8 + lane] = r * 0.04419417382415922f;
    }
  }
  __syncthreads();
}

DI void phase_prep(const Params& p, char* smem) {
  bf16_t* wb = (bf16_t*)(p.ws + OFF_WB);
  const int tid = otid(), vb = tid >> 8, t = tid & 255;
  float* lds = (float*)smem + vb * 2112;
  constexpr int c0 = 2816, c1 = c0 + 1408, c2 = c1 + 2816, c3 = c2 + 1408, c4 = c3 + 2048, c5 = c4 + 128, c6 = c5 + 32, c7 = c6 + 256, c8 = c7 + 256, c9 = c8 + 512;
  static_assert((c9 & 1) == 0, "pairs");
  for (int it0 = blockIdx.x; it0 < c9 / 2; it0 += gridDim.x) {
    const int it = it0 * 2 + vb;
    int mat, K, base; size_t off;
    if (it < c0) { mat = 0; K = 1024; base = 0; off = W1GU; }
    else if (it < c1) { mat = 1; K = 2816; base = c0; off = W1D; }
    else if (it < c2) { mat = 2; K = 1024; base = c1; off = W2GU; }
    else if (it < c3) { mat = 3; K = 2816; base = c2; off = W2D; }
    else if (it < c4) { mat = 4; K = 1024; base = c3; off = WIN; }
    else if (it < c5) { mat = 5; K = 256; base = c4; off = WQ; }
    else if (it < c6) { mat = 6; K = 128; base = c5; off = WUV; }
    else if (it < c7) { mat = 7; K = 512; base = c6; off = WOA; }
    else if (it < c8) { mat = 8; K = 512; base = c7; off = WOB; }
    else { mat = 9; K = 1024; base = c8; off = WOUT; }
    prep_transpose_tile(p, true, mat, K, wb + off, it - base, lds, t);
  }
  {
    const int wid = owid(tid);
    for (int it = blockIdx.x; it < T_ / NWAVE; it += gridDim.x) {
      int row = it * NWAVE + wid;
      rmsnorm_row(p.x + (size_t)row * D_, p.g_ffn1, (bf16_t*)(p.ws + OFF_H) + (size_t)row * D_);
    }
  }
  for (int it = blockIdx.x; it < T_ * 32 / NTHR; it += gridDim.x) {
    int e = it * NTHR + tid;
    int tok = e >> 5, i = e & 31;
    float inv_freq = exp2f(-(float)i * (13.287712379549449f / 32.f));
    float ang = (float)p.pos[tok] * inv_freq;
    double rev = (double)ang * 0.15915494309189535;
    rev -= floor(rev);
    float r = (float)rev;
    float2 cs; cs.x = __builtin_amdgcn_cosf(r); cs.y = __builtin_amdgcn_sinf(r);
    ((float2*)(p.ws + OFF_ROPE))[e] = cs;
  }
}

typedef f32x4 acc8p_t[2][2][4][2];
constexpr int G_BK = 64, G_HALF = 128, G_HT = G_HALF * G_BK;
DI int lds_byte(int r, int c) {
  int st = (r >> 4) * 2 + (c >> 5), rr = r & 15, cc = c & 31, ob = rr * 64 + cc * 2;
  return st * 1024 + (ob ^ (((ob >> 9) & 1) << 5));
}
DI void stage_rc(int b, int& R, int& C) {
  int st = b / 1024, sb = b % 1024, swz = sb ^ (((sb >> 9) & 1) << 5);
  R = (st >> 1) * 16 + swz / 64; C = (st & 1) * 32 + (swz % 64) / 2;
}
template <int LDA, int LDB, int NKT>
DI void gemm8p(const bf16_t* __restrict__ A, const bf16_t* __restrict__ Bt, char* smem, acc8p_t& acc) {
  static_assert(NKT >= 4 && (NKT % 2) == 0, "K tiles");
  bf16_t* shm = (bf16_t*)smem;
  const int tid = otid();
  const int wid = owid(tid), lane = tid & 63, wr = wid >> 2, wc = wid & 3, fr = lane & 15, fq = lane >> 4;
#define SA(b, h) (shm + ((b) * 2 + (h)) * G_HT)
#define SB(b, h) (shm + (4 + (b) * 2 + (h)) * G_HT)
  unsigned sofa[2], sofb[2];
#pragma unroll
  for (int _i = 0; _i < 2; ++_i) { int _r, _c; stage_rc(tid * 16 + _i * 8192, _r, _c); sofa[_i] = (unsigned)(_r * LDA + _c); sofb[_i] = (unsigned)(_r * LDB + _c); }
#define STAGE(P, BASE, LD, br, kt, SOF) do { const bf16_t* _ub = (BASE) + ((long)(br) * (LD) + (long)(kt) * G_BK);     \
    _Pragma("unroll") for (int _i = 0; _i < 2; ++_i) { \
      __builtin_amdgcn_global_load_lds((const unsigned*)(_ub + SOF[_i]), \
        (unsigned*)((char*)(P) + tid * 16 + _i * 8192), 16, 0, 0); } } while (0)
#define LDA_(dst, b, h) _Pragma("unroll") for (int m = 0; m < 4; ++m) _Pragma("unroll") for (int k = 0; k < 2; ++k) \
    dst[m][k] = *reinterpret_cast<const bf16x8*>((char*)SA(b, h) + lds_byte(wr * 64 + m * 16 + fr, k * 32 + fq * 8))
#define LDB_(dst, b, h) _Pragma("unroll") for (int n = 0; n < 2; ++n) _Pragma("unroll") for (int k = 0; k < 2; ++k) \
    dst[n][k] = *reinterpret_cast<const bf16x8*>((char*)SB(b, h) + lds_byte(wc * 32 + n * 16 + fr, k * 32 + fq * 8))
#define MMA(ai, bj, At_, Bt_) do { __builtin_amdgcn_s_setprio(1); \
    _Pragma("unroll") for (int m = 0; m < 4; ++m) _Pragma("unroll") for (int n = 0; n < 2; ++n) _Pragma("unroll") for (int k = 0; k < 2; ++k) \
      acc[ai][bj][m][n] = __builtin_amdgcn_mfma_f32_16x16x32_bf16(At_[m][k], Bt_[n][k], acc[ai][bj][m][n], 0, 0, 0); \
    __builtin_amdgcn_s_setprio(0); } while (0)
#define WAIT_V(n) asm volatile("s_waitcnt vmcnt(" #n ")" ::: "memory")
#define WAIT_L(n) asm volatile("s_waitcnt lgkmcnt(" #n ")" ::: "memory")
#define BAR __builtin_amdgcn_s_barrier()
#define SCHED __builtin_amdgcn_sched_barrier(0)
#pragma unroll
  for (int a = 0; a < 2; ++a)
#pragma unroll
    for (int b = 0; b < 2; ++b)
#pragma unroll
      for (int m = 0; m < 4; ++m)
#pragma unroll
        for (int n = 0; n < 2; ++n) acc[a][b][m][n] = f32x4{0.f, 0.f, 0.f, 0.f};
  bf16x8 At[4][2], B0[2][2], B1[2][2];
  constexpr int nt = NKT;
  WAIT_V(0);
  SCHED;
  STAGE(SB(0, 0), Bt, LDB, 0, 0, sofb); STAGE(SA(0, 0), A, LDA, 0, 0, sofa);
  STAGE(SB(0, 1), Bt, LDB, G_HALF, 0, sofb); STAGE(SA(0, 1), A, LDA, G_HALF, 0, sofa);
  if (wr == 1) BAR;
  WAIT_V(4); BAR;
  STAGE(SB(1, 0), Bt, LDB, 0, 1, sofb); STAGE(SA(1, 0), A, LDA, 0, 1, sofa); STAGE(SB(1, 1), Bt, LDB, G_HALF, 1, sofb);
  WAIT_V(6); BAR;
  for (int t = 0; t < nt - 2; t += 2) {
    LDB_(B0, 0, 0); SCHED; LDA_(At, 0, 0); STAGE(SA(1, 1), A, LDA, G_HALF, t + 1, sofa);
    WAIT_L(8); BAR; WAIT_L(0); MMA(0, 0, At, B0); BAR; SCHED;
    LDB_(B1, 0, 1); STAGE(SB(0, 0), Bt, LDB, 0, t + 2, sofb);
    BAR; WAIT_L(0); MMA(0, 1, At, B1); BAR;
    LDA_(At, 0, 1); STAGE(SA(0, 0), A, LDA, 0, t + 2, sofa);
    BAR; WAIT_L(0); MMA(1, 0, At, B0); BAR; SCHED;
    STAGE(SB(0, 1), Bt, LDB, G_HALF, t + 2, sofb);
    WAIT_V(6); BAR; MMA(1, 1, At, B1); BAR;
    LDB_(B0, 1, 0); SCHED; LDA_(At, 1, 0); STAGE(SA(0, 1), A, LDA, G_HALF, t + 2, sofa);
    WAIT_L(8); BAR; WAIT_L(0); MMA(0, 0, At, B0); BAR; SCHED;
    LDB_(B1, 1, 1); STAGE(SB(1, 0), Bt, LDB, 0, t + 3, sofb);
    BAR; WAIT_L(0); MMA(0, 1, At, B1); BAR;
    LDA_(At, 1, 1); STAGE(SA(1, 0), A, LDA, 0, t + 3, sofa);
    BAR; WAIT_L(0); MMA(1, 0, At, B0); BAR; SCHED;
    STAGE(SB(1, 1), Bt, LDB, G_HALF, t + 3, sofb);
    WAIT_V(6); BAR; MMA(1, 1, At, B1); BAR;
  }
  { LDB_(B0, 0, 0); LDA_(At, 0, 0); STAGE(SA(1, 1), A, LDA, G_HALF, nt - 1, sofa);
    BAR; WAIT_L(0); MMA(0, 0, At, B0); BAR;
    LDB_(B1, 0, 1); BAR; WAIT_L(0); MMA(0, 1, At, B1); BAR;
    LDA_(At, 0, 1); WAIT_V(4); BAR; WAIT_L(0); MMA(1, 0, At, B0); MMA(1, 1, At, B1); BAR; }
  { LDB_(B0, 1, 0); LDA_(At, 1, 0); WAIT_V(2); BAR; WAIT_L(0); MMA(0, 0, At, B0); BAR;
    LDB_(B1, 1, 1); WAIT_V(0); BAR; WAIT_L(0); MMA(0, 1, At, B1); BAR;
    LDA_(At, 1, 1); BAR; WAIT_L(0); MMA(1, 0, At, B0); MMA(1, 1, At, B1); BAR; }
  if (wr == 0) BAR;
#undef SA
#undef SB
#undef STAGE
#undef LDA_
#undef LDB_
#undef MMA
#undef WAIT_V
#undef WAIT_L
#undef BAR
#undef SCHED
}

DI int sched_tile(int it, int MT, int NT, int& mt, int& nt) {
  const int G = gridDim.x, b = blockIdx.x;
  const int per = G >> 3, pm = per >> 2;
  const int nfull = NT >> 2, w = NT & 3;
  if ((G & 31) == 0 && pm > 0 && (MT % pm) == 0 && w != 3 && (w == 0 || (MT % (per / w)) == 0)) {
    const int x = g_sched[0], j = g_sched[1];
    const int nsm = MT / pm;
    const int nmain = nsm * nfull;
    const int pm2 = w ? per / w : 1;
    const int ntail = w ? MT / pm2 : 0;
    const int st = it * 8 + x;
    if (st >= nmain + ntail) return -1;
    if (st < nmain) {
      const int sm = st / nfull, sn = st - sm * nfull;
      mt = sm * pm + (j % pm); nt = sn * 4 + (j / pm);
    } else {
      const int s2 = st - nmain;
      mt = s2 * pm2 + (j % pm2); nt = nfull * 4 + (j / pm2);
    }
    return 1;
  } else {
    const int tile = it * G + b;
    if (tile >= MT * NT) return -1;
    nt = tile % NT; mt = tile / NT;
    return 1;
  }
}

#define EPI_IDS const int tid = otid(), lane = tid & 63, wid = owid(tid), wr = wid >> 2, wc = wid & 3, fr = lane & 15, fq = lane >> 4; (void)wr; (void)wc; (void)fr; (void)fq;
#define LROW(ai, m, j) ((ai) * 128 + (m) * 16 + (j))
#define LCOL(bj, n) ((bj) * 128 + (n) * 16)
#define EPI_FOR _Pragma("unroll") for (int ai = 0; ai < 2; ++ai) _Pragma("unroll") for (int bj = 0; bj < 2; ++bj) \
    _Pragma("unroll") for (int m = 0; m < 4; ++m) _Pragma("unroll") for (int n = 0; n < 2; ++n) _Pragma("unroll") for (int j = 0; j < 4; ++j)

DI void phase_ffn_gu(const Params& p, size_t woff, char* smem) {
  const bf16_t* H = (const bf16_t*)(p.ws + OFF_H);
  const bf16_t* W = (const bf16_t*)(p.ws + OFF_WB) + woff;
  bf16_t* U = (bf16_t*)(p.ws + OFF_PA);
  for (int it = 0;; ++it) {
    int mt, nt; int s = sched_tile(it, 128, 22, mt, nt);
    if (s < 0) break; if (s == 0) continue;
    acc8p_t acc;
    gemm8p<D_, D_, 16>(H + (size_t)mt * 256 * D_, W + (size_t)nt * 256 * D_, smem, acc);
    EPI_IDS
    bf16_t* tp = U + (size_t)(mt * 256) * FF + nt * 128;
    const unsigned loff = (unsigned)((wr * 64 + fq * 4) * FF + wc * 32 + fr);
#pragma unroll
    for (int ai = 0; ai < 2; ++ai)
#pragma unroll
      for (int m = 0; m < 4; ++m)
#pragma unroll
        for (int n = 0; n < 2; ++n)
#pragma unroll
          for (int j = 0; j < 4; ++j) {
            float gv = acc[ai][0][m][n][j], uv = acc[ai][1][m][n][j];
            float sv = gv * frcp(1.f + fexp2(-LOG2E * gv)) * uv;
            (tp + LROW(ai, m, j) * FF + n * 16)[loff] = (bf16_t)f2bf(sv);
          }
  }
}

DI void phase_ffn_down(const Params& p, size_t woff, const float* res, char* smem) {
  const bf16_t* U = (const bf16_t*)(p.ws + OFF_PA);
  const bf16_t* W = (const bf16_t*)(p.ws + OFF_WB) + woff;
  float* out = p.out;
  for (int it = 0;; ++it) {
    int mt, nt; int s = sched_tile(it, 128, 4, mt, nt);
    if (s < 0) break; if (s == 0) continue;
    acc8p_t acc;
    gemm8p<FF, FF, 44>(U + (size_t)mt * 256 * FF, W + (size_t)nt * 256 * FF, smem, acc);
    EPI_IDS
    const size_t tb = (size_t)(mt * 256) * D_ + nt * 256;
    float* tp = out + tb; const float* rsp = res + tb;
    const unsigned loff = (unsigned)((wr * 64 + fq * 4) * D_ + wc * 32 + fr);
    EPI_FOR {
      const int ro = LROW(ai, m, j) * D_ + LCOL(bj, n);
      (tp + ro)[loff] = (rsp + ro)[loff] + 0.5f * acc[ai][bj][m][n][j];
    }
  }
}

DI void phase_win(const Params& p, char* smem) {
  const bf16_t* H = (const bf16_t*)(p.ws + OFF_H);
  const bf16_t* W = (const bf16_t*)(p.ws + OFF_WB) + WIN;
  bf16_t* PA = (bf16_t*)(p.ws + OFF_PA);
  bf16_t* VT = (bf16_t*)(p.ws + OFF_VT);
  bf16_t* GT = (bf16_t*)(p.ws + OFF_GATES);
  float* WI = (float*)(p.ws + OFF_WIDX);
  for (int it = 0;; ++it) {
    int mt, nt; int s = sched_tile(it, 128, 16, mt, nt);
    if (s < 0) break; if (s == 0) continue;
    acc8p_t acc;
    gemm8p<D_, D_, 16>(H + (size_t)mt * 256 * D_, W + (size_t)nt * 256 * D_, smem, acc);
    EPI_IDS
    if (nt < 6) {
      bf16_t* tp = PA + (size_t)(mt * 256) * PA_LD + nt * 256;
      const unsigned loff = (unsigned)((wr * 64 + fq * 4) * PA_LD + wc * 32 + fr);
      const float qsc = (nt == 2 || nt == 3) ? 0.125f * LOG2E : 1.f;
      EPI_FOR {
        const int ro = LROW(ai, m, j) * PA_LD + LCOL(bj, n);
        (tp + ro)[loff] = (bf16_t)f2bf(acc[ai][bj][m][n][j] * qsc);
      }
    } else if (nt < 8) {
      const int b = mt >> 4;
#pragma unroll
      for (int ai = 0; ai < 2; ++ai)
#pragma unroll
        for (int bj = 0; bj < 2; ++bj)
#pragma unroll
          for (int m = 0; m < 4; ++m)
#pragma unroll
            for (int n = 0; n < 2; ++n) {
              int c = (nt - 6) * 256 + bj * 128 + wc * 32 + n * 16 + fr;
              int h = c >> 6, d = c & 63;
              int tok = mt * 256 + ai * 128 + wr * 64 + m * 16 + fq * 4;
              bf16_t* dst = VT + ((size_t)(b * 8 + h) * 64 + d) * S_ + (tok & (S_ - 1));
              u32x2 w; w[0] = pack2(acc[ai][bj][m][n][0], acc[ai][bj][m][n][1]); w[1] = pack2(acc[ai][bj][m][n][2], acc[ai][bj][m][n][3]);
              *(u32x2*)dst = w;
            }
    } else if (nt < 16) {
      bf16_t* tp = GT + (size_t)(mt * 256) * 2048 + (nt - 8) * 256;
      const unsigned loff = (unsigned)((wr * 64 + fq * 4) * 2048 + wc * 32 + fr);
      EPI_FOR {
        const int ro = LROW(ai, m, j) * 2048 + LCOL(bj, n);
        float v = acc[ai][bj][m][n][j];
        float sg = frcp(1.f + fexp2(-LOG2E * v));
        (tp + ro)[loff] = (bf16_t)f2bf(sg);
      }
    }
  }
}

DI void phase_qproj(const Params& p, char* smem) {
  bf16_t* PA = (bf16_t*)(p.ws + OFF_PA);
  const bf16_t* W = (const bf16_t*)(p.ws + OFF_WB) + WQ;
  bf16_t* QA = (bf16_t*)(p.ws + OFF_H);
  bf16_t* QI = QA + (size_t)T_ * 512;
  const float2* ROPE = (const float2*)(p.ws + OFF_ROPE);
  float* rstd = (float*)(smem + 131072);
  for (int it = 0;; ++it) {
    int mt, nt; int s = sched_tile(it, 128, 4, mt, nt);
    if (s < 0) break; if (s == 0) continue;
    {
      const int tq = otid(); int row = tq >> 1, half = tq & 1;
      const bf16_t* src = PA + (size_t)(mt * 256 + row) * PA_LD + half * 128;
      float ss = 0.f;
#pragma unroll 4
      for (int i = 0; i < 16; ++i) {
        u32x4 v = *(const u32x4*)(src + i * 8);
#pragma unroll
        for (int j = 0; j < 4; ++j) { float a = bflo(v[j]), b = bfhi(v[j]); ss += a * a + b * b; }
      }
      ss += __shfl_xor(ss, 1);
      if (half == 0) rstd[row] = rsqrtf(ss * (1.f / 256.f) + EPS);
    }
    acc8p_t acc;
    gemm8p<PA_LD, 256, 4>(PA + (size_t)mt * 256 * PA_LD, W + (size_t)nt * 256 * 256, smem, acc);
    EPI_IDS
    const int head = (nt & 1) * 4 + wc;
    bf16_t* dtp = (nt < 2 ? QA : QI) + (size_t)(mt * 256) * 512 + head * 64;
    const float2* rtp = ROPE + (size_t)(mt * 256) * 32;
    const unsigned doff = (unsigned)((wr * 64 + fq * 4) * 512 + fr);
    const unsigned roff = (unsigned)((wr * 64 + fq * 4) * 32 + fr);
    const float* rsl = rstd + wr * 64 + fq * 4;
    float ga[4] = {1.f, 1.f, 1.f, 1.f};
    const bool do_norm = nt < 2;
    if (do_norm) { ga[0] = p.g_qa[fr]; ga[1] = p.g_qa[16 + fr]; ga[2] = p.g_qa[32 + fr]; ga[3] = p.g_qa[48 + fr]; }
#pragma unroll
    for (int ai = 0; ai < 2; ++ai)
#pragma unroll
      for (int m = 0; m < 4; ++m)
#pragma unroll
        for (int j = 0; j < 4; ++j) {
          const int lr = LROW(ai, m, j);
          const float rs = rsl[lr];
          float x0 = acc[ai][0][m][0][j] * rs, x1 = acc[ai][0][m][1][j] * rs;
          float y0 = acc[ai][1][m][0][j] * rs, y1 = acc[ai][1][m][1][j] * rs;
          if (do_norm) {
            float ss = x0 * x0 + x1 * x1 + y0 * y0 + y1 * y1;
#pragma unroll
            for (int o = 8; o > 0; o >>= 1) ss += __shfl_xor(ss, o);
            const float r2 = rsqrtf(ss * (1.f / 64.f) + EPS);
            x0 *= r2 * ga[0]; x1 *= r2 * ga[1]; y0 *= r2 * ga[2]; y1 *= r2 * ga[3];
          }
          const float2 c0 = (rtp + lr * 32)[roff], c1 = (rtp + lr * 32 + 16)[roff];
          bf16_t* dp = dtp + lr * 512;
          (dp)[doff] = (bf16_t)f2bf(x0 * c0.x - y0 * c0.y);
          (dp + 32)[doff] = (bf16_t)f2bf(x0 * c0.y + y0 * c0.x);
          (dp + 16)[doff] = (bf16_t)f2bf(x1 * c1.x - y1 * c1.y);
          (dp + 48)[doff] = (bf16_t)f2bf(x1 * c1.y + y1 * c1.x);
          if (j == 3) __builtin_amdgcn_sched_barrier(0);
        }
    __syncthreads();
  }
  const int tid = otid(), lane = tid & 63, wid = owid(tid);
  for (int it = blockIdx.x; it < T_ / 64; it += gridDim.x) {
    const int d = lane & 31; const bool isidx = lane >= 32;
    const float g0 = isidx ? 1.f : p.g_ka[d], g1 = isidx ? 1.f : p.g_ka[d + 32];
    for (int i = 0; i < 8; ++i) {
      int tok = it * 64 + wid * 8 + i;
      bf16_t* src = PA + (size_t)tok * PA_LD + (isidx ? PA_KI : PA_KA);
      float v0 = bf2f(src[d]), v1 = bf2f(src[d + 32]);
      float ss = v0 * v0 + v1 * v1;
#pragma unroll
      for (int o = 16; o > 0; o >>= 1) ss += __shfl_xor(ss, o);
      if (!isidx) { float r2 = rsqrtf(ss * (1.f / 64.f) + EPS); v0 *= r2 * g0; v1 *= r2 * g1; }
      float2 cs = ROPE[(size_t)tok * 32 + d];
      float o0 = v0 * cs.x - v1 * cs.y, o1 = v0 * cs.y + v1 * cs.x;
      src[d] = (bf16_t)f2bf(o0); src[d + 32] = (bf16_t)f2bf(o1);
    }
  }
}

DI f32x16 sb_qk(const char* cur, int sub, int r, int g, int sw, const bf16x8 (&qf)[4]) {
  f32x16 z;
#pragma unroll
  for (int i = 0; i < 16; ++i) z[i] = 0.f;
#pragma unroll
  for (int ks = 0; ks < 4; ++ks) {
    bf16x8 kf = ld_frag_s(cur + (sub * 32 + r) * 128 + (((ks * 2 + g) ^ sw) << 4));
    z = MFMA32(kf, qf[ks], z);
  }
  return z;
}
template <bool DIAG>
DI void sb_elem(const f32x16& z, int r, int g, float& R, bf16x8& pf0, bf16x8& pf1) {
  float e[16], rr[16];
#pragma unroll
  for (int i = 0; i < 16; ++i) {
    float z2 = fminf(z[i], 80.f);
    float ev = fexp2(z2);
    float rv_ = frcp(1.f + ev);
    if (DIAG && !(crow(i, g) < r)) { ev = 0.f; rv_ = 1.f; }
    e[i] = ev; rr[i] = rv_;
  }
  float G[4], Gp[4];
#pragma unroll
  for (int q = 0; q < 4; ++q) {
    rr[4 * q + 2] *= rr[4 * q + 3];
    rr[4 * q + 1] *= rr[4 * q + 2];
    rr[4 * q + 0] *= rr[4 * q + 1];
    G[q] = rr[4 * q];
  }
#pragma unroll
  for (int q = 0; q < 4; ++q) Gp[q] = __shfl_xor(G[q], 32);
  float SO[4], SP[4];
  SO[3] = 1.f; SO[2] = G[3]; SO[1] = G[2] * G[3]; SO[0] = G[1] * SO[1];
  SP[3] = 1.f; SP[2] = Gp[3]; SP[1] = Gp[2] * Gp[3]; SP[0] = Gp[1] * SP[1];
  float a[16];
#pragma unroll
  for (int q = 0; q < 4; ++q) {
    float part = g == 0 ? SP[q] * Gp[q] : SP[q];
    float E = SO[q] * part * R;
#pragma unroll
    for (int j = 0; j < 4; ++j) a[4 * q + j] = e[4 * q + j] * rr[4 * q + j] * E;
  }
  R = R * (SO[0] * G[0]) * (SP[0] * Gp[0]);
  u32x4 pw0, pw1;
#pragma unroll
  for (int j = 0; j < 4; ++j) { pw0[j] = pack2(a[2 * j], a[2 * j + 1]); pw1[j] = pack2(a[8 + 2 * j], a[8 + 2 * j + 1]); }
  pf0 = __builtin_bit_cast(bf16x8, pw0); pf1 = __builtin_bit_cast(bf16x8, pw1);
}
DI void sb_pv(const char* cur, int sub, int r, int g, const bf16x8& pf0, const bf16x8& pf1, f32x16& o0, f32x16& o1) {
#pragma unroll
  for (int ks2 = 0; ks2 < 2; ++ks2) {
    const bf16x8 pf = ks2 == 0 ? pf0 : pf1;
#pragma unroll
    for (int dt = 0; dt < 2; ++dt) {
      const char* vp = cur + 8192 + (dt * 32 + r) * 136 + (sub * 32 + 16 * ks2 + 4 * g) * 2;
      u32x2 lo = *(const u32x2*)vp, hi = *(const u32x2*)(vp + 16);
      u32x4 vv; vv[0] = lo[0]; vv[1] = lo[1]; vv[2] = hi[0]; vv[3] = hi[1];
      bf16x8 vf = __builtin_bit_cast(bf16x8, vv);
      if (dt == 0) o0 = MFMA32(vf, pf, o0); else o1 = MFMA32(vf, pf, o1);
    }
  }
}

template <bool DUMMY>
DI void sb_item(const Params& p, int b, int h, int qb, char* smem) {
  bf16_t* PA = (bf16_t*)(p.ws + OFF_PA);
  const bf16_t* VT = (const bf16_t*)(p.ws + OFF_VT) + (size_t)(b * 8 + h) * 64 * S_;
  const int tid = otid(), lane = tid & 63, wid = owid(tid), g = lane >> 5, r = lane & 31;
  const int tw = qb * 256 + wid * 32;
  constexpr int BUFSZ = 8192 + 8704;
  bf16x8 qf[4];
  {
    const bf16_t* qp = PA + (size_t)(b * S_ + tw + r) * PA_LD + PA_QB + h * 64 + g * 8;
#pragma unroll
    for (int ks = 0; ks < 4; ++ks) qf[ks] = ld_frag_g(qp + ks * 16);
  }
  const int srow = tid >> 3, sch = tid & 7;
  const bf16_t* gk = PA + (size_t)(b * S_ + srow) * PA_LD + PA_KB + h * 64 + sch * 8;
  const bf16_t* gv = VT + (size_t)srow * S_ + sch * 8;
  const unsigned k_st = srow * 128 + ((sch ^ ((srow >> 1) & 7)) << 4);
  const unsigned v_st = 8192 + srow * 136 + sch * 16;
  const int sw = (lane >> 1) & 7;
  f32x16 o0, o1;
#pragma unroll
  for (int i = 0; i < 16; ++i) { o0[i] = 0.f; o1[i] = 0.f; }
  float R = 1.f;
  const int nkt = 4 * qb + 4;
  u32x4 rk, rv;
  {
    int kt = nkt - 1;
    rk = *(const u32x4*)(gk + (size_t)(kt * 64) * PA_LD); rv = *(const u32x4*)(gv + kt * 64);
    char* cur = smem + (kt & 1) * BUFSZ;
    *(u32x4*)(cur + k_st) = rk;
    u32x2 lo, hi; lo[0] = rv[0]; lo[1] = rv[1]; hi[0] = rv[2]; hi[1] = rv[3];
    *(u32x2*)(cur + v_st) = lo; *(u32x2*)(cur + v_st + 8) = hi;
  }
  __syncthreads();
  for (int kt = nkt - 1; kt >= 0; --kt) {
    const char* cur = smem + (kt & 1) * BUFSZ;
    char* nxt = smem + ((kt + 1) & 1) * BUFSZ;
    const bool more = kt > 0;
    if (more) { rk = *(const u32x4*)(gk + (size_t)((kt - 1) * 64) * PA_LD); rv = *(const u32x4*)(gv + (kt - 1) * 64); }
    __builtin_amdgcn_sched_barrier(0);
    if (kt * 64 + 32 < tw) {
      const f32x16 z1 = sb_qk(cur, 1, r, g, sw, qf);
      const f32x16 z0 = sb_qk(cur, 0, r, g, sw, qf);
      bf16x8 p1a, p1b, p0a, p0b;
      sb_elem<false>(z1, r, g, R, p1a, p1b);
      sb_pv(cur, 1, r, g, p1a, p1b, o0, o1);
      sb_elem<false>(z0, r, g, R, p0a, p0b);
      sb_pv(cur, 0, r, g, p0a, p0b, o0, o1);
    } else {
#pragma unroll
      for (int sub = 1; sub >= 0; --sub) {
        const int sbase = kt * 64 + sub * 32;
        if (sbase <= tw) {
          const f32x16 z = sb_qk(cur, sub, r, g, sw, qf);
          bf16x8 pa, pb;
          if (sbase == tw) sb_elem<true>(z, r, g, R, pa, pb); else sb_elem<false>(z, r, g, R, pa, pb);
          sb_pv(cur, sub, r, g, pa, pb, o0, o1);
        }
      }
    }
    __builtin_amdgcn_sched_barrier(0);
    if (more) {
      *(u32x4*)(nxt + k_st) = rk;
      u32x2 lo, hi; lo[0] = rv[0]; lo[1] = rv[1]; hi[0] = rv[2]; hi[1] = rv[3];
      *(u32x2*)(nxt + v_st) = lo; *(u32x2*)(nxt + v_st + 8) = hi;
    }
    __syncthreads();
  }
  bf16_t* yp = DUMMY ? (bf16_t*)(p.ws + OFF_SLAB) + (size_t)(b * S_ + tw + r) * 512 + h * 64 : PA + (size_t)(b * S_ + tw + r) * PA_LD + PA_QB + h * 64;
#pragma unroll
  for (int rq = 0; rq < 4; ++rq) {
    u32x2 w0, w1;
    w0[0] = pack2(o0[4 * rq], o0[4 * rq + 1]); w0[1] = pack2(o0[4 * rq + 2], o0[4 * rq + 3]);
    w1[0] = pack2(o1[4 * rq], o1[4 * rq + 1]); w1[1] = pack2(o1[4 * rq + 2], o1[4 * rq + 3]);
    *(u32x2*)(yp + 8 * rq + 4 * g) = w0;
    *(u32x2*)(yp + 32 + 8 * rq + 4 * g) = w1;
  }
}

DI unsigned tokey(float f) { unsigned u = __float_as_uint(f); return (u & 0x80000000u) ? ~u : (u | 0x80000000u); }
DI int wave_count_sum(int c) {
  int tot = 0;
#pragma unroll
  for (int bt = 0; bt < 7; ++bt) tot += __builtin_popcountll(__ballot((c >> bt) & 1)) << bt;
  return tot;
}

DI void idx_item(const Params& p, int b, int qt, char* smem) {
  bf16_t* PA = (bf16_t*)(p.ws + OFF_PA);
  const bf16_t* QI = (const bf16_t*)(p.ws + OFF_H) + (size_t)T_ * 512;
  const float* WI = (const float*)(p.ws + OFF_WIDX);
  float* slab = (float*)(p.ws + OFF_SLAB) + (size_t)blockIdx.x * 16 * 4096;
  const int tid = otid(), lane = tid & 63, wid = owid(tid), g4 = lane >> 4, r = lane & 15;
  const int t0 = qt * 16;
  {
    bf16x8 qf[8][2]; float w[8];
    const bf16_t* qp = QI + (size_t)(b * S_ + t0 + r) * 512 + g4 * 8;
#pragma unroll
    for (int hh = 0; hh < 8; ++hh) { qf[hh][0] = ld_frag_g(qp + hh * 64); qf[hh][1] = ld_frag_g(qp + hh * 64 + 32); }
    {
      const float4* wp = (const float4*)(WI + (size_t)(b * S_ + t0 + r) * 8);
      float4 wa = wp[0], wb = wp[1];
      w[0] = wa.x; w[1] = wa.y; w[2] = wa.z; w[3] = wa.w; w[4] = wb.x; w[5] = wb.y; w[6] = wb.z; w[7] = wb.w;
    }
    const int nkt = qt + 1;
    const bf16_t* kbase = PA + (size_t)(b * S_ + r) * PA_LD + PA_KI + g4 * 8;
    bf16x8 k0, k1;
    {
      int kt = wid < nkt ? wid : 0;
      const bf16_t* kp = kbase + (size_t)(kt * 16) * PA_LD;
      k0 = ld_frag_g(kp); k1 = ld_frag_g(kp + 32);
    }
    for (int kt = wid; kt < nkt; kt += NWAVE) {
      bf16x8 n0, n1;
      {
        int kn = kt + NWAVE < nkt ? kt + NWAVE : kt;
        const bf16_t* kp = kbase + (size_t)(kn * 16) * PA_LD;
        n0 = ld_frag_g(kp); n1 = ld_frag_g(kp + 32);
      }
      f32x4 sc = {0.f, 0.f, 0.f, 0.f};
#pragma unroll
      for (int hh = 0; hh < 8; ++hh) {
        f32x4 c = {0.f, 0.f, 0.f, 0.f};
        c = MFMA16(k0, qf[hh][0], c);
        c = MFMA16(k1, qf[hh][1], c);
#pragma unroll
        for (int i = 0; i < 4; ++i) sc[i] += w[hh] * fmaxf(c[i], 0.f);
      }
      *(f32x4*)(slab + (size_t)r * 4096 + kt * 16 + 4 * g4) = sc;
      k0 = n0; k1 = n1;
    }
  }
  __syncthreads();
  for (int qi = 0; qi < 2; ++qi) {
    const int q = wid * 2 + qi;
    const int t = t0 + q, n = t + 1;
    unsigned short* out = (unsigned short*)(PA + (size_t)(b * S_ + t) * PA_LD);
    if (n <= 256) {
#pragma unroll
      for (int j = 0; j < 4; ++j) { int e = j * 64 + lane; out[e] = (unsigned short)(e < n ? e : 0); }
      continue;
    }
    const float* row = slab + (size_t)q * 4096 + lane;
    const int nj = (n + 63) >> 6;
    unsigned key[64];
#pragma unroll
    for (int ch = 0; ch < 4; ++ch) {
#pragma unroll
      for (int jj = 0; jj < 16; ++jj) key[ch * 16 + jj] = 0u;
      if (nj > ch * 16) {
#pragma unroll
        for (int jj = 0; jj < 16; ++jj) { const int j = ch * 16 + jj; if (j * 64 + lane < n) key[j] = tokey(row[j * 64]); }
      }
    }
    unsigned Tthr = 0u; int need = 0; bool exact = false;
    for (int bit = 31; bit >= 0; --bit) {
      const unsigned cand = Tthr | (1u << bit);
      int c = 0;
#pragma unroll
      for (int ch = 0; ch < 4; ++ch) {
        if (nj > ch * 16) {
#pragma unroll
          for (int jj = 0; jj < 16; ++jj) c += (key[ch * 16 + jj] >= cand) ? 1 : 0;
        }
      }
      const int cnt = wave_count_sum(c);
      if (cnt >= 256) Tthr = cand;
      if (cnt == 256) { exact = true; break; }
    }
    unsigned Tgt;
    if (exact) { Tgt = Tthr - 1u; need = 0; }
    else {
      int c = 0;
#pragma unroll
      for (int j = 0; j < 64; ++j) c += (key[j] > Tthr) ? 1 : 0;
      Tgt = Tthr; need = 256 - wave_count_sum(c);
    }
    const unsigned long long lt_mask = (1ull << lane) - 1ull;
    int base = 0, ties = 0;
#pragma unroll
    for (int j = 0; j < 64; ++j) {
      if (j < nj) {
        const bool gt = key[j] > Tgt;
        const bool eq = (!exact) && (key[j] == Tthr);
        const unsigned long long meq = __ballot(eq);
        const int myrank = ties + __builtin_popcountll(meq & lt_mask);
        const bool sel = gt || (eq && myrank < need);
        ties += __builtin_popcountll(meq);
        const unsigned long long ms = __ballot(sel);
        const int pos = base + __builtin_popcountll(ms & lt_mask);
        if (sel && pos < 256) out[pos] = (unsigned short)(j * 64 + lane);
        base += __builtin_popcountll(ms);
      }
    }
  }
  __syncthreads();
}

DI void phase_sb_dummy(const Params& p, char* smem) {
  unsigned* cnt = (unsigned*)(p.ws + OFF_CNT) + 16;
  int* s_item = (int*)(smem + SMEM_BYTES - 16);
  while (true) {
    if (otid() == 0) *s_item = (int)atomicAdd(cnt, 1u);
    __syncthreads();
    const int item = *s_item;
    __syncthreads();
    if (item >= 64 * 16) break;
    int qb = 15 - (item >> 6), bh = item & 63;
    sb_item<true>(p, bh >> 3, bh & 7, qb, smem);
  }
}

template <bool IDX_ONLY>
DI void phase_mix(const Params& p, char* smem) {
  unsigned* cnt = (unsigned*)(p.ws + OFF_CNT) + (IDX_ONLY ? 8 : 0);
  int* s_item = (int*)(smem + SMEM_BYTES - 16);
  constexpr int NSB = 64 * 16, NIDX = 8 * 256;
  while (true) {
    if (otid() == 0) *s_item = (int)atomicAdd(cnt, 1u);
    __syncthreads();
    const int item = *s_item;
    __syncthreads();
    if (IDX_ONLY) { if (item >= NIDX) break; int qt = 255 - (item >> 3), b = item & 7; idx_item(p, b, qt, smem); continue; }
    if (item >= NSB + NIDX) break;
    if (item < NSB) {
      int qb = 15 - (item >> 6), bh = item & 63;
      sb_item<false>(p, bh >> 3, bh & 7, qb, smem);
    } else {
      int j = item - NSB;
      int qt = 255 - (j >> 3), b = j & 7;
      idx_item(p, b, qt, smem);
    }
  }
}

DI void phase_sparse(const Params& p, char* smem) {
  const bf16_t* PA = (const bf16_t*)(p.ws + OFF_PA);
  const bf16_t* QA = (const bf16_t*)(p.ws + OFF_H);
  bf16_t* YA = (bf16_t*)(p.ws + OFF_SLAB + (size_t)64 * 1024 * 1024);
  const bf16_t* WUVb = (const bf16_t*)(p.ws + OFF_WB) + WUV;
  const int tid = otid(), lane = tid & 63, wid = owid(tid), g4 = lane >> 4, c = lane & 15;
  float* Pl = (float*)(smem + wid * 9280);
  int* Il = (int*)(smem + wid * 9280 + 8192);
  float* Sl = (float*)(smem + wid * 9280 + 9216);
  float* Pq = Pl + g4 * 32 + c;
  char* OL = smem + 8 * 9280;
  const float sc2 = 0.125f * LOG2E;
  for (int it = blockIdx.x; it < T_ / 16; it += gridDim.x) {
    const int tok0 = it * 16;
    const int b = tok0 >> 12;
    for (int qi = 0; qi < 2; ++qi) {
      const int q = wid * 2 + qi;
      const int tok = tok0 + q, t = tok & (S_ - 1);
      const int nsel = t + 1 < 256 ? t + 1 : 256;
      const unsigned short* irow = (const unsigned short*)(PA + (size_t)tok * PA_LD);
#pragma unroll
      for (int j = 0; j < 4; ++j) { int e = j * 64 + lane; int v = irow[e]; Il[e] = e < nsel ? v : 0; }
      __syncthreads();
      bf16x8 qf0, qf1;
      {
        u32x4 z4 = {0u, 0u, 0u, 0u};
        qf0 = __builtin_bit_cast(bf16x8, z4); qf1 = qf0;
        if (c < 8) { const bf16_t* qp = QA + (size_t)tok * 512 + c * 64 + g4 * 8; qf0 = ld_frag_g(qp); qf1 = ld_frag_g(qp + 32); }
      }
      float m = -INFINITY;
#pragma nounroll
      for (int kg = 0; kg < 4; ++kg) {
        bf16x8 ka[4][2];
#pragma unroll
        for (int k4 = 0; k4 < 4; ++k4) {
          int key = (Il + c)[(kg * 4 + k4) * 16];
          const bf16_t* kp = PA + (size_t)(b * S_ + key) * PA_LD + PA_KA + g4 * 8;
          ka[k4][0] = ld_frag_g(kp); ka[k4][1] = ld_frag_g(kp + 32);
        }
#pragma unroll
        for (int k4 = 0; k4 < 4; ++k4) {
          f32x4 cc = {0.f, 0.f, 0.f, 0.f};
          cc = MFMA16(ka[k4][0], qf0, cc);
          cc = MFMA16(ka[k4][1], qf1, cc);
#pragma unroll
          for (int i = 0; i < 4; ++i) {
            const int ec = (kg * 4 + k4) * 16 + i;
            float v = ec + 4 * g4 < nsel ? cc[i] : -INFINITY;
            m = fmaxf(m, v);
            if (c < 8) Pq[ec * 8] = v;
          }
        }
        __builtin_amdgcn_sched_barrier(0);
      }
      m = fmaxf(m, __shfl_xor(m, 16)); m = fmaxf(m, __shfl_xor(m, 32));
      float sum = 0.f;
      if (c < 8) {
#pragma unroll 4
        for (int kt = 0; kt < 16; ++kt)
#pragma unroll
          for (int i = 0; i < 4; ++i) {
            const int ec = kt * 16 + i;
            float pv = fexp2((Pq[ec * 8] - m) * sc2);
            Pq[ec * 8] = pv; sum += pv;
          }
      }
      sum += __shfl_xor(sum, 16); sum += __shfl_xor(sum, 32);
      if (lane < 8) Sl[lane] = 1.f / sum;
      __syncthreads();
      f32x2_t acc[8];
#pragma unroll
      for (int hh = 0; hh < 8; ++hh) acc[hh] = f32x2_t{0.f, 0.f};
      const char* vrow = (const char*)(PA + (size_t)b * S_ * PA_LD + PA_VA);
      const unsigned voff = (unsigned)lane * 4u;
      const int nk16 = (nsel + 15) & ~15;
      unsigned va[16], vb[16];
#define PV_LOAD(dst, k0_) _Pragma("unroll") for (int kk = 0; kk < 16; ++kk) { \
          int key = __builtin_amdgcn_readfirstlane(Il[(k0_) + kk]); dst[kk] = *(const unsigned*)((vrow + (size_t)key * (PA_LD * 2)) + voff); }
#define PV_ACC(srcv, k0_) _Pragma("unroll") for (int kk = 0; kk < 16; ++kk) { \
          const f32x4 pa = *(const f32x4*)(Pl + ((k0_) + kk) * 8), pb = *(const f32x4*)(Pl + ((k0_) + kk) * 8 + 4); \
          const f32x2_t v2 = {bflo(srcv[kk]), bfhi(srcv[kk])}; \
          _Pragma("unroll") for (int hh = 0; hh < 4; ++hh) { acc[hh] += pa[hh] * v2; acc[hh + 4] += pb[hh] * v2; } }
      PV_LOAD(va, 0);
      for (int k0 = 0; k0 < nk16; k0 += 32) {
        const bool m1 = k0 + 16 < nk16, m2 = k0 + 32 < nk16;
        if (m1) { PV_LOAD(vb, k0 + 16); }
        PV_ACC(va, k0);
        if (m2) { PV_LOAD(va, k0 + 32); }
        if (m1) { PV_ACC(vb, k0 + 16); }
      }
#undef PV_LOAD
#undef PV_ACC
#pragma unroll
      for (int hh = 0; hh < 8; ++hh) { const float iv = Sl[hh]; *(unsigned*)(OL + q * 2064 + hh * 256 + lane * 4) = pack2(acc[hh][0] * iv, acc[hh][1] * iv); }
      __syncthreads();
    }
    {
      const int h = wid;
      bf16x8 af[4];
#pragma unroll
      for (int ks = 0; ks < 4; ++ks) af[ks] = ld_frag_s(OL + c * 2064 + h * 256 + (ks * 32 + g4 * 8) * 2);
#pragma nounroll
      for (int nt = 0; nt < 4; ++nt) {
        f32x4 cc = {0.f, 0.f, 0.f, 0.f};
        const bf16_t* wp = WUVb + (size_t)(h * 64 + nt * 16 + c) * 128 + g4 * 8;
#pragma unroll
        for (int ks = 0; ks < 4; ++ks) cc = MFMA16(af[ks], ld_frag_g(wp + ks * 32), cc);
#pragma unroll
        for (int i = 0; i < 4; ++i) YA[(size_t)(tok0 + 4 * g4 + i) * 512 + h * 64 + nt * 16 + c] = (bf16_t)f2bf(cc[i]);
      }
    }
    __syncthreads();
  }
}

DI void phase_merge(const Params& p, char* smem) {
  const bf16_t* YA = (const bf16_t*)(p.ws + OFF_SLAB + (size_t)64 * 1024 * 1024);
  const bf16_t* YB = (const bf16_t*)(p.ws + OFF_PA) + PA_QB;
  const bf16_t* Wa = (const bf16_t*)(p.ws + OFF_WB) + WOA;
  const bf16_t* Wb = (const bf16_t*)(p.ws + OFF_WB) + WOB;
  const bf16_t* GT = (const bf16_t*)(p.ws + OFF_GATES);
  bf16_t* MG = (bf16_t*)(p.ws + OFF_SLAB);
  for (int it = 0;; ++it) {
    int mt, nt; int s = sched_tile(it, 128, 4, mt, nt);
    if (s < 0) break; if (s == 0) continue;
    acc8p_t acc;
    gemm8p<512, 512, 8>(YA + (size_t)mt * 256 * 512, Wa + (size_t)nt * 256 * 512, smem, acc);
    EPI_IDS
    const unsigned goff = (unsigned)((wr * 64 + fq * 4) * 2048 + wc * 32 + fr);
    const unsigned loff = (unsigned)((wr * 64 + fq * 4) * D_ + wc * 32 + fr);
    const bf16_t* gp = GT + (size_t)(mt * 256) * 2048 + nt * 256;
    bf16_t* tp = MG + (size_t)(mt * 256) * D_ + nt * 256;
    EPI_FOR {
      const int lr = LROW(ai, m, j), lc = LCOL(bj, n);
      float ga = bf2f((gp + lr * 2048 + lc)[goff]);
      (tp + lr * D_ + lc)[loff] = (bf16_t)f2bf(ga * acc[ai][bj][m][n][j]);
    }
  }
  for (int it = 0;; ++it) {
    int mt, nt; int s = sched_tile(it, 128, 4, mt, nt);
    if (s < 0) break; if (s == 0) continue;
    acc8p_t acc;
    gemm8p<PA_LD, 512, 8>(YB + (size_t)mt * 256 * PA_LD, Wb + (size_t)nt * 256 * 512, smem, acc);
    EPI_IDS
    const unsigned goff = (unsigned)((wr * 64 + fq * 4) * 2048 + wc * 32 + fr);
    const unsigned loff = (unsigned)((wr * 64 + fq * 4) * D_ + wc * 32 + fr);
    const bf16_t* gp = GT + (size_t)(mt * 256) * 2048 + 1024 + nt * 256;
    bf16_t* tp = MG + (size_t)(mt * 256) * D_ + nt * 256;
    EPI_FOR {
      const int lr = LROW(ai, m, j), lc = LCOL(bj, n);
      float gb = bf2f((gp + lr * 2048 + lc)[goff]);
      bf16_t* e = (tp + lr * D_ + lc) + loff;
      *e = (bf16_t)f2bf(bf2f(*e) + gb * acc[ai][bj][m][n][j]);
    }
  }
}

DI void phase_outproj(const Params& p, char* smem) {
  const bf16_t* MG = (const bf16_t*)(p.ws + OFF_SLAB);
  const bf16_t* W = (const bf16_t*)(p.ws + OFF_WB) + WOUT;
  float* out = p.out;
  for (int it = 0;; ++it) {
    int mt, nt; int s = sched_tile(it, 128, 4, mt, nt);
    if (s < 0) break; if (s == 0) continue;
    acc8p_t acc;
    gemm8p<D_, D_, 16>(MG + (size_t)mt * 256 * D_, W + (size_t)nt * 256 * D_, smem, acc);
    EPI_IDS
    float* tp = out + (size_t)(mt * 256) * D_ + nt * 256;
    const unsigned loff = (unsigned)((wr * 64 + fq * 4) * D_ + wc * 32 + fr);
    EPI_FOR {
      const int ro = LROW(ai, m, j) * D_ + LCOL(bj, n);
      (tp + ro)[loff] = (tp + ro)[loff] + acc[ai][bj][m][n][j];
    }
  }
}

#define XB_TMO      128
#define XB_XCNT(j)  (256  + 64 * (j))
#define XB_XSUB(j)  (1280 + 64 * (j))
#define XB_XGEN(j)  (2304 + 64 * (j))
#define XB_TOP      3328
#define XB_TOPGEN   3392
#define XCD_BAR_WORDS 3456
#define XB_SPIN_CAP (1u << 22)
#define LAS __attribute__((address_space(3)))
DI unsigned xb_ld(unsigned* p) { return __hip_atomic_load(p, __ATOMIC_RELAXED, __HIP_MEMORY_SCOPE_AGENT); }
DI unsigned xb_add(unsigned* p, unsigned v) { return __hip_atomic_fetch_add(p, v, __ATOMIC_RELAXED, __HIP_MEMORY_SCOPE_AGENT); }
DI unsigned xb_xcc_id() { return (unsigned)__builtin_amdgcn_s_getreg((3 << 11) | 20) & 0xFu; }
#define XB_SPIN(cond, bar) do { unsigned _sp = 0; while (cond) { __builtin_amdgcn_s_sleep(1); \
    if ((++_sp & 255u) == 0u) { if (xb_ld(&(bar)[XB_TMO])) break; if (_sp > XB_SPIN_CAP) { atomicAdd(&(bar)[XB_TMO], 1u); break; } } } } while (0)
struct XcdBarrier { unsigned* bar; unsigned x; volatile LAS unsigned* st; };
DI XcdBarrier xcd_barrier_post(unsigned* bar, volatile LAS unsigned* st) {
  XcdBarrier b; b.bar = bar; b.x = xb_xcc_id(); b.st = st;
  if (threadIdx.x == 0) (void)xb_add(&bar[XB_XCNT(b.x)], 1u);
  return b;
}
DI void xcd_barrier_complete(unsigned* bar, unsigned x, unsigned& nloc, unsigned& nx) {
  const unsigned G = gridDim.x * gridDim.y * gridDim.z;
  unsigned sum, cnt, mine, sp = 0u;
  for (;;) {
    sum = 0u; cnt = 0u; mine = 0u;
#pragma unroll
    for (unsigned j = 0; j < 16; ++j) { const unsigned c = xb_ld(&bar[XB_XCNT(j)]); sum += c; cnt += (c > 0u) ? 1u : 0u; mine = (j == x) ? c : mine; }
    if (sum == G) break;
    __builtin_amdgcn_s_sleep(1);
    if ((++sp & 255u) == 0u) { if (xb_ld(&bar[XB_TMO])) break; if (sp > XB_SPIN_CAP) { atomicAdd(&bar[XB_TMO], 1u); break; } }
  }
  nloc = mine > 0u ? mine : 1u; nx = cnt > 0u ? cnt : 1u;
}
DI void xcd_barrier(const XcdBarrier& b) {
  asm volatile("s_waitcnt vmcnt(0)" ::: "memory");
  __syncthreads();
  if (threadIdx.x == 0) {
    unsigned* bar = b.bar;
    __builtin_amdgcn_s_waitcnt(0);
    unsigned nloc = b.st[0], nx = b.st[1];
    if (nloc == 0u) { xcd_barrier_complete(bar, b.x, nloc, nx); b.st[0] = nloc; b.st[1] = nx; }
    const unsigned old = xb_add(&bar[XB_XSUB(b.x)], 1u);
    const unsigned gen = old / nloc;
    if (old + 1u == (gen + 1u) * nloc) {
      __builtin_amdgcn_fence(__ATOMIC_RELEASE, "agent");
      asm volatile("s_waitcnt vmcnt(0)" ::: "memory");
      const unsigned og = xb_add(&bar[XB_TOP], 1u);
      const unsigned tg = og / nx;
      if (og + 1u == (tg + 1u) * nx) xb_add(&bar[XB_TOPGEN], 1u);
      else XB_SPIN(xb_ld(&bar[XB_TOPGEN]) == tg, bar);
      __builtin_amdgcn_fence(__ATOMIC_ACQUIRE, "agent");
      xb_add(&bar[XB_XGEN(b.x)], 1u);
      asm volatile("s_waitcnt vmcnt(0)" ::: "memory");
    } else {
      XB_SPIN(xb_ld(&bar[XB_XGEN(b.x)]) == gen, bar);
      __builtin_amdgcn_fence(__ATOMIC_ACQUIRE, "agent");
      asm volatile("s_waitcnt vmcnt(0)" ::: "memory");
    }
  }
  __syncthreads();
}

DI void run_phase(const Params& p, int ph, char* smem) {
  switch (ph) {
    case 0: phase_prep(p, smem); break;
    case 1: phase_ffn_gu(p, W1GU, smem); break;
    case 2: phase_ffn_down(p, W1D, p.x, smem); break;
    case 3: phase_rmsnorm_widx(p, smem); break;
    case 4: phase_win(p, smem); break;
    case 5: phase_qproj(p, smem); break;
    case 6: phase_mix<false>(p, smem); break;
    case 13: phase_mix<true>(p, smem); break;
    case 14: phase_sb_dummy(p, smem); break;
    case 7: phase_sparse(p, smem); break;
    case 8: phase_merge(p, smem); break;
    case 9: phase_outproj(p, smem); break;
    case 10: phase_rmsnorm(p.out, p.g_ffn2, (bf16_t*)(p.ws + OFF_H)); break;
    case 11: phase_ffn_gu(p, W2GU, smem); break;
    case 12: phase_ffn_down(p, W2D, p.out, smem); break;
  }
}
constexpr int NPHASE = 13;

#if !MULTI_LAUNCH
__global__ void __launch_bounds__(512, 2) mega_kernel(Params p) {
  __shared__ __attribute__((aligned(16))) char smem[SMEM_BYTES];
  __shared__ uint4 xb_words;
  cg::grid_group grid = cg::this_grid();
  if (threadIdx.x == 0) xb_words = make_uint4(0u, 0u, 0u, 0u);
  __syncthreads();
  XcdBarrier xb = xcd_barrier_post((unsigned*)(p.ws + OFF_CNT + 256), (volatile LAS unsigned*)&xb_words);
  unsigned* bar0 = (unsigned*)(p.ws + OFF_CNT + 256);
  if (threadIdx.x == 0) g_sched[3] = (int)xb_add(&bar0[XB_XCNT(xb.x) + 16], 1u);
  grid.sync();
  if (threadIdx.x == 0) {
    const unsigned per = gridDim.x >> 3; bool ok = (gridDim.x & 7) == 0 && xb.x < 8;
    for (unsigned jx = 0; jx < 16; ++jx) { const unsigned c = xb_ld(&bar0[XB_XCNT(jx) + 16]); ok = ok && (c == (jx < 8 ? per : 0u)); }
    g_sched[0] = ok ? (int)xb.x : (int)(blockIdx.x & 7);
    g_sched[1] = ok ? g_sched[3] : (int)(blockIdx.x >> 3);
  }
  __syncthreads();
#pragma nounroll
  for (int ph = 0; ph < NPHASE; ++ph) {
    int phv = ph; asm volatile("" : "+s"(phv));
    run_phase(p, phv, smem);
    if (ph + 1 < NPHASE) xcd_barrier(xb);
  }
}
#else
template <int PH>
__global__ void __launch_bounds__(512, 2) phase_kernel(Params p) {
  __shared__ __attribute__((aligned(16))) char smem[SMEM_BYTES];
  if (threadIdx.x == 0) { g_sched[0] = blockIdx.x & 7; g_sched[1] = blockIdx.x >> 3; }
  __syncthreads();
  run_phase(p, PH, smem);
}
#ifndef PROBE_MASK
#define PROBE_MASK 0
#endif
template <int PH> static void launch_phases(const Params& p, hipStream_t stream) {
  hipLaunchKernelGGL(phase_kernel<PH>, dim3(256), dim3(NTHR), 0, stream, p);
  if constexpr (((PROBE_MASK >> PH) & 1) != 0 && PH != 6) hipLaunchKernelGGL(phase_kernel<PH>, dim3(256), dim3(NTHR), 0, stream, p);
  if constexpr (((PROBE_MASK >> PH) & 1) != 0 && PH == 6) hipLaunchKernelGGL(phase_kernel<13>, dim3(256), dim3(NTHR), 0, stream, p);
  if constexpr (((PROBE_MASK >> 14) & 1) != 0 && PH == 5) hipLaunchKernelGGL(phase_kernel<14>, dim3(256), dim3(NTHR), 0, stream, p);
  if constexpr (PH + 1 < NPHASE) launch_phases<PH + 1>(p, stream);
}
#endif

extern "C" void kernel_launch(void* const* d_in, const int* in_sizes, int n_in, void* d_out, int out_size, void* d_ws,
                              size_t ws_size, hipStream_t stream) {
  Params p{};
  p.x = (const float*)d_in[0]; p.pos = (const int*)d_in[1];
  p.g_ffn1 = (const float*)d_in[2]; p.w1g = (const float*)d_in[3]; p.w1u = (const float*)d_in[4]; p.w1d = (const float*)d_in[5];
  p.g_mix = (const float*)d_in[6]; p.w_in = (const float*)d_in[7]; p.g_cq = (const float*)d_in[8]; p.w_uq = (const float*)d_in[9];
  p.w_qi = (const float*)d_in[10]; p.g_qa = (const float*)d_in[11]; p.g_ka = (const float*)d_in[12]; p.w_uv = (const float*)d_in[13];
  p.w_oa = (const float*)d_in[14]; p.w_ob = (const float*)d_in[15]; p.w_out = (const float*)d_in[16]; p.g_ffn2 = (const float*)d_in[17];
  p.w2g = (const float*)d_in[18]; p.w2u = (const float*)d_in[19]; p.w2d = (const float*)d_in[20];
  p.out = (float*)d_out; p.ws = (char*)d_ws;
  if (ws_size < WS_NEED) { fprintf(stderr, "workspace too small: %zu < %zu\n", ws_size, (size_t)WS_NEED); return; }
  (void)hipMemsetAsync((char*)d_ws + OFF_CNT, 0, 256 + 16384, stream);
#if MULTI_LAUNCH
  launch_phases<0>(p, stream);
#else
  static int grid_blocks = 0;
  if (!grid_blocks) {
    int dev = 0, cus = 0, per_cu = 0;
    (void)hipGetDevice(&dev);
    (void)hipDeviceGetAttribute(&cus, hipDeviceAttributeMultiprocessorCount, dev);
    (void)hipOccupancyMaxActiveBlocksPerMultiprocessor(&per_cu, mega_kernel, NTHR, 0);
    if (per_cu > 1) per_cu = 1;
    grid_blocks = cus * per_cu;
    if (grid_blocks > 256) grid_blocks = 256;
  }
  void* args[] = {&p};
  hipError_t e = hipLaunchCooperativeKernel((void*)mega_kernel, dim3(grid_blocks), dim3(NTHR), args, 0, stream);
  if (e != hipSuccess) fprintf(stderr, "cooperative launch failed: %s (grid %d)\n", hipGetErrorString(e), grid_blocks);
#endif
}
```

```cpp
#include <hip/hip_runtime.h>
#include <hip/hip_cooperative_groups.h>
#include <stdint.h>
#include <stdio.h>
namespace cg = cooperative_groups;

#ifndef MULTI_LAUNCH
#define MULTI_LAUNCH 0
#endif

#define DI __device__ __forceinline__
typedef unsigned short bf16_t;
typedef __attribute__((ext_vector_type(8))) short bf16x8;
typedef __attribute__((ext_vector_type(16))) float f32x16;
typedef __attribute__((ext_vector_type(4))) float f32x4;
typedef __attribute__((ext_vector_type(4))) unsigned u32x4;
typedef __attribute__((ext_vector_type(2))) unsigned u32x2;
typedef __attribute__((ext_vector_type(4))) short s16x4;

constexpr int T_ = 32768, S_ = 4096, D_ = 1024, FF = 2816;
constexpr int PA_LD = 1536;
constexpr int PA_KA = 256, PA_VA = 320, PA_KI = 448, PA_QB = 512, PA_KB = 1024;
constexpr float EPS = 1e-6f;
constexpr float LOG2E = 1.4426950408889634f;

constexpr size_t W1GU = 0;
constexpr size_t W1D = W1GU + (size_t)5632 * 1024;
constexpr size_t W2GU = W1D + (size_t)1024 * 2816;
constexpr size_t W2D = W2GU + (size_t)5632 * 1024;
constexpr size_t WIN = W2D + (size_t)1024 * 2816;
constexpr size_t WQ = WIN + (size_t)4096 * 1024;
constexpr size_t WUV = WQ + (size_t)1024 * 256;
constexpr size_t WOA = WUV + (size_t)512 * 128;
constexpr size_t WOB = WOA + (size_t)1024 * 512;
constexpr size_t WOUT = WOB + (size_t)1024 * 512;
constexpr size_t WB_ELEMS = WOUT + (size_t)1024 * 1024;
constexpr size_t OFF_WB = 0;
constexpr size_t OFF_H = (WB_ELEMS * 2 + 255) & ~(size_t)255;
constexpr size_t OFF_PA = OFF_H + (size_t)T_ * 1024 * 2;
constexpr size_t OFF_VT = OFF_PA + (size_t)T_ * PA_LD * 2;
constexpr size_t OFF_GATES = OFF_VT + (size_t)T_ * 512 * 2;
constexpr size_t OFF_SLAB = OFF_GATES + (size_t)T_ * 2048 * 2;
constexpr size_t OFF_WIDX = OFF_SLAB + (size_t)512 * 16 * 4096 * 4;
constexpr size_t OFF_ROPE = OFF_WIDX + (size_t)T_ * 8 * 4;
constexpr size_t OFF_CNT = OFF_ROPE + (size_t)T_ * 32 * 8;
constexpr size_t WS_NEED = OFF_CNT + 256 + 16384;
static_assert(WS_NEED <= (size_t)512 * 1024 * 1024, "workspace too large");
static_assert((size_t)T_ * FF * 2 <= OFF_SLAB - OFF_PA, "U must fit in PA+VT+GATES");

constexpr int SMEM_BYTES = 131072 + 2048;
__shared__ int g_sched[4];
constexpr int NTHR = 512, NWAVE = 8;

struct Params {
  const float* x; const int* pos;
  const float *g_ffn1, *w1g, *w1u, *w1d, *g_mix, *w_in, *g_cq, *w_uq, *w_qi, *g_qa, *g_ka, *w_uv, *w_oa, *w_ob, *w_out, *g_ffn2, *w2g, *w2u, *w2d;
  float* out;
  char* ws;
};

typedef __attribute__((ext_vector_type(2))) __bf16 bf16x2_t;
typedef __attribute__((ext_vector_type(2))) float f32x2_t;
DI unsigned pack2(float a, float b) { f32x2_t v = {a, b}; return __builtin_bit_cast(unsigned, __builtin_convertvector(v, bf16x2_t)); }
DI unsigned f2bf(float x) { return pack2(x, 0.f) & 0xffffu; }
DI float bf2f(unsigned v) { return __uint_as_float(v << 16); }
DI float bflo(unsigned v) { return __uint_as_float(v << 16); }
DI float bfhi(unsigned v) { return __uint_as_float(v & 0xffff0000u); }
DI float fexp2(float x) { return __builtin_amdgcn_exp2f(x); }
DI float frcp(float x) { return __builtin_amdgcn_rcpf(x); }
DI float wave_sum(float v) {
#pragma unroll
  for (int o = 32; o > 0; o >>= 1) v += __shfl_xor(v, o);
  return v;
}
#define MFMA32(a, b, c) __builtin_amdgcn_mfma_f32_32x32x16_bf16((a), (b), (c), 0, 0, 0)
#define MFMA16(a, b, c) __builtin_amdgcn_mfma_f32_16x16x32_bf16((a), (b), (c), 0, 0, 0)
DI bf16x8 ld_frag_g(const bf16_t* p) { return __builtin_bit_cast(bf16x8, *(const u32x4*)p); }
DI bf16x8 ld_frag_s(const char* p) { return __builtin_bit_cast(bf16x8, *(const u32x4*)p); }
DI int otid() { int t = threadIdx.x; asm volatile("" : "+v"(t)); return t; }
DI int owid(int tid) { return __builtin_amdgcn_readfirstlane(tid >> 6); }
DI int crow(int reg, int g) { return (reg & 3) + 8 * (reg >> 2) + 4 * g; }

DI const float* prep_col(const Params& p, int mat, int r, int& ld) {
  switch (mat) {
    case 0: case 2: {
      int j = r >> 8, q = r & 255; int half = q >> 7, c = q & 127;
      int n = j * 128 + c; ld = FF;
      const float* g = mat == 0 ? p.w1g : p.w2g; const float* u = mat == 0 ? p.w1u : p.w2u;
      return (half ? u : g) + n;
    }
    case 1: ld = D_; return p.w1d + r;
    case 3: ld = D_; return p.w2d + r;
    case 4: {
      ld = 4104;
      if (r < 512) return p.w_in + r;
      return p.w_in + r + 8;
    }
    case 5: {
      ld = 512;
      int T = r >> 8, q = r & 255; int hl = (q & 127) >> 5, d = (q >> 7) * 32 + (q & 31);
      int col = ((T & 1) * 4 + hl) * 64 + d;
      return (T < 2 ? p.w_uq : p.w_qi) + col;
    }
    case 6: { ld = 64; int h = r >> 6, d = r & 63; return p.w_uv + h * 8192 + d; }
    case 7: ld = D_; return p.w_oa + r;
    case 8: ld = D_; return p.w_ob + r;
    default: ld = D_; return p.w_out + r;
  }
}

DI void prep_transpose_tile(const Params& p, bool valid, int mat, int K, bf16_t* dst, int tile, float* lds, int t) {
  const int nkt = K >> 7;
  const int r0 = (tile / nkt) * 32, k0 = (tile % nkt) * 128;
  const int tx = t & 31, ty = t >> 5;
  if (valid) {
    int ld; const float* col = prep_col(p, mat, r0 + tx, ld);
#pragma unroll
    for (int i = 0; i < 16; ++i) {
      int k = k0 + ty + 8 * i;
      float v = 0.f;
      if (col) { v = col[(size_t)k * ld]; if (mat == 5) v *= p.g_cq[k]; }
      lds[tx * 129 + ty + 8 * i] = v;
    }
  }
  __syncthreads();
  if (valid) {
    const int row = t >> 3, kc = (t & 7) * 16;
    const float* s = lds + row * 129 + kc;
    u32x4 o0, o1;
    o0[0] = pack2(s[0], s[1]); o0[1] = pack2(s[2], s[3]); o0[2] = pack2(s[4], s[5]); o0[3] = pack2(s[6], s[7]);
    o1[0] = pack2(s[8], s[9]); o1[1] = pack2(s[10], s[11]); o1[2] = pack2(s[12], s[13]); o1[3] = pack2(s[14], s[15]);
    u32x4* d = (u32x4*)(dst + (size_t)(r0 + row) * K + k0 + kc);
    d[0] = o0; d[1] = o1;
  }
  __syncthreads();
}

DI void rmsnorm_row(const float* __restrict__ xr, const float* __restrict__ g, bf16_t* __restrict__ o) {
  const int lane = otid() & 63;
  float4 v[4]; float ss = 0.f;
#pragma unroll
  for (int j = 0; j < 4; ++j) { v[j] = *(const float4*)(xr + lane * 4 + 256 * j); ss += v[j].x * v[j].x + v[j].y * v[j].y + v[j].z * v[j].z + v[j].w * v[j].w; }
  ss = wave_sum(ss);
  const float rs = rsqrtf(ss * (1.f / 1024.f) + EPS);
#pragma unroll
  for (int j = 0; j < 4; ++j) {
    float4 gg = *(const float4*)(g + lane * 4 + 256 * j);
    u32x2 w; w[0] = pack2(v[j].x * rs * gg.x, v[j].y * rs * gg.y); w[1] = pack2(v[j].z * rs * gg.z, v[j].w * rs * gg.w);
    *(u32x2*)(o + lane * 4 + 256 * j) = w;
  }
}

DI void phase_rmsnorm(const float* __restrict__ src, const float* __restrict__ g, bf16_t* __restrict__ dst) {
  const int wid = owid(otid());
  for (int it = blockIdx.x; it < T_ / NWAVE; it += gridDim.x) {
    int row = it * NWAVE + wid;
    rmsnorm_row(src + (size_t)row * D_, g, dst + (size_t)row * D_);
  }
}

DI void phase_rmsnorm_widx(const Params& p, char* smem) {
  const int tid = otid(), lane = tid & 63, wid = owid(tid);
  float* wl = (float*)smem;
  for (int e = tid; e < 8 * 1024; e += NTHR) { int k = e >> 3, h = e & 7; wl[h * 1024 + k] = p.w_in[(size_t)k * 4104 + 512 + h]; }
  __syncthreads();
  const float* src = p.out; const float* g = p.g_mix;
  bf16_t* dst = (bf16_t*)(p.ws + OFF_H);
  float* WI = (float*)(p.ws + OFF_WIDX);
  for (int it = blockIdx.x; it < T_ / NWAVE; it += gridDim.x) {
    const int row = it * NWAVE + wid;
    const float* xr = src + (size_t)row * D_;
    float4 v[4]; float ss = 0.f;
#pragma unroll
    for (int j = 0; j < 4; ++j) { v[j] = *(const float4*)(xr + lane * 4 + 256 * j); ss += v[j].x * v[j].x + v[j].y * v[j].y + v[j].z * v[j].z + v[j].w * v[j].w; }
    ss = wave_sum(ss);
    const float rs = rsqrtf(ss * (1.f / 1024.f) + EPS);
    float acc[8];
#pragma unroll
    for (int h = 0; h < 8; ++h) acc[h] = 0.f;
#pragma unroll
    for (int j = 0; j < 4; ++j) {
      float4 gg = *(const float4*)(g + lane * 4 + 256 * j);
      const float y0 = v[j].x * rs * gg.x, y1 = v[j].y * rs * gg.y, y2 = v[j].z * rs * gg.z, y3 = v[j].w * rs * gg.w;
      u32x2 w; w[0] = pack2(y0, y1); w[1] = pack2(y2, y3);
      *(u32x2*)(dst + (size_t)row * D_ + lane * 4 + 256 * j) = w;
#pragma unroll
      for (int h = 0; h < 8; ++h) {
        const f32x4 ww = *(const f32x4*)(wl + h * 1024 + lane * 4 + 256 * j);
        acc[h] += y0 * ww[0] + y1 * ww[1] + y2 * ww[2] + y3 * ww[3];
      }
    }
#pragma unroll
    for (int h = 0; h < 8; ++h) acc[h] = wave_sum(acc[h]);
    if (lane < 8) {
      float r = acc[0];
#pragma unroll
      for (int h = 1; h < 8; ++h) r = lane == h ? acc[h] : r;
      WI[(size_t)row * 8 + lane] = r * 0.04419417382415922f;
    }
  }
  __syncthreads();
}

DI void phase_prep(const Params& p, char* smem) {
  bf16_t* wb = (bf16_t*)(p.ws + OFF_WB);
  const int tid = otid(), vb = tid >> 8, t = tid & 255;
  float* lds = (float*)smem + vb * 4160;
  constexpr int c0 = 1408, c1 = c0 + 704, c2 = c1 + 1408, c3 = c2 + 704, c4 = c3 + 1024, c5 = c4 + 64, c6 = c5 + 16, c7 = c6 + 128, c8 = c7 + 128, c9 = c8 + 256;
  static_assert((c9 & 1) == 0, "pairs");
  for (int it0 = blockIdx.x; it0 < c9 / 2; it0 += gridDim.x) {
    const int it = it0 * 2 + vb;
    int mat, K, base; size_t off;
    if (it < c0) { mat = 0; K = 1024; base = 0; off = W1GU; }
    else if (it < c1) { mat = 1; K = 2816; base = c0; off = W1D; }
    else if (it < c2) { mat = 2; K = 1024; base = c1; off = W2GU; }
    else if (it < c3) { mat = 3; K = 2816; base = c2; off = W2D; }
    else if (it < c4) { mat = 4; K = 1024; base = c3; off = WIN; }
    else if (it < c5) { mat = 5; K = 256; base = c4; off = WQ; }
    else if (it < c6) { mat = 6; K = 128; base = c5; off = WUV; }
    else if (it < c7) { mat = 7; K = 512; base = c6; off = WOA; }
    else if (it < c8) { mat = 8; K = 512; base = c7; off = WOB; }
    else { mat = 9; K = 1024; base = c8; off = WOUT; }
    prep_transpose_tile(p, true, mat, K, wb + off, it - base, lds, t);
  }
  {
    const int wid = owid(tid);
    for (int it = blockIdx.x; it < T_ / NWAVE; it += gridDim.x) {
      int row = it * NWAVE + wid;
      rmsnorm_row(p.x + (size_t)row * D_, p.g_ffn1, (bf16_t*)(p.ws + OFF_H) + (size_t)row * D_);
    }
  }
  for (int it = blockIdx.x; it < T_ * 32 / NTHR; it += gridDim.x) {
    int e = it * NTHR + tid;
    int tok = e >> 5, i = e & 31;
    float inv_freq = exp2f(-(float)i * (13.287712379549449f / 32.f));
    float ang = (float)p.pos[tok] * inv_freq;
    double rev = (double)ang * 0.15915494309189535;
    rev -= floor(rev);
    float r = (float)rev;
    float2 cs; cs.x = __builtin_amdgcn_cosf(r); cs.y = __builtin_amdgcn_sinf(r);
    ((float2*)(p.ws + OFF_ROPE))[e] = cs;
  }
}

typedef f32x4 acc8p_t[2][2][4][2];
constexpr int G_BK = 64, G_HALF = 128, G_HT = G_HALF * G_BK;
DI int lds_byte(int r, int c) {
  int st = (r >> 4) * 2 + (c >> 5), rr = r & 15, cc = c & 31, ob = rr * 64 + cc * 2;
  return st * 1024 + (ob ^ (((ob >> 9) & 1) << 5));
}
DI void stage_rc(int b, int& R, int& C) {
  int st = b / 1024, sb = b % 1024, swz = sb ^ (((sb >> 9) & 1) << 5);
  R = (st >> 1) * 16 + swz / 64; C = (st & 1) * 32 + (swz % 64) / 2;
}
template <int LDA, int LDB, int NKT>
DI void gemm8p(const bf16_t* __restrict__ A, const bf16_t* __restrict__ Bt, char* smem, acc8p_t& acc) {
  static_assert(NKT >= 4 && (NKT % 2) == 0, "K tiles");
  bf16_t* shm = (bf16_t*)smem;
  const int tid = otid();
  const int wid = owid(tid), lane = tid & 63, wr = wid >> 2, wc = wid & 3, fr = lane & 15, fq = lane >> 4;
#define SA(b, h) (shm + ((b) * 2 + (h)) * G_HT)
#define SB(b, h) (shm + (4 + (b) * 2 + (h)) * G_HT)
  unsigned sofa, sofb;
  { int _r, _c; stage_rc(tid * 16, _r, _c); sofa = (unsigned)(_r * LDA + _c); sofb = (unsigned)(_r * LDB + _c); }
#define STAGE(P, BASE, LD, br, kt, SOF) do { const bf16_t* _ub = (BASE) + ((long)(br) * (LD) + (long)(kt) * G_BK);     \
    _Pragma("unroll") for (int _i = 0; _i < 2; ++_i) { \
      __builtin_amdgcn_global_load_lds((const unsigned*)((_ub + (long)_i * 64 * (LD)) + SOF), \
        (unsigned*)((char*)(P) + tid * 16 + _i * 8192), 16, 0, 0); } } while (0)
#define LDA_(dst, b, h) _Pragma("unroll") for (int m = 0; m < 4; ++m) _Pragma("unroll") for (int k = 0; k < 2; ++k) \
    dst[m][k] = *reinterpret_cast<const bf16x8*>((char*)SA(b, h) + lds_byte(wr * 64 + m * 16 + fr, k * 32 + fq * 8))
#define LDB_(dst, b, h) _Pragma("unroll") for (int n = 0; n < 2; ++n) _Pragma("unroll") for (int k = 0; k < 2; ++k) \
    dst[n][k] = *reinterpret_cast<const bf16x8*>((char*)SB(b, h) + lds_byte(wc * 32 + n * 16 + fr, k * 32 + fq * 8))
#define MMA(ai, bj, At_, Bt_) do { __builtin_amdgcn_s_setprio(1); \
    _Pragma("unroll") for (int m = 0; m < 4; ++m) _Pragma("unroll") for (int n = 0; n < 2; ++n) _Pragma("unroll") for (int k = 0; k < 2; ++k) \
      acc[ai][bj][m][n] = __builtin_amdgcn_mfma_f32_16x16x32_bf16(At_[m][k], Bt_[n][k], acc[ai][bj][m][n], 0, 0, 0); \
    __builtin_amdgcn_s_setprio(0); } while (0)
#define WAIT_V(n) asm volatile("s_waitcnt vmcnt(" #n ")" ::: "memory")
#define WAIT_L(n) asm volatile("s_waitcnt lgkmcnt(" #n ")" ::: "memory")
#define BAR __builtin_amdgcn_s_barrier()
#define SCHED __builtin_amdgcn_sched_barrier(0)
#pragma unroll
  for (int a = 0; a < 2; ++a)
#pragma unroll
    for (int b = 0; b < 2; ++b)
#pragma unroll
      for (int m = 0; m < 4; ++m)
#pragma unroll
        for (int n = 0; n < 2; ++n) acc[a][b][m][n] = f32x4{0.f, 0.f, 0.f, 0.f};
  bf16x8 At[4][2], B0[2][2], B1[2][2];
  constexpr int nt = NKT;
  WAIT_V(0);
  SCHED;
  STAGE(SB(0, 0), Bt, LDB, 0, 0, sofb); STAGE(SA(0, 0), A, LDA, 0, 0, sofa);
  STAGE(SB(0, 1), Bt, LDB, G_HALF, 0, sofb); STAGE(SA(0, 1), A, LDA, G_HALF, 0, sofa);
  if (wr == 1) BAR;
  WAIT_V(4); BAR;
  STAGE(SB(1, 0), Bt, LDB, 0, 1, sofb); STAGE(SA(1, 0), A, LDA, 0, 1, sofa); STAGE(SB(1, 1), Bt, LDB, G_HALF, 1, sofb);
  WAIT_V(6); BAR;
  for (int t = 0; t < nt - 2; t += 2) {
    LDB_(B0, 0, 0); SCHED; LDA_(At, 0, 0); STAGE(SA(1, 1), A, LDA, G_HALF, t + 1, sofa);
    WAIT_L(8); BAR; WAIT_L(0); MMA(0, 0, At, B0); BAR; SCHED;
    LDB_(B1, 0, 1); STAGE(SB(0, 0), Bt, LDB, 0, t + 2, sofb);
    BAR; WAIT_L(0); MMA(0, 1, At, B1); BAR;
    LDA_(At, 0, 1); STAGE(SA(0, 0), A, LDA, 0, t + 2, sofa);
    BAR; WAIT_L(0); MMA(1, 0, At, B0); BAR; SCHED;
    STAGE(SB(0, 1), Bt, LDB, G_HALF, t + 2, sofb);
    WAIT_V(6); BAR; MMA(1, 1, At, B1); BAR;
    LDB_(B0, 1, 0); SCHED; LDA_(At, 1, 0); STAGE(SA(0, 1), A, LDA, G_HALF, t + 2, sofa);
    WAIT_L(8); BAR; WAIT_L(0); MMA(0, 0, At, B0); BAR; SCHED;
    LDB_(B1, 1, 1); STAGE(SB(1, 0), Bt, LDB, 0, t + 3, sofb);
    BAR; WAIT_L(0); MMA(0, 1, At, B1); BAR;
    LDA_(At, 1, 1); STAGE(SA(1, 0), A, LDA, 0, t + 3, sofa);
    BAR; WAIT_L(0); MMA(1, 0, At, B0); BAR; SCHED;
    STAGE(SB(1, 1), Bt, LDB, G_HALF, t + 3, sofb);
    WAIT_V(6); BAR; MMA(1, 1, At, B1); BAR;
  }
  { LDB_(B0, 0, 0); LDA_(At, 0, 0); STAGE(SA(1, 1), A, LDA, G_HALF, nt - 1, sofa);
    BAR; WAIT_L(0); MMA(0, 0, At, B0); BAR;
    LDB_(B1, 0, 1); BAR; WAIT_L(0); MMA(0, 1, At, B1); BAR;
    LDA_(At, 0, 1); WAIT_V(4); BAR; WAIT_L(0); MMA(1, 0, At, B0); MMA(1, 1, At, B1); BAR; }
  { LDB_(B0, 1, 0); LDA_(At, 1, 0); WAIT_V(2); BAR; WAIT_L(0); MMA(0, 0, At, B0); BAR;
    LDB_(B1, 1, 1); WAIT_V(0); BAR; WAIT_L(0); MMA(0, 1, At, B1); BAR;
    LDA_(At, 1, 1); BAR; WAIT_L(0); MMA(1, 0, At, B0); MMA(1, 1, At, B1); BAR; }
  if (wr == 0) BAR;
#undef SA
#undef SB
#undef STAGE
#undef LDA_
#undef LDB_
#undef MMA
#undef WAIT_V
#undef WAIT_L
#undef BAR
#undef SCHED
}

DI int sched_tile(int it, int MT, int NT, int& mt, int& nt) {
  const int G = gridDim.x, b = blockIdx.x;
  const int per = G >> 3, pm = per >> 2;
  const int nfull = NT >> 2, w = NT & 3;
  if ((G & 31) == 0 && pm > 0 && (MT % pm) == 0 && w != 3 && (w == 0 || (MT % (per / w)) == 0)) {
    const int x = g_sched[0], j = g_sched[1];
    const int nsm = MT / pm;
    const int nmain = nsm * nfull;
    const int pm2 = w ? per / w : 1;
    const int ntail = w ? MT / pm2 : 0;
    const int st = it * 8 + x;
    if (st >= nmain + ntail) return -1;
    if (st < nmain) {
      const int sm = st / nfull, sn = st - sm * nfull;
      mt = sm * pm + (j % pm); nt = sn * 4 + (j / pm);
    } else {
      const int s2 = st - nmain;
      mt = s2 * pm2 + (j % pm2); nt = nfull * 4 + (j / pm2);
    }
    return 1;
  } else {
    const int tile = it * G + b;
    if (tile >= MT * NT) return -1;
    nt = tile % NT; mt = tile / NT;
    return 1;
  }
}

#define EPI_IDS const int tid = otid(), lane = tid & 63, wid = owid(tid), wr = wid >> 2, wc = wid & 3, fr = lane & 15, fq = lane >> 4; (void)wr; (void)wc; (void)fr; (void)fq;
#define LROW(ai, m, j) ((ai) * 128 + (m) * 16 + (j))
#define LCOL(bj, n) ((bj) * 128 + (n) * 16)
#define EPI_FOR _Pragma("unroll") for (int ai = 0; ai < 2; ++ai) _Pragma("unroll") for (int bj = 0; bj < 2; ++bj) \
    _Pragma("unroll") for (int m = 0; m < 4; ++m) _Pragma("unroll") for (int n = 0; n < 2; ++n) _Pragma("unroll") for (int j = 0; j < 4; ++j)

DI void phase_ffn_gu(const Params& p, size_t woff, char* smem) {
  const bf16_t* H = (const bf16_t*)(p.ws + OFF_H);
  const bf16_t* W = (const bf16_t*)(p.ws + OFF_WB) + woff;
  bf16_t* U = (bf16_t*)(p.ws + OFF_PA);
  for (int it = 0;; ++it) {
    int mt, nt; int s = sched_tile(it, 128, 22, mt, nt);
    if (s < 0) break; if (s == 0) continue;
    acc8p_t acc;
    gemm8p<D_, D_, 16>(H + (size_t)mt * 256 * D_, W + (size_t)nt * 256 * D_, smem, acc);
    EPI_IDS
    bf16_t* tp = U + (size_t)(mt * 256) * FF + nt * 128;
    const unsigned loff = (unsigned)((wr * 64 + fq * 4) * FF + wc * 32 + fr);
#pragma unroll
    for (int ai = 0; ai < 2; ++ai)
#pragma unroll
      for (int m = 0; m < 4; ++m)
#pragma unroll
        for (int n = 0; n < 2; ++n)
#pragma unroll
          for (int j = 0; j < 4; ++j) {
            float gv = acc[ai][0][m][n][j], uv = acc[ai][1][m][n][j];
            float sv = gv * frcp(1.f + fexp2(-LOG2E * gv)) * uv;
            (tp + LROW(ai, m, j) * FF + n * 16)[loff] = (bf16_t)f2bf(sv);
          }
  }
}

DI void phase_ffn_down(const Params& p, size_t woff, const float* res, char* smem) {
  const bf16_t* U = (const bf16_t*)(p.ws + OFF_PA);
  const bf16_t* W = (const bf16_t*)(p.ws + OFF_WB) + woff;
  float* out = p.out;
  for (int it = 0;; ++it) {
    int mt, nt; int s = sched_tile(it, 128, 4, mt, nt);
    if (s < 0) break; if (s == 0) continue;
    acc8p_t acc;
    gemm8p<FF, FF, 44>(U + (size_t)mt * 256 * FF, W + (size_t)nt * 256 * FF, smem, acc);
    EPI_IDS
    const size_t tb = (size_t)(mt * 256) * D_ + nt * 256;
    float* tp = out + tb; const float* rsp = res + tb;
    const unsigned loff = (unsigned)((wr * 64 + fq * 4) * D_ + wc * 32 + fr);
    EPI_FOR {
      const int ro = LROW(ai, m, j) * D_ + LCOL(bj, n);
      (tp + ro)[loff] = (rsp + ro)[loff] + 0.5f * acc[ai][bj][m][n][j];
    }
  }
}

DI void phase_win(const Params& p, char* smem) {
  const bf16_t* H = (const bf16_t*)(p.ws + OFF_H);
  const bf16_t* W = (const bf16_t*)(p.ws + OFF_WB) + WIN;
  bf16_t* PA = (bf16_t*)(p.ws + OFF_PA);
  bf16_t* VT = (bf16_t*)(p.ws + OFF_VT);
  bf16_t* GT = (bf16_t*)(p.ws + OFF_GATES);
  float* WI = (float*)(p.ws + OFF_WIDX);
  for (int it = 0;; ++it) {
    int mt, nt; int s = sched_tile(it, 128, 16, mt, nt);
    if (s < 0) break; if (s == 0) continue;
    acc8p_t acc;
    gemm8p<D_, D_, 16>(H + (size_t)mt * 256 * D_, W + (size_t)nt * 256 * D_, smem, acc);
    EPI_IDS
    if (nt < 6) {
      bf16_t* tp = PA + (size_t)(mt * 256) * PA_LD + nt * 256;
      const unsigned loff = (unsigned)((wr * 64 + fq * 4) * PA_LD + wc * 32 + fr);
      const float qsc = (nt == 2 || nt == 3) ? 0.125f * LOG2E : 1.f;
      EPI_FOR {
        const int ro = LROW(ai, m, j) * PA_LD + LCOL(bj, n);
        (tp + ro)[loff] = (bf16_t)f2bf(acc[ai][bj][m][n][j] * qsc);
      }
    } else if (nt < 8) {
      const int b = mt >> 4;
#pragma unroll
      for (int ai = 0; ai < 2; ++ai)
#pragma unroll
        for (int bj = 0; bj < 2; ++bj)
#pragma unroll
          for (int m = 0; m < 4; ++m)
#pragma unroll
            for (int n = 0; n < 2; ++n) {
              int c = (nt - 6) * 256 + bj * 128 + wc * 32 + n * 16 + fr;
              int h = c >> 6, d = c & 63;
              int tok = mt * 256 + ai * 128 + wr * 64 + m * 16 + fq * 4;
              bf16_t* dst = VT + ((size_t)(b * 8 + h) * 64 + d) * S_ + (tok & (S_ - 1));
              u32x2 w; w[0] = pack2(acc[ai][bj][m][n][0], acc[ai][bj][m][n][1]); w[1] = pack2(acc[ai][bj][m][n][2], acc[ai][bj][m][n][3]);
              *(u32x2*)dst = w;
            }
    } else if (nt < 16) {
      bf16_t* tp = GT + (size_t)(mt * 256) * 2048 + (nt - 8) * 256;
      const unsigned loff = (unsigned)((wr * 64 + fq * 4) * 2048 + wc * 32 + fr);
      EPI_FOR {
        const int ro = LROW(ai, m, j) * 2048 + LCOL(bj, n);
        float v = acc[ai][bj][m][n][j];
        float sg = frcp(1.f + fexp2(-LOG2E * v));
        (tp + ro)[loff] = (bf16_t)f2bf(sg);
      }
    }
  }
}

DI void phase_qproj(const Params& p, char* smem) {
  bf16_t* PA = (bf16_t*)(p.ws + OFF_PA);
  const bf16_t* W = (const bf16_t*)(p.ws + OFF_WB) + WQ;
  bf16_t* QA = (bf16_t*)(p.ws + OFF_H);
  bf16_t* QI = QA + (size_t)T_ * 512;
  const float2* ROPE = (const float2*)(p.ws + OFF_ROPE);
  float* rstd = (float*)(smem + 131072);
  for (int it = 0;; ++it) {
    int mt, nt; int s = sched_tile(it, 128, 4, mt, nt);
    if (s < 0) break; if (s == 0) continue;
    {
      const int tq = otid(); int row = tq >> 1, half = tq & 1;
      const bf16_t* src = PA + (size_t)(mt * 256 + row) * PA_LD + half * 128;
      float ss = 0.f;
#pragma unroll 4
      for (int i = 0; i < 16; ++i) {
        u32x4 v = *(const u32x4*)(src + i * 8);
#pragma unroll
        for (int j = 0; j < 4; ++j) { float a = bflo(v[j]), b = bfhi(v[j]); ss += a * a + b * b; }
      }
      ss += __shfl_xor(ss, 1);
      if (half == 0) rstd[row] = rsqrtf(ss * (1.f / 256.f) + EPS);
    }
    acc8p_t acc;
    gemm8p<PA_LD, 256, 4>(PA + (size_t)mt * 256 * PA_LD, W + (size_t)nt * 256 * 256, smem, acc);
    EPI_IDS
    const int head = (nt & 1) * 4 + wc;
    bf16_t* dtp = (nt < 2 ? QA : QI) + (size_t)(mt * 256) * 512 + head * 64;
    const float2* rtp = ROPE + (size_t)(mt * 256) * 32;
    const unsigned doff = (unsigned)((wr * 64 + fq * 4) * 512 + fr);
    const unsigned roff = (unsigned)((wr * 64 + fq * 4) * 32 + fr);
    const float* rsl = rstd + wr * 64 + fq * 4;
    float ga[4] = {1.f, 1.f, 1.f, 1.f};
    const bool do_norm = nt < 2;
    if (do_norm) { ga[0] = p.g_qa[fr]; ga[1] = p.g_qa[16 + fr]; ga[2] = p.g_qa[32 + fr]; ga[3] = p.g_qa[48 + fr]; }
#pragma unroll
    for (int ai = 0; ai < 2; ++ai)
#pragma unroll
      for (int m = 0; m < 4; ++m)
#pragma unroll
        for (int j = 0; j < 4; ++j) {
          const int lr = LROW(ai, m, j);
          const float rs = rsl[lr];
          float x0 = acc[ai][0][m][0][j] * rs, x1 = acc[ai][0][m][1][j] * rs;
          float y0 = acc[ai][1][m][0][j] * rs, y1 = acc[ai][1][m][1][j] * rs;
          if (do_norm) {
            float ss = x0 * x0 + x1 * x1 + y0 * y0 + y1 * y1;
#pragma unroll
            for (int o = 8; o > 0; o >>= 1) ss += __shfl_xor(ss, o);
            const float r2 = rsqrtf(ss * (1.f / 64.f) + EPS);
            x0 *= r2 * ga[0]; x1 *= r2 * ga[1]; y0 *= r2 * ga[2]; y1 *= r2 * ga[3];
          }
          const float2 c0 = (rtp + lr * 32)[roff], c1 = (rtp + lr * 32 + 16)[roff];
          bf16_t* dp = dtp + lr * 512;
          (dp)[doff] = (bf16_t)f2bf(x0 * c0.x - y0 * c0.y);
          (dp + 32)[doff] = (bf16_t)f2bf(x0 * c0.y + y0 * c0.x);
          (dp + 16)[doff] = (bf16_t)f2bf(x1 * c1.x - y1 * c1.y);
          (dp + 48)[doff] = (bf16_t)f2bf(x1 * c1.y + y1 * c1.x);
          if (j == 3) __builtin_amdgcn_sched_barrier(0);
        }
    __syncthreads();
  }
  const int tid = otid(), lane = tid & 63, wid = owid(tid);
  for (int it = blockIdx.x; it < T_ / 64; it += gridDim.x) {
    const int d = lane & 31; const bool isidx = lane >= 32;
    const float g0 = isidx ? 1.f : p.g_ka[d], g1 = isidx ? 1.f : p.g_ka[d + 32];
    for (int i = 0; i < 8; ++i) {
      int tok = it * 64 + wid * 8 + i;
      bf16_t* src = PA + (size_t)tok * PA_LD + (isidx ? PA_KI : PA_KA);
      float v0 = bf2f(src[d]), v1 = bf2f(src[d + 32]);
      float ss = v0 * v0 + v1 * v1;
#pragma unroll
      for (int o = 16; o > 0; o >>= 1) ss += __shfl_xor(ss, o);
      if (!isidx) { float r2 = rsqrtf(ss * (1.f / 64.f) + EPS); v0 *= r2 * g0; v1 *= r2 * g1; }
      float2 cs = ROPE[(size_t)tok * 32 + d];
      float o0 = v0 * cs.x - v1 * cs.y, o1 = v0 * cs.y + v1 * cs.x;
      src[d] = (bf16_t)f2bf(o0); src[d + 32] = (bf16_t)f2bf(o1);
    }
  }
}

DI f32x16 sb_qk(const char* cur, int sub, int r, int g, int sw, const bf16x8 (&qf)[4]) {
  f32x16 z;
#pragma unroll
  for (int i = 0; i < 16; ++i) z[i] = 0.f;
#pragma unroll
  for (int ks = 0; ks < 4; ++ks) {
    bf16x8 kf = ld_frag_s(cur + (sub * 32 + r) * 128 + (((ks * 2 + g) ^ sw) << 4));
    z = MFMA32(kf, qf[ks], z);
  }
  return z;
}
template <bool DIAG>
DI void sb_elem(const f32x16& z, int r, int g, float& R, bf16x8& pf0, bf16x8& pf1) {
  float e[16], rr[16];
#pragma unroll
  for (int i = 0; i < 16; ++i) {
    float z2 = fminf(z[i], 80.f);
    float ev = fexp2(z2);
    float rv_ = frcp(1.f + ev);
    if (DIAG && !(crow(i, g) < r)) { ev = 0.f; rv_ = 1.f; }
    e[i] = ev; rr[i] = rv_;
  }
  float G[4], Gp[4];
#pragma unroll
  for (int q = 0; q < 4; ++q) {
    rr[4 * q + 2] *= rr[4 * q + 3];
    rr[4 * q + 1] *= rr[4 * q + 2];
    rr[4 * q + 0] *= rr[4 * q + 1];
    G[q] = rr[4 * q];
  }
#pragma unroll
  for (int q = 0; q < 4; ++q) Gp[q] = __shfl_xor(G[q], 32);
  float SO[4], SP[4];
  SO[3] = 1.f; SO[2] = G[3]; SO[1] = G[2] * G[3]; SO[0] = G[1] * SO[1];
  SP[3] = 1.f; SP[2] = Gp[3]; SP[1] = Gp[2] * Gp[3]; SP[0] = Gp[1] * SP[1];
  float a[16];
#pragma unroll
  for (int q = 0; q < 4; ++q) {
    float part = g == 0 ? SP[q] * Gp[q] : SP[q];
    float E = SO[q] * part * R;
#pragma unroll
    for (int j = 0; j < 4; ++j) a[4 * q + j] = e[4 * q + j] * rr[4 * q + j] * E;
  }
  R = R * (SO[0] * G[0]) * (SP[0] * Gp[0]);
  u32x4 pw0, pw1;
#pragma unroll
  for (int j = 0; j < 4; ++j) { pw0[j] = pack2(a[2 * j], a[2 * j + 1]); pw1[j] = pack2(a[8 + 2 * j], a[8 + 2 * j + 1]); }
  pf0 = __builtin_bit_cast(bf16x8, pw0); pf1 = __builtin_bit_cast(bf16x8, pw1);
}
DI void sb_pv(const char* cur, int sub, int r, int g, const bf16x8& pf0, const bf16x8& pf1, f32x16& o0, f32x16& o1) {
#pragma unroll
  for (int ks2 = 0; ks2 < 2; ++ks2) {
    const bf16x8 pf = ks2 == 0 ? pf0 : pf1;
#pragma unroll
    for (int dt = 0; dt < 2; ++dt) {
      const char* vp = cur + 8192 + (dt * 32 + r) * 136 + (sub * 32 + 16 * ks2 + 4 * g) * 2;
      u32x2 lo = *(const u32x2*)vp, hi = *(const u32x2*)(vp + 16);
      u32x4 vv; vv[0] = lo[0]; vv[1] = lo[1]; vv[2] = hi[0]; vv[3] = hi[1];
      bf16x8 vf = __builtin_bit_cast(bf16x8, vv);
      if (dt == 0) o0 = MFMA32(vf, pf, o0); else o1 = MFMA32(vf, pf, o1);
    }
  }
}

template <bool DUMMY>
DI void sb_item(const Params& p, int b, int h, int qb, char* smem) {
  bf16_t* PA = (bf16_t*)(p.ws + OFF_PA);
  const bf16_t* VT = (const bf16_t*)(p.ws + OFF_VT) + (size_t)(b * 8 + h) * 64 * S_;
  const int tid = otid(), lane = tid & 63, wid = owid(tid), g = lane >> 5, r = lane & 31;
  const int tw = qb * 256 + wid * 32;
  constexpr int BUFSZ = 8192 + 8704;
  bf16x8 qf[4];
  {
    const bf16_t* qp = PA + (size_t)(b * S_ + tw + r) * PA_LD + PA_QB + h * 64 + g * 8;
#pragma unroll
    for (int ks = 0; ks < 4; ++ks) qf[ks] = ld_frag_g(qp + ks * 16);
  }
  const int srow = tid >> 3, sch = tid & 7;
  const bf16_t* gk = PA + (size_t)(b * S_ + srow) * PA_LD + PA_KB + h * 64 + sch * 8;
  const bf16_t* gv = VT + (size_t)srow * S_ + sch * 8;
  const unsigned k_st = srow * 128 + ((sch ^ ((srow >> 1) & 7)) << 4);
  const unsigned v_st = 8192 + srow * 136 + sch * 16;
  const int sw = (lane >> 1) & 7;
  f32x16 o0, o1;
#pragma unroll
  for (int i = 0; i < 16; ++i) { o0[i] = 0.f; o1[i] = 0.f; }
  float R = 1.f;
  const int nkt = 4 * qb + 4;
  u32x4 rk, rv;
  {
    int kt = nkt - 1;
    rk = *(const u32x4*)(gk + (size_t)(kt * 64) * PA_LD); rv = *(const u32x4*)(gv + kt * 64);
    char* cur = smem + (kt & 1) * BUFSZ;
    *(u32x4*)(cur + k_st) = rk;
    u32x2 lo, hi; lo[0] = rv[0]; lo[1] = rv[1]; hi[0] = rv[2]; hi[1] = rv[3];
    *(u32x2*)(cur + v_st) = lo; *(u32x2*)(cur + v_st + 8) = hi;
  }
  __syncthreads();
  for (int kt = nkt - 1; kt >= 0; --kt) {
    const char* cur = smem + (kt & 1) * BUFSZ;
    char* nxt = smem + ((kt + 1) & 1) * BUFSZ;
    const bool more = kt > 0;
    if (more) { rk = *(const u32x4*)(gk + (size_t)((kt - 1) * 64) * PA_LD); rv = *(const u32x4*)(gv + (kt - 1) * 64); }
    __builtin_amdgcn_sched_barrier(0);
    if (kt * 64 + 32 < tw) {
      const f32x16 z1 = sb_qk(cur, 1, r, g, sw, qf);
      const f32x16 z0 = sb_qk(cur, 0, r, g, sw, qf);
      bf16x8 p1a, p1b, p0a, p0b;
      sb_elem<false>(z1, r, g, R, p1a, p1b);
      sb_pv(cur, 1, r, g, p1a, p1b, o0, o1);
      sb_elem<false>(z0, r, g, R, p0a, p0b);
      sb_pv(cur, 0, r, g, p0a, p0b, o0, o1);
    } else {
#pragma unroll
      for (int sub = 1; sub >= 0; --sub) {
        const int sbase = kt * 64 + sub * 32;
        if (sbase <= tw) {
          const f32x16 z = sb_qk(cur, sub, r, g, sw, qf);
          bf16x8 pa, pb;
          if (sbase == tw) sb_elem<true>(z, r, g, R, pa, pb); else sb_elem<false>(z, r, g, R, pa, pb);
          sb_pv(cur, sub, r, g, pa, pb, o0, o1);
        }
      }
    }
    __builtin_amdgcn_sched_barrier(0);
    if (more) {
      *(u32x4*)(nxt + k_st) = rk;
      u32x2 lo, hi; lo[0] = rv[0]; lo[1] = rv[1]; hi[0] = rv[2]; hi[1] = rv[3];
      *(u32x2*)(nxt + v_st) = lo; *(u32x2*)(nxt + v_st + 8) = hi;
    }
    __syncthreads();
  }
  bf16_t* yp = DUMMY ? (bf16_t*)(p.ws + OFF_SLAB) + (size_t)(b * S_ + tw + r) * 512 + h * 64 : PA + (size_t)(b * S_ + tw + r) * PA_LD + PA_QB + h * 64;
#pragma unroll
  for (int rq = 0; rq < 4; ++rq) {
    u32x2 w0, w1;
    w0[0] = pack2(o0[4 * rq], o0[4 * rq + 1]); w0[1] = pack2(o0[4 * rq + 2], o0[4 * rq + 3]);
    w1[0] = pack2(o1[4 * rq], o1[4 * rq + 1]); w1[1] = pack2(o1[4 * rq + 2], o1[4 * rq + 3]);
    *(u32x2*)(yp + 8 * rq + 4 * g) = w0;
    *(u32x2*)(yp + 32 + 8 * rq + 4 * g) = w1;
  }
}

DI unsigned tokey(float f) { unsigned u = __float_as_uint(f); return (u & 0x80000000u) ? ~u : (u | 0x80000000u); }
DI int wave_count_sum(int c) {
  int tot = 0;
#pragma unroll
  for (int bt = 0; bt < 7; ++bt) tot += __builtin_popcountll(__ballot((c >> bt) & 1)) << bt;
  return tot;
}

DI void idx_item(const Params& p, int b, int qt, char* smem) {
  bf16_t* PA = (bf16_t*)(p.ws + OFF_PA);
  const bf16_t* QI = (const bf16_t*)(p.ws + OFF_H) + (size_t)T_ * 512;
  const float* WI = (const float*)(p.ws + OFF_WIDX);
  float* slab = (float*)(p.ws + OFF_SLAB) + (size_t)blockIdx.x * 16 * 4096;
  const int tid = otid(), lane = tid & 63, wid = owid(tid), g4 = lane >> 4, r = lane & 15;
  const int t0 = qt * 16;
  {
    bf16x8 qf[8][2]; float w[8];
    const bf16_t* qp = QI + (size_t)(b * S_ + t0 + r) * 512 + g4 * 8;
#pragma unroll
    for (int hh = 0; hh < 8; ++hh) { qf[hh][0] = ld_frag_g(qp + hh * 64); qf[hh][1] = ld_frag_g(qp + hh * 64 + 32); }
    {
      const float4* wp = (const float4*)(WI + (size_t)(b * S_ + t0 + r) * 8);
      float4 wa = wp[0], wb = wp[1];
      w[0] = wa.x; w[1] = wa.y; w[2] = wa.z; w[3] = wa.w; w[4] = wb.x; w[5] = wb.y; w[6] = wb.z; w[7] = wb.w;
    }
    const int nkt = qt + 1;
    const bf16_t* kbase = PA + (size_t)(b * S_ + r) * PA_LD + PA_KI + g4 * 8;
    bf16x8 k0, k1;
    {
      int kt = wid < nkt ? wid : 0;
      const bf16_t* kp = kbase + (size_t)(kt * 16) * PA_LD;
      k0 = ld_frag_g(kp); k1 = ld_frag_g(kp + 32);
    }
    for (int kt = wid; kt < nkt; kt += NWAVE) {
      bf16x8 n0, n1;
      {
        int kn = kt + NWAVE < nkt ? kt + NWAVE : kt;
        const bf16_t* kp = kbase + (size_t)(kn * 16) * PA_LD;
        n0 = ld_frag_g(kp); n1 = ld_frag_g(kp + 32);
      }
      f32x4 sc = {0.f, 0.f, 0.f, 0.f};
#pragma unroll
      for (int hh = 0; hh < 8; ++hh) {
        f32x4 c = {0.f, 0.f, 0.f, 0.f};
        c = MFMA16(k0, qf[hh][0], c);
        c = MFMA16(k1, qf[hh][1], c);
#pragma unroll
        for (int i = 0; i < 4; ++i) sc[i] += w[hh] * fmaxf(c[i], 0.f);
      }
      *(f32x4*)(slab + (size_t)r * 4096 + kt * 16 + 4 * g4) = sc;
      k0 = n0; k1 = n1;
    }
  }
  __syncthreads();
  for (int qi = 0; qi < 2; ++qi) {
    const int q = wid * 2 + qi;
    const int t = t0 + q, n = t + 1;
    unsigned short* out = (unsigned short*)(PA + (size_t)(b * S_ + t) * PA_LD);
    if (n <= 256) {
#pragma unroll
      for (int j = 0; j < 4; ++j) { int e = j * 64 + lane; out[e] = (unsigned short)(e < n ? e : 0); }
      continue;
    }
    const float* row = slab + (size_t)q * 4096 + lane;
    const int nj = (n + 63) >> 6;
    unsigned key[64];
#pragma unroll
    for (int ch = 0; ch < 4; ++ch) {
#pragma unroll
      for (int jj = 0; jj < 16; ++jj) key[ch * 16 + jj] = 0u;
      if (nj > ch * 16) {
#pragma unroll
        for (int jj = 0; jj < 16; ++jj) { const int j = ch * 16 + jj; if (j * 64 + lane < n) key[j] = tokey(row[j * 64]); }
      }
    }
    unsigned Tthr = 0u; int need = 0; bool exact = false;
    for (int bit = 31; bit >= 0; --bit) {
      const unsigned cand = Tthr | (1u << bit);
      int c = 0;
#pragma unroll
      for (int ch = 0; ch < 4; ++ch) {
        if (nj > ch * 16) {
#pragma unroll
          for (int jj = 0; jj < 16; ++jj) c += (key[ch * 16 + jj] >= cand) ? 1 : 0;
        }
      }
      const int cnt = wave_count_sum(c);
      if (cnt >= 256) Tthr = cand;
      if (cnt == 256) { exact = true; break; }
    }
    unsigned Tgt;
    if (exact) { Tgt = Tthr - 1u; need = 0; }
    else {
      int c = 0;
#pragma unroll
      for (int j = 0; j < 64; ++j) c += (key[j] > Tthr) ? 1 : 0;
      Tgt = Tthr; need = 256 - wave_count_sum(c);
    }
    const unsigned long long lt_mask = (1ull << lane) - 1ull;
    int base = 0, ties = 0;
#pragma unroll
    for (int j = 0; j < 64; ++j) {
      if (j < nj) {
        const bool gt = key[j] > Tgt;
        const bool eq = (!exact) && (key[j] == Tthr);
        const unsigned long long meq = __ballot(eq);
        const int myrank = ties + __builtin_popcountll(meq & lt_mask);
        const bool sel = gt || (eq && myrank < need);
        ties += __builtin_popcountll(meq);
        const unsigned long long ms = __ballot(sel);
        const int pos = base + __builtin_popcountll(ms & lt_mask);
        if (sel && pos < 256) out[pos] = (unsigned short)(j * 64 + lane);
        base += __builtin_popcountll(ms);
      }
    }
  }
  __syncthreads();
}

DI void phase_sb_dummy(const Params& p, char* smem) {
  unsigned* cnt = (unsigned*)(p.ws + OFF_CNT) + 16;
  int* s_item = (int*)(smem + SMEM_BYTES - 16);
  while (true) {
    if (otid() == 0) *s_item = (int)atomicAdd(cnt, 1u);
    __syncthreads();
    const int item = *s_item;
    __syncthreads();
    if (item >= 64 * 16) break;
    int qb = 15 - (item >> 6), bh = item & 63;
    sb_item<true>(p, bh >> 3, bh & 7, qb, smem);
  }
}

template <bool IDX_ONLY>
DI void phase_mix(const Params& p, char* smem) {
  unsigned* cnt = (unsigned*)(p.ws + OFF_CNT) + (IDX_ONLY ? 8 : 0);
  int* s_item = (int*)(smem + SMEM_BYTES - 16);
  constexpr int NSB = 64 * 16, NIDX = 8 * 256;
  while (true) {
    if (otid() == 0) *s_item = (int)atomicAdd(cnt, 1u);
    __syncthreads();
    const int item = *s_item;
    __syncthreads();
    if (IDX_ONLY) { if (item >= NIDX) break; int qt = 255 - (item >> 3), b = item & 7; idx_item(p, b, qt, smem); continue; }
    if (item >= NSB + NIDX) break;
    if (item < NSB) {
      int qb = 15 - (item >> 6), bh = item & 63;
      sb_item<false>(p, bh >> 3, bh & 7, qb, smem);
    } else {
      int j = item - NSB;
      int qt = 255 - (j >> 3), b = j & 7;
      idx_item(p, b, qt, smem);
    }
  }
}

DI void phase_sparse(const Params& p, char* smem) {
  const bf16_t* PA = (const bf16_t*)(p.ws + OFF_PA);
  const bf16_t* QA = (const bf16_t*)(p.ws + OFF_H);
  bf16_t* YA = (bf16_t*)(p.ws + OFF_SLAB + (size_t)64 * 1024 * 1024);
  const bf16_t* WUVb = (const bf16_t*)(p.ws + OFF_WB) + WUV;
  const int tid = otid(), lane = tid & 63, wid = owid(tid), g4 = lane >> 4, c = lane & 15;
  constexpr int WST = 10304;
  char* Vl = smem + wid * WST;
  int* Il = (int*)(smem + wid * WST + 9216);
  char* OL = smem + 8 * WST;
  const float sc2 = 0.125f * LOG2E;
  typedef __attribute__((address_space(3))) s16x4 lds_s16x4;
  for (int it = blockIdx.x; it < T_ / 16; it += gridDim.x) {
    const int tok0 = it * 16;
    const int b = tok0 >> 12;
#pragma nounroll
    for (int qi = 0; qi < 2; ++qi) {
      const int q = wid * 2 + qi;
      const int tok = tok0 + q, t = tok & (S_ - 1);
      const int nsel = t + 1 < 256 ? t + 1 : 256;
      const unsigned short* irow = (const unsigned short*)(PA + (size_t)tok * PA_LD);
#pragma unroll
      for (int j = 0; j < 4; ++j) { int e = j * 64 + lane; int v = irow[e]; Il[e] = e < nsel ? v : 0; }
      __syncthreads();
      bf16x8 qf0, qf1;
      {
        u32x4 z4 = {0u, 0u, 0u, 0u};
        qf0 = __builtin_bit_cast(bf16x8, z4); qf1 = qf0;
        if (c < 8) { const bf16_t* qp = QA + (size_t)tok * 512 + c * 64 + g4 * 8; qf0 = ld_frag_g(qp); qf1 = ld_frag_g(qp + 32); }
      }
      f32x4 acc[8];
#pragma unroll
      for (int ct = 0; ct < 8; ++ct) acc[ct] = f32x4{0.f, 0.f, 0.f, 0.f};
      float m = -INFINITY, sum = 0.f;
      const int nch = (nsel + 31) >> 5;
      const char* kbase = (const char*)(PA + (size_t)b * S_ * PA_LD);
#pragma nounroll
      for (int ch = 0; ch < nch; ++ch) {
        u32x4 vr[8];
#pragma unroll
        for (int r8 = 0; r8 < 8; ++r8) {
          const int row = r8 * 4 + g4;
          const int key = Il[ch * 32 + row];
          vr[r8] = *(const u32x4*)(kbase + (size_t)key * (PA_LD * 2) + PA_VA * 2 + c * 16);
        }
        f32x4 cc[2];
#pragma unroll
        for (int tt = 0; tt < 2; ++tt) {
          const int key = Il[ch * 32 + tt * 16 + c];
          const bf16_t* kp = (const bf16_t*)(kbase + (size_t)key * (PA_LD * 2)) + PA_KA + g4 * 8;
          const bf16x8 ka0 = ld_frag_g(kp), ka1 = ld_frag_g(kp + 32);
          f32x4 z = {0.f, 0.f, 0.f, 0.f};
          z = MFMA16(ka0, qf0, z);
          z = MFMA16(ka1, qf1, z);
          cc[tt] = z;
        }
        float cmax = -INFINITY;
#pragma unroll
        for (int tt = 0; tt < 2; ++tt)
#pragma unroll
          for (int i = 0; i < 4; ++i) {
            const int e = ch * 32 + tt * 16 + 4 * g4 + i;
            const float v = e < nsel ? cc[tt][i] : -INFINITY;
            cc[tt][i] = v; cmax = fmaxf(cmax, v);
          }
        cmax = fmaxf(cmax, __shfl_xor(cmax, 16)); cmax = fmaxf(cmax, __shfl_xor(cmax, 32));
        const float mn = fmaxf(m, cmax);
        const float alpha = fexp2((m - mn) * sc2);
        m = mn;
        float ps = 0.f; float pv[8];
#pragma unroll
        for (int tt = 0; tt < 2; ++tt)
#pragma unroll
          for (int i = 0; i < 4; ++i) { const float e2 = fexp2((cc[tt][i] - mn) * sc2); pv[tt * 4 + i] = e2; ps += e2; }
        sum = sum * alpha + ps;
        u32x4 pw; pw[0] = pack2(pv[0], pv[1]); pw[1] = pack2(pv[2], pv[3]); pw[2] = pack2(pv[4], pv[5]); pw[3] = pack2(pv[6], pv[7]);
        const bf16x8 pf = __builtin_bit_cast(bf16x8, pw);
#pragma unroll
        for (int ct = 0; ct < 8; ++ct) acc[ct] *= alpha;
#pragma unroll
        for (int r8 = 0; r8 < 8; ++r8) *(u32x4*)(Vl + (r8 * 4 + g4) * 288 + c * 16) = vr[r8];
        {
          const int qq = c >> 2, pp = c & 3;
          const char* vb0 = Vl + (4 * g4 + qq) * 288 + pp * 8;
#pragma unroll
          for (int ct = 0; ct < 8; ++ct) {
            const s16x4 lo = __builtin_amdgcn_ds_read_tr16_b64_v4i16((lds_s16x4*)(vb0 + ct * 32));
            const s16x4 hi = __builtin_amdgcn_ds_read_tr16_b64_v4i16((lds_s16x4*)(vb0 + 16 * 288 + ct * 32));
            const bf16x8 af = __builtin_shufflevector(lo, hi, 0, 1, 2, 3, 4, 5, 6, 7);
            acc[ct] = MFMA16(af, pf, acc[ct]);
          }
        }
      }
      sum += __shfl_xor(sum, 16); sum += __shfl_xor(sum, 32);
      const float inv = 1.f / sum;
      if (c < 8) {
#pragma unroll
        for (int ct = 0; ct < 8; ++ct) {
          u32x2 w; w[0] = pack2(acc[ct][0] * inv, acc[ct][1] * inv); w[1] = pack2(acc[ct][2] * inv, acc[ct][3] * inv);
          *(u32x2*)(OL + q * 2064 + c * 256 + (ct * 16 + 4 * g4) * 2) = w;
        }
      }
      __syncthreads();
    }
    {
      const int h = wid;
      bf16x8 af[4];
#pragma unroll
      for (int ks = 0; ks < 4; ++ks) af[ks] = ld_frag_s(OL + c * 2064 + h * 256 + (ks * 32 + g4 * 8) * 2);
#pragma nounroll
      for (int nt = 0; nt < 4; ++nt) {
        f32x4 cc = {0.f, 0.f, 0.f, 0.f};
        const bf16_t* wp = WUVb + (size_t)(h * 64 + nt * 16 + c) * 128 + g4 * 8;
#pragma unroll
        for (int ks = 0; ks < 4; ++ks) cc = MFMA16(af[ks], ld_frag_g(wp + ks * 32), cc);
#pragma unroll
        for (int i = 0; i < 4; ++i) YA[(size_t)(tok0 + 4 * g4 + i) * 512 + h * 64 + nt * 16 + c] = (bf16_t)f2bf(cc[i]);
      }
    }
    __syncthreads();
  }
}

DI void phase_merge(const Params& p, char* smem) {
  const bf16_t* YA = (const bf16_t*)(p.ws + OFF_SLAB + (size_t)64 * 1024 * 1024);
  const bf16_t* YB = (const bf16_t*)(p.ws + OFF_PA) + PA_QB;
  const bf16_t* Wa = (const bf16_t*)(p.ws + OFF_WB) + WOA;
  const bf16_t* Wb = (const bf16_t*)(p.ws + OFF_WB) + WOB;
  const bf16_t* GT = (const bf16_t*)(p.ws + OFF_GATES);
  bf16_t* MG = (bf16_t*)(p.ws + OFF_SLAB);
  for (int it = 0;; ++it) {
    int mt, nt; int s = sched_tile(it, 128, 4, mt, nt);
    if (s < 0) break; if (s == 0) continue;
    acc8p_t acc;
    gemm8p<512, 512, 8>(YA + (size_t)mt * 256 * 512, Wa + (size_t)nt * 256 * 512, smem, acc);
    EPI_IDS
    const unsigned goff = (unsigned)((wr * 64 + fq * 4) * 2048 + wc * 32 + fr);
    const unsigned loff = (unsigned)((wr * 64 + fq * 4) * D_ + wc * 32 + fr);
    const bf16_t* gp = GT + (size_t)(mt * 256) * 2048 + nt * 256;
    bf16_t* tp = MG + (size_t)(mt * 256) * D_ + nt * 256;
    EPI_FOR {
      const int lr = LROW(ai, m, j), lc = LCOL(bj, n);
      float ga = bf2f((gp + lr * 2048 + lc)[goff]);
      (tp + lr * D_ + lc)[loff] = (bf16_t)f2bf(ga * acc[ai][bj][m][n][j]);
    }
  }
  for (int it = 0;; ++it) {
    int mt, nt; int s = sched_tile(it, 128, 4, mt, nt);
    if (s < 0) break; if (s == 0) continue;
    acc8p_t acc;
    gemm8p<PA_LD, 512, 8>(YB + (size_t)mt * 256 * PA_LD, Wb + (size_t)nt * 256 * 512, smem, acc);
    EPI_IDS
    const unsigned goff = (unsigned)((wr * 64 + fq * 4) * 2048 + wc * 32 + fr);
    const unsigned loff = (unsigned)((wr * 64 + fq * 4) * D_ + wc * 32 + fr);
    const bf16_t* gp = GT + (size_t)(mt * 256) * 2048 + 1024 + nt * 256;
    bf16_t* tp = MG + (size_t)(mt * 256) * D_ + nt * 256;
    EPI_FOR {
      const int lr = LROW(ai, m, j), lc = LCOL(bj, n);
      float gb = bf2f((gp + lr * 2048 + lc)[goff]);
      bf16_t* e = (tp + lr * D_ + lc) + loff;
      *e = (bf16_t)f2bf(bf2f(*e) + gb * acc[ai][bj][m][n][j]);
    }
  }
}

DI void phase_outproj(const Params& p, char* smem) {
  const bf16_t* MG = (const bf16_t*)(p.ws + OFF_SLAB);
  const bf16_t* W = (const bf16_t*)(p.ws + OFF_WB) + WOUT;
  float* out = p.out;
  for (int it = 0;; ++it) {
    int mt, nt; int s = sched_tile(it, 128, 4, mt, nt);
    if (s < 0) break; if (s == 0) continue;
    acc8p_t acc;
    gemm8p<D_, D_, 16>(MG + (size_t)mt * 256 * D_, W + (size_t)nt * 256 * D_, smem, acc);
    EPI_IDS
    float* tp = out + (size_t)(mt * 256) * D_ + nt * 256;
    const unsigned loff = (unsigned)((wr * 64 + fq * 4) * D_ + wc * 32 + fr);
    EPI_FOR {
      const int ro = LROW(ai, m, j) * D_ + LCOL(bj, n);
      (tp + ro)[loff] = (tp + ro)[loff] + acc[ai][bj][m][n][j];
    }
  }
}

#define XB_TMO      128
#define XB_XCNT(j)  (256  + 64 * (j))
#define XB_XSUB(j)  (1280 + 64 * (j))
#define XB_XGEN(j)  (2304 + 64 * (j))
#define XB_TOP      3328
#define XB_TOPGEN   3392
#define XCD_BAR_WORDS 3456
#define XB_SPIN_CAP (1u << 22)
#define LAS __attribute__((address_space(3)))
DI unsigned xb_ld(unsigned* p) { return __hip_atomic_load(p, __ATOMIC_RELAXED, __HIP_MEMORY_SCOPE_AGENT); }
DI unsigned xb_add(unsigned* p, unsigned v) { return __hip_atomic_fetch_add(p, v, __ATOMIC_RELAXED, __HIP_MEMORY_SCOPE_AGENT); }
DI unsigned xb_xcc_id() { return (unsigned)__builtin_amdgcn_s_getreg((3 << 11) | 20) & 0xFu; }
#define XB_SPIN(cond, bar) do { unsigned _sp = 0; while (cond) { __builtin_amdgcn_s_sleep(1); \
    if ((++_sp & 255u) == 0u) { if (xb_ld(&(bar)[XB_TMO])) break; if (_sp > XB_SPIN_CAP) { atomicAdd(&(bar)[XB_TMO], 1u); break; } } } } while (0)
struct XcdBarrier { unsigned* bar; unsigned x; volatile LAS unsigned* st; };
DI XcdBarrier xcd_barrier_post(unsigned* bar, volatile LAS unsigned* st) {
  XcdBarrier b; b.bar = bar; b.x = xb_xcc_id(); b.st = st;
  if (threadIdx.x == 0) (void)xb_add(&bar[XB_XCNT(b.x)], 1u);
  return b;
}
DI void xcd_barrier_complete(unsigned* bar, unsigned x, unsigned& nloc, unsigned& nx) {
  const unsigned G = gridDim.x * gridDim.y * gridDim.z;
  unsigned sum, cnt, mine, sp = 0u;
  for (;;) {
    sum = 0u; cnt = 0u; mine = 0u;
#pragma unroll
    for (unsigned j = 0; j < 16; ++j) { const unsigned c = xb_ld(&bar[XB_XCNT(j)]); sum += c; cnt += (c > 0u) ? 1u : 0u; mine = (j == x) ? c : mine; }
    if (sum == G) break;
    __builtin_amdgcn_s_sleep(1);
    if ((++sp & 255u) == 0u) { if (xb_ld(&bar[XB_TMO])) break; if (sp > XB_SPIN_CAP) { atomicAdd(&bar[XB_TMO], 1u); break; } }
  }
  nloc = mine > 0u ? mine : 1u; nx = cnt > 0u ? cnt : 1u;
}
DI void xcd_barrier(const XcdBarrier& b) {
  asm volatile("s_waitcnt vmcnt(0)" ::: "memory");
  __syncthreads();
  if (threadIdx.x == 0) {
    unsigned* bar = b.bar;
    __builtin_amdgcn_s_waitcnt(0);
    unsigned nloc = b.st[0], nx = b.st[1];
    if (nloc == 0u) { xcd_barrier_complete(bar, b.x, nloc, nx); b.st[0] = nloc; b.st[1] = nx; }
    const unsigned old = xb_add(&bar[XB_XSUB(b.x)], 1u);
    const unsigned gen = old / nloc;
    if (old + 1u == (gen + 1u) * nloc) {
      __builtin_amdgcn_fence(__ATOMIC_RELEASE, "agent");
      asm volatile("s_waitcnt vmcnt(0)" ::: "memory");
      const unsigned og = xb_add(&bar[XB_TOP], 1u);
      const unsigned tg = og / nx;
      if (og + 1u == (tg + 1u) * nx) xb_add(&bar[XB_TOPGEN], 1u);
      else XB_SPIN(xb_ld(&bar[XB_TOPGEN]) == tg, bar);
      __builtin_amdgcn_fence(__ATOMIC_ACQUIRE, "agent");
      xb_add(&bar[XB_XGEN(b.x)], 1u);
      asm volatile("s_waitcnt vmcnt(0)" ::: "memory");
    } else {
      XB_SPIN(xb_ld(&bar[XB_XGEN(b.x)]) == gen, bar);
      __builtin_amdgcn_fence(__ATOMIC_ACQUIRE, "agent");
      asm volatile("s_waitcnt vmcnt(0)" ::: "memory");
    }
  }
  __syncthreads();
}

DI void run_phase(const Params& p, int ph, char* smem) {
  switch (ph) {
    case 0: phase_prep(p, smem); break;
    case 1: phase_ffn_gu(p, W1GU, smem); break;
    case 2: phase_ffn_down(p, W1D, p.x, smem); break;
    case 3: phase_rmsnorm_widx(p, smem); break;
    case 4: phase_win(p, smem); break;
    case 5: phase_qproj(p, smem); break;
    case 6: phase_mix<false>(p, smem); break;
    case 13: phase_mix<true>(p, smem); break;
    case 14: phase_sb_dummy(p, smem); break;
    case 7: phase_sparse(p, smem); break;
    case 8: phase_merge(p, smem); break;
    case 9: phase_outproj(p, smem); break;
    case 10: phase_rmsnorm(p.out, p.g_ffn2, (bf16_t*)(p.ws + OFF_H)); break;
    case 11: phase_ffn_gu(p, W2GU, smem); break;
    case 12: phase_ffn_down(p, W2D, p.out, smem); break;
  }
}
constexpr int NPHASE = 13;

#if !MULTI_LAUNCH
__global__ void __launch_bounds__(512, 2) mega_kernel(Params p) {
  __shared__ __attribute__((aligned(16))) char smem[SMEM_BYTES];
  __shared__ uint4 xb_words;
  cg::grid_group grid = cg::this_grid();
  if (threadIdx.x == 0) xb_words = make_uint4(0u, 0u, 0u, 0u);
  __syncthreads();
  XcdBarrier xb = xcd_barrier_post((unsigned*)(p.ws + OFF_CNT + 256), (volatile LAS unsigned*)&xb_words);
  unsigned* bar0 = (unsigned*)(p.ws + OFF_CNT + 256);
  if (threadIdx.x == 0) g_sched[3] = (int)xb_add(&bar0[XB_XCNT(xb.x) + 16], 1u);
  grid.sync();
  if (threadIdx.x == 0) {
    const unsigned per = gridDim.x >> 3; bool ok = (gridDim.x & 7) == 0 && xb.x < 8;
    for (unsigned jx = 0; jx < 16; ++jx) { const unsigned c = xb_ld(&bar0[XB_XCNT(jx) + 16]); ok = ok && (c == (jx < 8 ? per : 0u)); }
    g_sched[0] = ok ? (int)xb.x : (int)(blockIdx.x & 7);
    g_sched[1] = ok ? g_sched[3] : (int)(blockIdx.x >> 3);
  }
  __syncthreads();
#pragma nounroll
  for (int ph = 0; ph < NPHASE; ++ph) {
    int phv = ph; asm volatile("" : "+s"(phv));
    run_phase(p, phv, smem);
    if (ph + 1 < NPHASE) { XcdBarrier xb2; xb2.bar = (unsigned*)(p.ws + OFF_CNT + 256); xb2.x = xb_xcc_id(); xb2.st = (volatile LAS unsigned*)&xb_words; xcd_barrier(xb2); }
  }
}
#else
template <int PH>
__global__ void __launch_bounds__(512, 2) phase_kernel(Params p) {
  __shared__ __attribute__((aligned(16))) char smem[SMEM_BYTES];
  if (threadIdx.x == 0) { g_sched[0] = blockIdx.x & 7; g_sched[1] = blockIdx.x >> 3; }
  __syncthreads();
  run_phase(p, PH, smem);
}
#ifndef PROBE_MASK
#define PROBE_MASK 0
#endif
template <int PH> static void launch_phases(const Params& p, hipStream_t stream) {
  hipLaunchKernelGGL(phase_kernel<PH>, dim3(256), dim3(NTHR), 0, stream, p);
  if constexpr (((PROBE_MASK >> PH) & 1) != 0 && PH != 6) hipLaunchKernelGGL(phase_kernel<PH>, dim3(256), dim3(NTHR), 0, stream, p);
  if constexpr (((PROBE_MASK >> PH) & 1) != 0 && PH == 6) hipLaunchKernelGGL(phase_kernel<13>, dim3(256), dim3(NTHR), 0, stream, p);
  if constexpr (((PROBE_MASK >> 14) & 1) != 0 && PH == 5) hipLaunchKernelGGL(phase_kernel<14>, dim3(256), dim3(NTHR), 0, stream, p);
  if constexpr (PH + 1 < NPHASE) launch_phases<PH + 1>(p, stream);
}
#endif

extern "C" void kernel_launch(void* const* d_in, const int* in_sizes, int n_in, void* d_out, int out_size, void* d_ws,
                              size_t ws_size, hipStream_t stream) {
  Params p{};
  p.x = (const float*)d_in[0]; p.pos = (const int*)d_in[1];
  p.g_ffn1 = (const float*)d_in[2]; p.w1g = (const float*)d_in[3]; p.w1u = (const float*)d_in[4]; p.w1d = (const float*)d_in[5];
  p.g_mix = (const float*)d_in[6]; p.w_in = (const float*)d_in[7]; p.g_cq = (const float*)d_in[8]; p.w_uq = (const float*)d_in[9];
  p.w_qi = (const float*)d_in[10]; p.g_qa = (const float*)d_in[11]; p.g_ka = (const float*)d_in[12]; p.w_uv = (const float*)d_in[13];
  p.w_oa = (const float*)d_in[14]; p.w_ob = (const float*)d_in[15]; p.w_out = (const float*)d_in[16]; p.g_ffn2 = (const float*)d_in[17];
  p.w2g = (const float*)d_in[18]; p.w2u = (const float*)d_in[19]; p.w2d = (const float*)d_in[20];
  p.out = (float*)d_out; p.ws = (char*)d_ws;
  if (ws_size < WS_NEED) { fprintf(stderr, "workspace too small: %zu < %zu\n", ws_size, (size_t)WS_NEED); return; }
  (void)hipMemsetAsync((char*)d_ws + OFF_CNT, 0, 256 + 16384, stream);
#if MULTI_LAUNCH
  launch_phases<0>(p, stream);
#else
  static int grid_blocks = 0;
  if (!grid_blocks) {
    int dev = 0, cus = 0, per_cu = 0;
    (void)hipGetDevice(&dev);
    (void)hipDeviceGetAttribute(&cus, hipDeviceAttributeMultiprocessorCount, dev);
    (void)hipOccupancyMaxActiveBlocksPerMultiprocessor(&per_cu, mega_kernel, NTHR, 0);
    if (per_cu > 1) per_cu = 1;
    grid_blocks = cus * per_cu;
    if (grid_blocks > 256) grid_blocks = 256;
  }
  void* args[] = {&p};
  hipError_t e = hipLaunchCooperativeKernel((void*)mega_kernel, dim3(grid_blocks), dim3(NTHR), args, 0, stream);
  if (e != hipSuccess) fprintf(stderr, "cooperative launch failed: %s (grid %d)\n", hipGetErrorString(e), grid_blocks);
#endif
}
```

```cpp
#include <hip/hip_runtime.h>
#include <hip/hip_cooperative_groups.h>
#include <stdint.h>
#include <stdio.h>
namespace cg = cooperative_groups;

#ifndef MULTI_LAUNCH
#define MULTI_LAUNCH 0
#endif

#define DI __device__ __forceinline__
typedef unsigned short bf16_t;
typedef __attribute__((ext_vector_type(8))) short bf16x8;
typedef __attribute__((ext_vector_type(16))) float f32x16;
typedef __attribute__((ext_vector_type(4))) float f32x4;
typedef __attribute__((ext_vector_type(4))) unsigned u32x4;
typedef __attribute__((ext_vector_type(2))) unsigned u32x2;
typedef __attribute__((ext_vector_type(4))) short s16x4;

constexpr int T_ = 32768, S_ = 4096, D_ = 1024, FF = 2816;
constexpr int PA_LD = 1536;
constexpr int PA_KA = 256, PA_VA = 320, PA_KI = 448, PA_QB = 512, PA_KB = 1024;
constexpr float EPS = 1e-6f;
constexpr float LOG2E = 1.4426950408889634f;

constexpr size_t W1GU = 0;
constexpr size_t W1D = W1GU + (size_t)5632 * 1024;
constexpr size_t W2GU = W1D + (size_t)1024 * 2816;
constexpr size_t W2D = W2GU + (size_t)5632 * 1024;
constexpr size_t WIN = W2D + (size_t)1024 * 2816;
constexpr size_t WQ = WIN + (size_t)4096 * 1024;
constexpr size_t WUV = WQ + (size_t)1024 * 256;
constexpr size_t WOA = WUV + (size_t)512 * 128;
constexpr size_t WOB = WOA + (size_t)1024 * 512;
constexpr size_t WOUT = WOB + (size_t)1024 * 512;
constexpr size_t WB_ELEMS = WOUT + (size_t)1024 * 1024;
constexpr size_t OFF_WB = 0;
constexpr size_t OFF_H = (WB_ELEMS * 2 + 255) & ~(size_t)255;
constexpr size_t OFF_PA = OFF_H + (size_t)T_ * 1024 * 2;
constexpr size_t OFF_VT = OFF_PA + (size_t)T_ * PA_LD * 2;
constexpr size_t OFF_GATES = OFF_VT + (size_t)T_ * 512 * 2;
constexpr size_t OFF_SLAB = OFF_GATES + (size_t)T_ * 2048 * 2;
constexpr size_t OFF_WIDX = OFF_SLAB + (size_t)512 * 16 * 4096 * 4;
constexpr size_t OFF_ROPE = OFF_WIDX + (size_t)T_ * 8 * 4;
constexpr size_t OFF_CNT = OFF_ROPE + (size_t)T_ * 32 * 8;
constexpr size_t WS_NEED = OFF_CNT + 256 + 16384;
static_assert(WS_NEED <= (size_t)512 * 1024 * 1024, "workspace too large");
static_assert((size_t)T_ * FF * 2 <= OFF_SLAB - OFF_PA, "U must fit in PA+VT+GATES");

constexpr int SMEM_BYTES = 131072 + 2048;
__shared__ int g_sched[4];
constexpr int NTHR = 512, NWAVE = 8;

struct Params {
  const float* x; const int* pos;
  const float *g_ffn1, *w1g, *w1u, *w1d, *g_mix, *w_in, *g_cq, *w_uq, *w_qi, *g_qa, *g_ka, *w_uv, *w_oa, *w_ob, *w_out, *g_ffn2, *w2g, *w2u, *w2d;
  float* out;
  char* ws;
};

typedef __attribute__((ext_vector_type(2))) __bf16 bf16x2_t;
typedef __attribute__((ext_vector_type(2))) float f32x2_t;
DI unsigned pack2(float a, float b) { f32x2_t v = {a, b}; return __builtin_bit_cast(unsigned, __builtin_convertvector(v, bf16x2_t)); }
DI unsigned f2bf(float x) { return pack2(x, 0.f) & 0xffffu; }
DI float bf2f(unsigned v) { return __uint_as_float(v << 16); }
DI float bflo(unsigned v) { return __uint_as_float(v << 16); }
DI float bfhi(unsigned v) { return __uint_as_float(v & 0xffff0000u); }
DI float fexp2(float x) { return __builtin_amdgcn_exp2f(x); }
DI float frcp(float x) { return __builtin_amdgcn_rcpf(x); }
DI float wave_sum(float v) {
#pragma unroll
  for (int o = 32; o > 0; o >>= 1) v += __shfl_xor(v, o);
  return v;
}
#define MFMA32(a, b, c) __builtin_amdgcn_mfma_f32_32x32x16_bf16((a), (b), (c), 0, 0, 0)
#define MFMA16(a, b, c) __builtin_amdgcn_mfma_f32_16x16x32_bf16((a), (b), (c), 0, 0, 0)
DI bf16x8 ld_frag_g(const bf16_t* p) { return __builtin_bit_cast(bf16x8, *(const u32x4*)p); }
DI bf16x8 ld_frag_s(const char* p) { return __builtin_bit_cast(bf16x8, *(const u32x4*)p); }
DI int otid() { int t = threadIdx.x; asm volatile("" : "+v"(t)); return t; }
DI int owid(int tid) { return __builtin_amdgcn_readfirstlane(tid >> 6); }
DI int crow(int reg, int g) { return (reg & 3) + 8 * (reg >> 2) + 4 * g; }

DI const float* prep_col(const Params& p, int mat, int r, int& ld) {
  switch (mat) {
    case 0: case 2: {
      int j = r >> 8, q = r & 255; int half = q >> 7, c = q & 127;
      int n = j * 128 + c; ld = FF;
      const float* g = mat == 0 ? p.w1g : p.w2g; const float* u = mat == 0 ? p.w1u : p.w2u;
      return (half ? u : g) + n;
    }
    case 1: ld = D_; return p.w1d + r;
    case 3: ld = D_; return p.w2d + r;
    case 4: {
      ld = 4104;
      if (r < 512) return p.w_in + r;
      return p.w_in + r + 8;
    }
    case 5: {
      ld = 512;
      int T = r >> 8, q = r & 255; int hl = (q & 127) >> 5, d = (q >> 7) * 32 + (q & 31);
      int col = ((T & 1) * 4 + hl) * 64 + d;
      return (T < 2 ? p.w_uq : p.w_qi) + col;
    }
    case 6: { ld = 64; int h = r >> 6, d = r & 63; return p.w_uv + h * 8192 + d; }
    case 7: ld = D_; return p.w_oa + r;
    case 8: ld = D_; return p.w_ob + r;
    default: ld = D_; return p.w_out + r;
  }
}

DI void prep_transpose_tile(const Params& p, bool valid, int mat, int K, bf16_t* dst, int tile, float* lds, int t) {
  const int nkt = K >> 7;
  const int r0 = (tile / nkt) * 32, k0 = (tile % nkt) * 128;
  const int tx = t & 31, ty = t >> 5;
  if (valid) {
    int ld; const float* col = prep_col(p, mat, r0 + tx, ld);
#pragma unroll
    for (int i = 0; i < 16; ++i) {
      int k = k0 + ty + 8 * i;
      float v = 0.f;
      if (col) { v = col[(size_t)k * ld]; if (mat == 5) v *= p.g_cq[k]; }
      lds[tx * 129 + ty + 8 * i] = v;
    }
  }
  __syncthreads();
  if (valid) {
    const int row = t >> 3, kc = (t & 7) * 16;
    const float* s = lds + row * 129 + kc;
    u32x4 o0, o1;
    o0[0] = pack2(s[0], s[1]); o0[1] = pack2(s[2], s[3]); o0[2] = pack2(s[4], s[5]); o0[3] = pack2(s[6], s[7]);
    o1[0] = pack2(s[8], s[9]); o1[1] = pack2(s[10], s[11]); o1[2] = pack2(s[12], s[13]); o1[3] = pack2(s[14], s[15]);
    u32x4* d = (u32x4*)(dst + (size_t)(r0 + row) * K + k0 + kc);
    d[0] = o0; d[1] = o1;
  }
  __syncthreads();
}

DI void rmsnorm_row(const float* __restrict__ xr, const float* __restrict__ g, bf16_t* __restrict__ o) {
  const int lane = otid() & 63;
  float4 v[4]; float ss = 0.f;
#pragma unroll
  for (int j = 0; j < 4; ++j) { v[j] = *(const float4*)(xr + lane * 4 + 256 * j); ss += v[j].x * v[j].x + v[j].y * v[j].y + v[j].z * v[j].z + v[j].w * v[j].w; }
  ss = wave_sum(ss);
  const float rs = rsqrtf(ss * (1.f / 1024.f) + EPS);
#pragma unroll
  for (int j = 0; j < 4; ++j) {
    float4 gg = *(const float4*)(g + lane * 4 + 256 * j);
    u32x2 w; w[0] = pack2(v[j].x * rs * gg.x, v[j].y * rs * gg.y); w[1] = pack2(v[j].z * rs * gg.z, v[j].w * rs * gg.w);
    *(u32x2*)(o + lane * 4 + 256 * j) = w;
  }
}

DI void phase_rmsnorm(const float* __restrict__ src, const float* __restrict__ g, bf16_t* __restrict__ dst) {
  const int wid = owid(otid());
  for (int it = blockIdx.x; it < T_ / NWAVE; it += gridDim.x) {
    int row = it * NWAVE + wid;
    rmsnorm_row(src + (size_t)row * D_, g, dst + (size_t)row * D_);
  }
}

DI void phase_rmsnorm_widx(const Params& p, char* smem) {
  const int tid = otid(), lane = tid & 63, wid = owid(tid);
  float* wl = (float*)smem;
  for (int e = tid; e < 8 * 1024; e += NTHR) { int k = e >> 3, h = e & 7; wl[h * 1024 + k] = p.w_in[(size_t)k * 4104 + 512 + h]; }
  __syncthreads();
  const float* src = p.out; const float* g = p.g_mix;
  bf16_t* dst = (bf16_t*)(p.ws + OFF_H);
  float* WI = (float*)(p.ws + OFF_WIDX);
  for (int it = blockIdx.x; it < T_ / NWAVE; it += gridDim.x) {
    const int row = it * NWAVE + wid;
    const float* xr = src + (size_t)row * D_;
    float4 v[4]; float ss = 0.f;
#pragma unroll
    for (int j = 0; j < 4; ++j) { v[j] = *(const float4*)(xr + lane * 4 + 256 * j); ss += v[j].x * v[j].x + v[j].y * v[j].y + v[j].z * v[j].z + v[j].w * v[j].w; }
    ss = wave_sum(ss);
    const float rs = rsqrtf(ss * (1.f / 1024.f) + EPS);
    float acc[8];
#pragma unroll
    for (int h = 0; h < 8; ++h) acc[h] = 0.f;
#pragma unroll
    for (int j = 0; j < 4; ++j) {
      float4 gg = *(const float4*)(g + lane * 4 + 256 * j);
      const float y0 = v[j].x * rs * gg.x, y1 = v[j].y * rs * gg.y, y2 = v[j].z * rs * gg.z, y3 = v[j].w * rs * gg.w;
      u32x2 w; w[0] = pack2(y0, y1); w[1] = pack2(y2, y3);
      *(u32x2*)(dst + (size_t)row * D_ + lane * 4 + 256 * j) = w;
#pragma unroll
      for (int h = 0; h < 8; ++h) {
        const f32x4 ww = *(const f32x4*)(wl + h * 1024 + lane * 4 + 256 * j);
        acc[h] += y0 * ww[0] + y1 * ww[1] + y2 * ww[2] + y3 * ww[3];
      }
    }
#pragma unroll
    for (int h = 0; h < 8; ++h) acc[h] = wave_sum(acc[h]);
    if (lane < 8) {
      float r = acc[0];
#pragma unroll
      for (int h = 1; h < 8; ++h) r = lane == h ? acc[h] : r;
      WI[(size_t)row * 8 + lane] = r * 0.04419417382415922f;
    }
  }
  __syncthreads();
}

DI void phase_prep(const Params& p, char* smem) {
  bf16_t* wb = (bf16_t*)(p.ws + OFF_WB);
  const int tid = otid(), vb = tid >> 8, t = tid & 255;
  float* lds = (float*)smem + vb * 4160;
  constexpr int c0 = 1408, c1 = c0 + 704, c2 = c1 + 1408, c3 = c2 + 704, c4 = c3 + 1024, c5 = c4 + 64, c6 = c5 + 16, c7 = c6 + 128, c8 = c7 + 128, c9 = c8 + 256;
  static_assert((c9 & 1) == 0, "pairs");
  for (int it0 = blockIdx.x; it0 < c9 / 2; it0 += gridDim.x) {
    const int it = it0 * 2 + vb;
    int mat, K, base; size_t off;
    if (it < c0) { mat = 0; K = 1024; base = 0; off = W1GU; }
    else if (it < c1) { mat = 1; K = 2816; base = c0; off = W1D; }
    else if (it < c2) { mat = 2; K = 1024; base = c1; off = W2GU; }
    else if (it < c3) { mat = 3; K = 2816; base = c2; off = W2D; }
    else if (it < c4) { mat = 4; K = 1024; base = c3; off = WIN; }
    else if (it < c5) { mat = 5; K = 256; base = c4; off = WQ; }
    else if (it < c6) { mat = 6; K = 128; base = c5; off = WUV; }
    else if (it < c7) { mat = 7; K = 512; base = c6; off = WOA; }
    else if (it < c8) { mat = 8; K = 512; base = c7; off = WOB; }
    else { mat = 9; K = 1024; base = c8; off = WOUT; }
    prep_transpose_tile(p, true, mat, K, wb + off, it - base, lds, t);
  }
  {
    const int wid = owid(tid);
    for (int it = blockIdx.x; it < T_ / NWAVE; it += gridDim.x) {
      int row = it * NWAVE + wid;
      rmsnorm_row(p.x + (size_t)row * D_, p.g_ffn1, (bf16_t*)(p.ws + OFF_H) + (size_t)row * D_);
    }
  }
  for (int it = blockIdx.x; it < T_ * 32 / NTHR; it += gridDim.x) {
    int e = it * NTHR + tid;
    int tok = e >> 5, i = e & 31;
    float inv_freq = exp2f(-(float)i * (13.287712379549449f / 32.f));
    float ang = (float)p.pos[tok] * inv_freq;
    double rev = (double)ang * 0.15915494309189535;
    rev -= floor(rev);
    float r = (float)rev;
    float2 cs; cs.x = __builtin_amdgcn_cosf(r); cs.y = __builtin_amdgcn_sinf(r);
    ((float2*)(p.ws + OFF_ROPE))[e] = cs;
  }
}

typedef f32x4 acc8p_t[2][2][4][2];
constexpr int G_BK = 64, G_HALF = 128, G_HT = G_HALF * G_BK;
DI int lds_byte(int r, int c) {
  int st = (r >> 4) * 2 + (c >> 5), rr = r & 15, cc = c & 31, ob = rr * 64 + cc * 2;
  return st * 1024 + (ob ^ (((ob >> 9) & 1) << 5));
}
DI void stage_rc(int b, int& R, int& C) {
  int st = b / 1024, sb = b % 1024, swz = sb ^ (((sb >> 9) & 1) << 5);
  R = (st >> 1) * 16 + swz / 64; C = (st & 1) * 32 + (swz % 64) / 2;
}
template <int LDA, int LDB, int NKT>
DI void gemm8p(const bf16_t* __restrict__ A, const bf16_t* __restrict__ Bt, char* smem, acc8p_t& acc) {
  static_assert(NKT >= 4 && (NKT % 2) == 0, "K tiles");
  bf16_t* shm = (bf16_t*)smem;
  const int tid = otid();
  const int wid = owid(tid), lane = tid & 63, wr = wid >> 2, wc = wid & 3, fr = lane & 15, fq = lane >> 4;
#define SA(b, h) (shm + ((b) * 2 + (h)) * G_HT)
#define SB(b, h) (shm + (4 + (b) * 2 + (h)) * G_HT)
  unsigned sofa, sofb;
  { int _r, _c; stage_rc(tid * 16, _r, _c); sofa = (unsigned)(_r * LDA + _c); sofb = (unsigned)(_r * LDB + _c); }
#define STAGE(P, BASE, LD, br, kt, SOF) do { const bf16_t* _ub = (BASE) + ((long)(br) * (LD) + (long)(kt) * G_BK);     \
    _Pragma("unroll") for (int _i = 0; _i < 2; ++_i) { \
      __builtin_amdgcn_global_load_lds((const unsigned*)((_ub + (long)_i * 64 * (LD)) + SOF), \
        (unsigned*)((char*)(P) + tid * 16 + _i * 8192), 16, 0, 0); } } while (0)
#define LDA_(dst, b, h) _Pragma("unroll") for (int m = 0; m < 4; ++m) _Pragma("unroll") for (int k = 0; k < 2; ++k) \
    dst[m][k] = *reinterpret_cast<const bf16x8*>((char*)SA(b, h) + lds_byte(wr * 64 + m * 16 + fr, k * 32 + fq * 8))
#define LDB_(dst, b, h) _Pragma("unroll") for (int n = 0; n < 2; ++n) _Pragma("unroll") for (int k = 0; k < 2; ++k) \
    dst[n][k] = *reinterpret_cast<const bf16x8*>((char*)SB(b, h) + lds_byte(wc * 32 + n * 16 + fr, k * 32 + fq * 8))
#define MMA(ai, bj, At_, Bt_) do { __builtin_amdgcn_s_setprio(1); \
    _Pragma("unroll") for (int m = 0; m < 4; ++m) _Pragma("unroll") for (int n = 0; n < 2; ++n) _Pragma("unroll") for (int k = 0; k < 2; ++k) \
      acc[ai][bj][m][n] = __builtin_amdgcn_mfma_f32_16x16x32_bf16(At_[m][k], Bt_[n][k], acc[ai][bj][m][n], 0, 0, 0); \
    __builtin_amdgcn_s_setprio(0); } while (0)
#define WAIT_V(n) asm volatile("s_waitcnt vmcnt(" #n ")" ::: "memory")
#define WAIT_L(n) asm volatile("s_waitcnt lgkmcnt(" #n ")" ::: "memory")
#define BAR __builtin_amdgcn_s_barrier()
#define SCHED __builtin_amdgcn_sched_barrier(0)
#pragma unroll
  for (int a = 0; a < 2; ++a)
#pragma unroll
    for (int b = 0; b < 2; ++b)
#pragma unroll
      for (int m = 0; m < 4; ++m)
#pragma unroll
        for (int n = 0; n < 2; ++n) acc[a][b][m][n] = f32x4{0.f, 0.f, 0.f, 0.f};
  bf16x8 At[4][2], B0[2][2], B1[2][2];
  constexpr int nt = NKT;
  WAIT_V(0);
  SCHED;
  STAGE(SB(0, 0), Bt, LDB, 0, 0, sofb); STAGE(SA(0, 0), A, LDA, 0, 0, sofa);
  STAGE(SB(0, 1), Bt, LDB, G_HALF, 0, sofb); STAGE(SA(0, 1), A, LDA, G_HALF, 0, sofa);
  if (wr == 1) BAR;
  WAIT_V(4); BAR;
  STAGE(SB(1, 0), Bt, LDB, 0, 1, sofb); STAGE(SA(1, 0), A, LDA, 0, 1, sofa); STAGE(SB(1, 1), Bt, LDB, G_HALF, 1, sofb);
  WAIT_V(6); BAR;
  for (int t = 0; t < nt - 2; t += 2) {
    LDB_(B0, 0, 0); SCHED; LDA_(At, 0, 0); STAGE(SA(1, 1), A, LDA, G_HALF, t + 1, sofa);
    WAIT_L(8); BAR; WAIT_L(0); MMA(0, 0, At, B0); BAR; SCHED;
    LDB_(B1, 0, 1); STAGE(SB(0, 0), Bt, LDB, 0, t + 2, sofb);
    BAR; WAIT_L(0); MMA(0, 1, At, B1); BAR;
    LDA_(At, 0, 1); STAGE(SA(0, 0), A, LDA, 0, t + 2, sofa);
    BAR; WAIT_L(0); MMA(1, 0, At, B0); BAR; SCHED;
    STAGE(SB(0, 1), Bt, LDB, G_HALF, t + 2, sofb);
    WAIT_V(6); BAR; MMA(1, 1, At, B1); BAR;
    LDB_(B0, 1, 0); SCHED; LDA_(At, 1, 0); STAGE(SA(0, 1), A, LDA, G_HALF, t + 2, sofa);
    WAIT_L(8); BAR; WAIT_L(0); MMA(0, 0, At, B0); BAR; SCHED;
    LDB_(B1, 1, 1); STAGE(SB(1, 0), Bt, LDB, 0, t + 3, sofb);
    BAR; WAIT_L(0); MMA(0, 1, At, B1); BAR;
    LDA_(At, 1, 1); STAGE(SA(1, 0), A, LDA, 0, t + 3, sofa);
    BAR; WAIT_L(0); MMA(1, 0, At, B0); BAR; SCHED;
    STAGE(SB(1, 1), Bt, LDB, G_HALF, t + 3, sofb);
    WAIT_V(6); BAR; MMA(1, 1, At, B1); BAR;
  }
  { LDB_(B0, 0, 0); LDA_(At, 0, 0); STAGE(SA(1, 1), A, LDA, G_HALF, nt - 1, sofa);
    BAR; WAIT_L(0); MMA(0, 0, At, B0); BAR;
    LDB_(B1, 0, 1); BAR; WAIT_L(0); MMA(0, 1, At, B1); BAR;
    LDA_(At, 0, 1); WAIT_V(4); BAR; WAIT_L(0); MMA(1, 0, At, B0); MMA(1, 1, At, B1); BAR; }
  { LDB_(B0, 1, 0); LDA_(At, 1, 0); WAIT_V(2); BAR; WAIT_L(0); MMA(0, 0, At, B0); BAR;
    LDB_(B1, 1, 1); WAIT_V(0); BAR; WAIT_L(0); MMA(0, 1, At, B1); BAR;
    LDA_(At, 1, 1); BAR; WAIT_L(0); MMA(1, 0, At, B0); MMA(1, 1, At, B1); BAR; }
  if (wr == 0) BAR;
#undef SA
#undef SB
#undef STAGE
#undef LDA_
#undef LDB_
#undef MMA
#undef WAIT_V
#undef WAIT_L
#undef BAR
#undef SCHED
}

DI int sched_tile(int it, int MT, int NT, int& mt, int& nt) {
  const int G = gridDim.x, b = blockIdx.x;
  const int per = G >> 3, pm = per >> 2;
  const int nfull = NT >> 2, w = NT & 3;
  if ((G & 31) == 0 && pm > 0 && (MT % pm) == 0 && w != 3 && (w == 0 || (MT % (per / w)) == 0)) {
    const int x = g_sched[0], j = g_sched[1];
    const int nsm = MT / pm;
    const int nmain = nsm * nfull;
    const int pm2 = w ? per / w : 1;
    const int ntail = w ? MT / pm2 : 0;
    const int st = it * 8 + x;
    if (st >= nmain + ntail) return -1;
    if (st < nmain) {
      const int sm = st / nfull, sn = st - sm * nfull;
      mt = sm * pm + (j % pm); nt = sn * 4 + (j / pm);
    } else {
      const int s2 = st - nmain;
      mt = s2 * pm2 + (j % pm2); nt = nfull * 4 + (j / pm2);
    }
    return 1;
  } else {
    const int tile = it * G + b;
    if (tile >= MT * NT) return -1;
    nt = tile % NT; mt = tile / NT;
    return 1;
  }
}

#define EPI_IDS const int tid = otid(), lane = tid & 63, wid = owid(tid), wr = wid >> 2, wc = wid & 3, fr = lane & 15, fq = lane >> 4; (void)wr; (void)wc; (void)fr; (void)fq;
#define LROW(ai, m, j) ((ai) * 128 + (m) * 16 + (j))
#define LCOL(bj, n) ((bj) * 128 + (n) * 16)
#define EPI_FOR _Pragma("unroll") for (int ai = 0; ai < 2; ++ai) _Pragma("unroll") for (int bj = 0; bj < 2; ++bj) \
    _Pragma("unroll") for (int m = 0; m < 4; ++m) _Pragma("unroll") for (int n = 0; n < 2; ++n) _Pragma("unroll") for (int j = 0; j < 4; ++j)

DI void phase_ffn_gu(const Params& p, size_t woff, char* smem) {
  const bf16_t* H = (const bf16_t*)(p.ws + OFF_H);
  const bf16_t* W = (const bf16_t*)(p.ws + OFF_WB) + woff;
  bf16_t* U = (bf16_t*)(p.ws + OFF_PA);
  for (int it = 0;; ++it) {
    int mt, nt; int s = sched_tile(it, 128, 22, mt, nt);
    if (s < 0) break; if (s == 0) continue;
    acc8p_t acc;
    gemm8p<D_, D_, 16>(H + (size_t)mt * 256 * D_, W + (size_t)nt * 256 * D_, smem, acc);
    EPI_IDS
    bf16_t* tp = U + (size_t)(mt * 256) * FF + nt * 128;
    const unsigned loff = (unsigned)((wr * 64 + fq * 4) * FF + wc * 32 + fr);
#pragma unroll
    for (int ai = 0; ai < 2; ++ai)
#pragma unroll
      for (int m = 0; m < 4; ++m)
#pragma unroll
        for (int n = 0; n < 2; ++n)
#pragma unroll
          for (int j = 0; j < 4; ++j) {
            float gv = acc[ai][0][m][n][j], uv = acc[ai][1][m][n][j];
            float sv = gv * frcp(1.f + fexp2(-LOG2E * gv)) * uv;
            (tp + LROW(ai, m, j) * FF + n * 16)[loff] = (bf16_t)f2bf(sv);
          }
  }
}

DI void phase_ffn_down(const Params& p, size_t woff, const float* res, char* smem) {
  const bf16_t* U = (const bf16_t*)(p.ws + OFF_PA);
  const bf16_t* W = (const bf16_t*)(p.ws + OFF_WB) + woff;
  float* out = p.out;
  for (int it = 0;; ++it) {
    int mt, nt; int s = sched_tile(it, 128, 4, mt, nt);
    if (s < 0) break; if (s == 0) continue;
    acc8p_t acc;
    gemm8p<FF, FF, 44>(U + (size_t)mt * 256 * FF, W + (size_t)nt * 256 * FF, smem, acc);
    EPI_IDS
    const size_t tb = (size_t)(mt * 256) * D_ + nt * 256;
    float* tp = out + tb; const float* rsp = res + tb;
    const unsigned loff = (unsigned)((wr * 64 + fq * 4) * D_ + wc * 32 + fr);
    EPI_FOR {
      const int ro = LROW(ai, m, j) * D_ + LCOL(bj, n);
      (tp + ro)[loff] = (rsp + ro)[loff] + 0.5f * acc[ai][bj][m][n][j];
    }
  }
}

DI void phase_win(const Params& p, char* smem) {
  const bf16_t* H = (const bf16_t*)(p.ws + OFF_H);
  const bf16_t* W = (const bf16_t*)(p.ws + OFF_WB) + WIN;
  bf16_t* PA = (bf16_t*)(p.ws + OFF_PA);
  bf16_t* VT = (bf16_t*)(p.ws + OFF_VT);
  bf16_t* GT = (bf16_t*)(p.ws + OFF_GATES);
  float* WI = (float*)(p.ws + OFF_WIDX);
  for (int it = 0;; ++it) {
    int mt, nt; int s = sched_tile(it, 128, 16, mt, nt);
    if (s < 0) break; if (s == 0) continue;
    acc8p_t acc;
    gemm8p<D_, D_, 16>(H + (size_t)mt * 256 * D_, W + (size_t)nt * 256 * D_, smem, acc);
    EPI_IDS
    if (nt < 6) {
      bf16_t* tp = PA + (size_t)(mt * 256) * PA_LD + nt * 256;
      const unsigned loff = (unsigned)((wr * 64 + fq * 4) * PA_LD + wc * 32 + fr);
      const float qsc = (nt == 2 || nt == 3) ? 0.125f * LOG2E : 1.f;
      EPI_FOR {
        const int ro = LROW(ai, m, j) * PA_LD + LCOL(bj, n);
        (tp + ro)[loff] = (bf16_t)f2bf(acc[ai][bj][m][n][j] * qsc);
      }
    } else if (nt < 8) {
      const int b = mt >> 4;
#pragma unroll
      for (int ai = 0; ai < 2; ++ai)
#pragma unroll
        for (int bj = 0; bj < 2; ++bj)
#pragma unroll
          for (int m = 0; m < 4; ++m)
#pragma unroll
            for (int n = 0; n < 2; ++n) {
              int c = (nt - 6) * 256 + bj * 128 + wc * 32 + n * 16 + fr;
              int h = c >> 6, d = c & 63;
              int tok = mt * 256 + ai * 128 + wr * 64 + m * 16 + fq * 4;
              bf16_t* dst = VT + ((size_t)(b * 8 + h) * 64 + d) * S_ + (tok & (S_ - 1));
              u32x2 w; w[0] = pack2(acc[ai][bj][m][n][0], acc[ai][bj][m][n][1]); w[1] = pack2(acc[ai][bj][m][n][2], acc[ai][bj][m][n][3]);
              *(u32x2*)dst = w;
            }
    } else if (nt < 16) {
      bf16_t* tp = GT + (size_t)(mt * 256) * 2048 + (nt - 8) * 256;
      const unsigned loff = (unsigned)((wr * 64 + fq * 4) * 2048 + wc * 32 + fr);
      EPI_FOR {
        const int ro = LROW(ai, m, j) * 2048 + LCOL(bj, n);
        float v = acc[ai][bj][m][n][j];
        float sg = frcp(1.f + fexp2(-LOG2E * v));
        (tp + ro)[loff] = (bf16_t)f2bf(sg);
      }
    }
  }
}

DI void phase_qproj(const Params& p, char* smem) {
  bf16_t* PA = (bf16_t*)(p.ws + OFF_PA);
  const bf16_t* W = (const bf16_t*)(p.ws + OFF_WB) + WQ;
  bf16_t* QA = (bf16_t*)(p.ws + OFF_H);
  bf16_t* QI = QA + (size_t)T_ * 512;
  const float2* ROPE = (const float2*)(p.ws + OFF_ROPE);
  float* rstd = (float*)(smem + 131072);
  for (int it = 0;; ++it) {
    int mt, nt; int s = sched_tile(it, 128, 4, mt, nt);
    if (s < 0) break; if (s == 0) continue;
    acc8p_t acc;
    gemm8p<PA_LD, 256, 4>(PA + (size_t)mt * 256 * PA_LD, W + (size_t)nt * 256 * 256, smem, acc);
    {
      const int tq = otid(); int row = tq >> 1, half = tq & 1;
      const bf16_t* src = PA + (size_t)(mt * 256 + row) * PA_LD + half * 128;
      float ss = 0.f;
#pragma unroll 4
      for (int i = 0; i < 16; ++i) {
        u32x4 v = *(const u32x4*)(src + i * 8);
#pragma unroll
        for (int j = 0; j < 4; ++j) { float a = bflo(v[j]), b = bfhi(v[j]); ss += a * a + b * b; }
      }
      ss += __shfl_xor(ss, 1);
      if (half == 0) rstd[row] = rsqrtf(ss * (1.f / 256.f) + EPS);
    }
    __syncthreads();
    EPI_IDS
    const int head = (nt & 1) * 4 + wc;
    bf16_t* dtp = (nt < 2 ? QA : QI) + (size_t)(mt * 256) * 512 + head * 64;
    const float2* rtp = ROPE + (size_t)(mt * 256) * 32;
    const unsigned doff = (unsigned)((wr * 64 + fq * 4) * 512 + fr);
    const unsigned roff = (unsigned)((wr * 64 + fq * 4) * 32 + fr);
    const float* rsl = rstd + wr * 64 + fq * 4;
    float ga[4] = {1.f, 1.f, 1.f, 1.f};
    const bool do_norm = nt < 2;
    if (do_norm) { ga[0] = p.g_qa[fr]; ga[1] = p.g_qa[16 + fr]; ga[2] = p.g_qa[32 + fr]; ga[3] = p.g_qa[48 + fr]; }
#pragma unroll
    for (int ai = 0; ai < 2; ++ai)
#pragma unroll
      for (int m = 0; m < 4; ++m)
#pragma unroll
        for (int j = 0; j < 4; ++j) {
          const int lr = LROW(ai, m, j);
          const float rs = rsl[lr];
          float x0 = acc[ai][0][m][0][j] * rs, x1 = acc[ai][0][m][1][j] * rs;
          float y0 = acc[ai][1][m][0][j] * rs, y1 = acc[ai][1][m][1][j] * rs;
          if (do_norm) {
            float ss = x0 * x0 + x1 * x1 + y0 * y0 + y1 * y1;
#pragma unroll
            for (int o = 8; o > 0; o >>= 1) ss += __shfl_xor(ss, o);
            const float r2 = rsqrtf(ss * (1.f / 64.f) + EPS);
            x0 *= r2 * ga[0]; x1 *= r2 * ga[1]; y0 *= r2 * ga[2]; y1 *= r2 * ga[3];
          }
          const float2 c0 = (rtp + lr * 32)[roff], c1 = (rtp + lr * 32 + 16)[roff];
          bf16_t* dp = dtp + lr * 512;
          (dp)[doff] = (bf16_t)f2bf(x0 * c0.x - y0 * c0.y);
          (dp + 32)[doff] = (bf16_t)f2bf(x0 * c0.y + y0 * c0.x);
          (dp + 16)[doff] = (bf16_t)f2bf(x1 * c1.x - y1 * c1.y);
          (dp + 48)[doff] = (bf16_t)f2bf(x1 * c1.y + y1 * c1.x);
          if (j == 3) __builtin_amdgcn_sched_barrier(0);
        }
    __syncthreads();
  }
  const int tid = otid(), lane = tid & 63, wid = owid(tid);
  for (int it = blockIdx.x; it < T_ / 64; it += gridDim.x) {
    const int d = lane & 31; const bool isidx = lane >= 32;
    const float g0 = isidx ? 1.f : p.g_ka[d], g1 = isidx ? 1.f : p.g_ka[d + 32];
    for (int i = 0; i < 8; ++i) {
      int tok = it * 64 + wid * 8 + i;
      bf16_t* src = PA + (size_t)tok * PA_LD + (isidx ? PA_KI : PA_KA);
      float v0 = bf2f(src[d]), v1 = bf2f(src[d + 32]);
      float ss = v0 * v0 + v1 * v1;
#pragma unroll
      for (int o = 16; o > 0; o >>= 1) ss += __shfl_xor(ss, o);
      if (!isidx) { float r2 = rsqrtf(ss * (1.f / 64.f) + EPS); v0 *= r2 * g0; v1 *= r2 * g1; }
      float2 cs = ROPE[(size_t)tok * 32 + d];
      float o0 = v0 * cs.x - v1 * cs.y, o1 = v0 * cs.y + v1 * cs.x;
      src[d] = (bf16_t)f2bf(o0); src[d + 32] = (bf16_t)f2bf(o1);
    }
  }
}

DI f32x16 sb_qk(const char* cur, int sub, int r, int g, int sw, const bf16x8 (&qf)[4]) {
  f32x16 z;
#pragma unroll
  for (int i = 0; i < 16; ++i) z[i] = 0.f;
#pragma unroll
  for (int ks = 0; ks < 4; ++ks) {
    bf16x8 kf = ld_frag_s(cur + (sub * 32 + r) * 128 + (((ks * 2 + g) ^ sw) << 4));
    z = MFMA32(kf, qf[ks], z);
  }
  return z;
}
template <bool DIAG>
DI void sb_elem(const f32x16& z, int r, int g, float& R, bf16x8& pf0, bf16x8& pf1) {
  float e[16], rr[16];
#pragma unroll
  for (int i = 0; i < 16; ++i) {
    float z2 = fminf(z[i], 80.f);
    float ev = fexp2(z2);
    float rv_ = frcp(1.f + ev);
    if (DIAG && !(crow(i, g) < r)) { ev = 0.f; rv_ = 1.f; }
    e[i] = ev; rr[i] = rv_;
  }
  float G[4], Gp[4];
#pragma unroll
  for (int q = 0; q < 4; ++q) {
    rr[4 * q + 2] *= rr[4 * q + 3];
    rr[4 * q + 1] *= rr[4 * q + 2];
    rr[4 * q + 0] *= rr[4 * q + 1];
    G[q] = rr[4 * q];
  }
#pragma unroll
  for (int q = 0; q < 4; ++q) Gp[q] = __shfl_xor(G[q], 32);
  float SO[4], SP[4];
  SO[3] = 1.f; SO[2] = G[3]; SO[1] = G[2] * G[3]; SO[0] = G[1] * SO[1];
  SP[3] = 1.f; SP[2] = Gp[3]; SP[1] = Gp[2] * Gp[3]; SP[0] = Gp[1] * SP[1];
  float a[16];
#pragma unroll
  for (int q = 0; q < 4; ++q) {
    float part = g == 0 ? SP[q] * Gp[q] : SP[q];
    float E = SO[q] * part * R;
#pragma unroll
    for (int j = 0; j < 4; ++j) a[4 * q + j] = e[4 * q + j] * rr[4 * q + j] * E;
  }
  R = R * (SO[0] * G[0]) * (SP[0] * Gp[0]);
  u32x4 pw0, pw1;
#pragma unroll
  for (int j = 0; j < 4; ++j) { pw0[j] = pack2(a[2 * j], a[2 * j + 1]); pw1[j] = pack2(a[8 + 2 * j], a[8 + 2 * j + 1]); }
  pf0 = __builtin_bit_cast(bf16x8, pw0); pf1 = __builtin_bit_cast(bf16x8, pw1);
}
DI void sb_pv(const char* cur, int sub, int r, int g, const bf16x8& pf0, const bf16x8& pf1, f32x16& o0, f32x16& o1) {
#pragma unroll
  for (int ks2 = 0; ks2 < 2; ++ks2) {
    const bf16x8 pf = ks2 == 0 ? pf0 : pf1;
#pragma unroll
    for (int dt = 0; dt < 2; ++dt) {
      const char* vp = cur + 8192 + (dt * 32 + r) * 136 + (sub * 32 + 16 * ks2 + 4 * g) * 2;
      u32x2 lo = *(const u32x2*)vp, hi = *(const u32x2*)(vp + 16);
      u32x4 vv; vv[0] = lo[0]; vv[1] = lo[1]; vv[2] = hi[0]; vv[3] = hi[1];
      bf16x8 vf = __builtin_bit_cast(bf16x8, vv);
      if (dt == 0) o0 = MFMA32(vf, pf, o0); else o1 = MFMA32(vf, pf, o1);
    }
  }
}

template <bool DUMMY>
DI void sb_item(const Params& p, int b, int h, int qb, char* smem) {
  bf16_t* PA = (bf16_t*)(p.ws + OFF_PA);
  const bf16_t* VT = (const bf16_t*)(p.ws + OFF_VT) + (size_t)(b * 8 + h) * 64 * S_;
  const int tid = otid(), lane = tid & 63, wid = owid(tid), g = lane >> 5, r = lane & 31;
  const int tw = qb * 256 + wid * 32;
  constexpr int BUFSZ = 8192 + 8704;
  bf16x8 qf[4];
  {
    const bf16_t* qp = PA + (size_t)(b * S_ + tw + r) * PA_LD + PA_QB + h * 64 + g * 8;
#pragma unroll
    for (int ks = 0; ks < 4; ++ks) qf[ks] = ld_frag_g(qp + ks * 16);
  }
  const int srow = tid >> 3, sch = tid & 7;
  const bf16_t* gk = PA + (size_t)(b * S_ + srow) * PA_LD + PA_KB + h * 64 + sch * 8;
  const bf16_t* gv = VT + (size_t)srow * S_ + sch * 8;
  const unsigned k_st = srow * 128 + ((sch ^ ((srow >> 1) & 7)) << 4);
  const unsigned v_st = 8192 + srow * 136 + sch * 16;
  const int sw = (lane >> 1) & 7;
  f32x16 o0, o1;
#pragma unroll
  for (int i = 0; i < 16; ++i) { o0[i] = 0.f; o1[i] = 0.f; }
  float R = 1.f;
  const int nkt = 4 * qb + 4;
  u32x4 rk, rv;
  {
    int kt = nkt - 1;
    rk = *(const u32x4*)(gk + (size_t)(kt * 64) * PA_LD); rv = *(const u32x4*)(gv + kt * 64);
    char* cur = smem + (kt & 1) * BUFSZ;
    *(u32x4*)(cur + k_st) = rk;
    u32x2 lo, hi; lo[0] = rv[0]; lo[1] = rv[1]; hi[0] = rv[2]; hi[1] = rv[3];
    *(u32x2*)(cur + v_st) = lo; *(u32x2*)(cur + v_st + 8) = hi;
  }
  __syncthreads();
  for (int kt = nkt - 1; kt >= 0; --kt) {
    const char* cur = smem + (kt & 1) * BUFSZ;
    char* nxt = smem + ((kt + 1) & 1) * BUFSZ;
    const bool more = kt > 0;
    if (more) { rk = *(const u32x4*)(gk + (size_t)((kt - 1) * 64) * PA_LD); rv = *(const u32x4*)(gv + (kt - 1) * 64); }
    __builtin_amdgcn_sched_barrier(0);
    if (kt * 64 + 32 < tw) {
      const f32x16 z1 = sb_qk(cur, 1, r, g, sw, qf);
      const f32x16 z0 = sb_qk(cur, 0, r, g, sw, qf);
      bf16x8 p1a, p1b, p0a, p0b;
      sb_elem<false>(z1, r, g, R, p1a, p1b);
      sb_pv(cur, 1, r, g, p1a, p1b, o0, o1);
      sb_elem<false>(z0, r, g, R, p0a, p0b);
      sb_pv(cur, 0, r, g, p0a, p0b, o0, o1);
    } else {
#pragma unroll
      for (int sub = 1; sub >= 0; --sub) {
        const int sbase = kt * 64 + sub * 32;
        if (sbase <= tw) {
          const f32x16 z = sb_qk(cur, sub, r, g, sw, qf);
          bf16x8 pa, pb;
          if (sbase == tw) sb_elem<true>(z, r, g, R, pa, pb); else sb_elem<false>(z, r, g, R, pa, pb);
          sb_pv(cur, sub, r, g, pa, pb, o0, o1);
        }
      }
    }
    __builtin_amdgcn_sched_barrier(0);
    if (more) {
      *(u32x4*)(nxt + k_st) = rk;
      u32x2 lo, hi; lo[0] = rv[0]; lo[1] = rv[1]; hi[0] = rv[2]; hi[1] = rv[3];
      *(u32x2*)(nxt + v_st) = lo; *(u32x2*)(nxt + v_st + 8) = hi;
    }
    __syncthreads();
  }
  bf16_t* yp = DUMMY ? (bf16_t*)(p.ws + OFF_SLAB) + (size_t)(b * S_ + tw + r) * 512 + h * 64 : PA + (size_t)(b * S_ + tw + r) * PA_LD + PA_QB + h * 64;
#pragma unroll
  for (int rq = 0; rq < 4; ++rq) {
    u32x2 w0, w1;
    w0[0] = pack2(o0[4 * rq], o0[4 * rq + 1]); w0[1] = pack2(o0[4 * rq + 2], o0[4 * rq + 3]);
    w1[0] = pack2(o1[4 * rq], o1[4 * rq + 1]); w1[1] = pack2(o1[4 * rq + 2], o1[4 * rq + 3]);
    *(u32x2*)(yp + 8 * rq + 4 * g) = w0;
    *(u32x2*)(yp + 32 + 8 * rq + 4 * g) = w1;
  }
}

DI unsigned tokey(float f) { unsigned u = __float_as_uint(f); return (u & 0x80000000u) ? ~u : (u | 0x80000000u); }
DI int wave_count_sum(int c) {
  int tot = 0;
#pragma unroll
  for (int bt = 0; bt < 7; ++bt) tot += __builtin_popcountll(__ballot((c >> bt) & 1)) << bt;
  return tot;
}

DI void idx_item(const Params& p, int b, int qt, char* smem) {
  bf16_t* PA = (bf16_t*)(p.ws + OFF_PA);
  const bf16_t* QI = (const bf16_t*)(p.ws + OFF_H) + (size_t)T_ * 512;
  const float* WI = (const float*)(p.ws + OFF_WIDX);
  float* slab = (float*)(p.ws + OFF_SLAB) + (size_t)blockIdx.x * 16 * 4096;
  const int tid = otid(), lane = tid & 63, wid = owid(tid), g4 = lane >> 4, r = lane & 15;
  const int t0 = qt * 16;
  {
    bf16x8 qf[8][2]; float w[8];
    const bf16_t* qp = QI + (size_t)(b * S_ + t0 + r) * 512 + g4 * 8;
#pragma unroll
    for (int hh = 0; hh < 8; ++hh) { qf[hh][0] = ld_frag_g(qp + hh * 64); qf[hh][1] = ld_frag_g(qp + hh * 64 + 32); }
    {
      const float4* wp = (const float4*)(WI + (size_t)(b * S_ + t0 + r) * 8);
      float4 wa = wp[0], wb = wp[1];
      w[0] = wa.x; w[1] = wa.y; w[2] = wa.z; w[3] = wa.w; w[4] = wb.x; w[5] = wb.y; w[6] = wb.z; w[7] = wb.w;
    }
    const int nkt = qt + 1;
    const bf16_t* kbase = PA + (size_t)(b * S_ + r) * PA_LD + PA_KI + g4 * 8;
    bf16x8 k0, k1;
    {
      int kt = wid < nkt ? wid : 0;
      const bf16_t* kp = kbase + (size_t)(kt * 16) * PA_LD;
      k0 = ld_frag_g(kp); k1 = ld_frag_g(kp + 32);
    }
    for (int kt = wid; kt < nkt; kt += NWAVE) {
      bf16x8 n0, n1;
      {
        int kn = kt + NWAVE < nkt ? kt + NWAVE : kt;
        const bf16_t* kp = kbase + (size_t)(kn * 16) * PA_LD;
        n0 = ld_frag_g(kp); n1 = ld_frag_g(kp + 32);
      }
      f32x4 sc = {0.f, 0.f, 0.f, 0.f};
#pragma unroll
      for (int hh = 0; hh < 8; ++hh) {
        f32x4 c = {0.f, 0.f, 0.f, 0.f};
        c = MFMA16(k0, qf[hh][0], c);
        c = MFMA16(k1, qf[hh][1], c);
#pragma unroll
        for (int i = 0; i < 4; ++i) sc[i] += w[hh] * fmaxf(c[i], 0.f);
      }
      *(f32x4*)(slab + (size_t)r * 4096 + kt * 16 + 4 * g4) = sc;
      k0 = n0; k1 = n1;
    }
  }
  __syncthreads();
  for (int qi = 0; qi < 2; ++qi) {
    const int q = wid * 2 + qi;
    const int t = t0 + q, n = t + 1;
    unsigned short* out = (unsigned short*)(PA + (size_t)(b * S_ + t) * PA_LD);
    if (n <= 256) {
#pragma unroll
      for (int j = 0; j < 4; ++j) { int e = j * 64 + lane; out[e] = (unsigned short)(e < n ? e : 0); }
      continue;
    }
    const float* row = slab + (size_t)q * 4096 + lane;
    const int nj = (n + 63) >> 6;
    unsigned key[64];
#pragma unroll
    for (int ch = 0; ch < 4; ++ch) {
#pragma unroll
      for (int jj = 0; jj < 16; ++jj) key[ch * 16 + jj] = 0xff800000u;
      if (nj > ch * 16) {
#pragma unroll
        for (int jj = 0; jj < 16; ++jj) { const int j = ch * 16 + jj; if (j * 64 + lane < n) key[j] = __float_as_uint(row[j * 64]); }
      }
    }
    __builtin_amdgcn_sched_barrier(0);
#pragma unroll
    for (int j = 0; j < 64; ++j) key[j] = (j * 64 + lane < n) ? tokey(__uint_as_float(key[j])) : 0u;
    unsigned Tthr = 0u; int need = 0; bool exact = false;
    for (int bit = 31; bit >= 0; --bit) {
      const unsigned cand = Tthr | (1u << bit);
      int c = 0;
#pragma unroll
      for (int ch = 0; ch < 4; ++ch) {
        if (nj > ch * 16) {
#pragma unroll
          for (int jj = 0; jj < 16; ++jj) c += (key[ch * 16 + jj] >= cand) ? 1 : 0;
        }
      }
      const int cnt = wave_count_sum(c);
      if (cnt >= 256) Tthr = cand;
      if (cnt == 256) { exact = true; break; }
    }
    unsigned Tgt;
    if (exact) { Tgt = Tthr - 1u; need = 0; }
    else {
      int c = 0;
#pragma unroll
      for (int j = 0; j < 64; ++j) c += (key[j] > Tthr) ? 1 : 0;
      Tgt = Tthr; need = 256 - wave_count_sum(c);
    }
    const unsigned long long lt_mask = (1ull << lane) - 1ull;
    int base = 0, ties = 0;
#pragma unroll
    for (int j = 0; j < 64; ++j) {
      if (j < nj) {
        const bool gt = key[j] > Tgt;
        const bool eq = (!exact) && (key[j] == Tthr);
        const unsigned long long meq = __ballot(eq);
        const int myrank = ties + __builtin_popcountll(meq & lt_mask);
        const bool sel = gt || (eq && myrank < need);
        ties += __builtin_popcountll(meq);
        const unsigned long long ms = __ballot(sel);
        const int pos = base + __builtin_popcountll(ms & lt_mask);
        if (sel && pos < 256) out[pos] = (unsigned short)(j * 64 + lane);
        base += __builtin_popcountll(ms);
      }
    }
  }
  __syncthreads();
}

DI void phase_sb_dummy(const Params& p, char* smem) {
  unsigned* cnt = (unsigned*)(p.ws + OFF_CNT) + 16;
  int* s_item = (int*)(smem + SMEM_BYTES - 16);
  while (true) {
    if (otid() == 0) *s_item = (int)atomicAdd(cnt, 1u);
    __syncthreads();
    const int item = *s_item;
    __syncthreads();
    if (item >= 64 * 16) break;
    int qb = 15 - (item >> 6), bh = item & 63;
    sb_item<true>(p, bh >> 3, bh & 7, qb, smem);
  }
}

template <bool IDX_ONLY>
DI void phase_mix(const Params& p, char* smem) {
  unsigned* cnt = (unsigned*)(p.ws + OFF_CNT) + (IDX_ONLY ? 8 : 0);
  int* s_item = (int*)(smem + SMEM_BYTES - 16);
  constexpr int NSB = 64 * 16, NIDX = 8 * 256;
  while (true) {
    if (otid() == 0) *s_item = (int)atomicAdd(cnt, 1u);
    __syncthreads();
    const int item = *s_item;
    __syncthreads();
    if (IDX_ONLY) { if (item >= NIDX) break; int qt = 255 - (item >> 3), b = item & 7; idx_item(p, b, qt, smem); continue; }
    if (item >= NSB + NIDX) break;
    if (item < NSB) {
      int qb = 15 - (item >> 6), bh = item & 63;
      sb_item<false>(p, bh >> 3, bh & 7, qb, smem);
    } else {
      int j = item - NSB;
      int qt = 255 - (j >> 3), b = j & 7;
      idx_item(p, b, qt, smem);
    }
  }
}

DI void phase_sparse(const Params& p, char* smem) {
  const bf16_t* PA = (const bf16_t*)(p.ws + OFF_PA);
  const bf16_t* QA = (const bf16_t*)(p.ws + OFF_H);
  bf16_t* YA = (bf16_t*)(p.ws + OFF_SLAB + (size_t)64 * 1024 * 1024);
  const bf16_t* WUVb = (const bf16_t*)(p.ws + OFF_WB) + WUV;
  const int tid = otid(), lane = tid & 63, wid = owid(tid), g4 = lane >> 4, c = lane & 15;
  constexpr int WST = 10304;
  char* Vl = smem + wid * WST;
  int* Il = (int*)(smem + wid * WST + 9216);
  char* OL = smem + 8 * WST;
  const float sc2 = 0.125f * LOG2E;
  typedef __attribute__((address_space(3))) s16x4 lds_s16x4;
  for (int it = blockIdx.x; it < T_ / 16; it += gridDim.x) {
    const int tok0 = it * 16;
    const int b = tok0 >> 12;
#pragma nounroll
    for (int qi = 0; qi < 2; ++qi) {
      const int q = wid * 2 + qi;
      const int tok = tok0 + q, t = tok & (S_ - 1);
      const int nsel = t + 1 < 256 ? t + 1 : 256;
      const unsigned short* irow = (const unsigned short*)(PA + (size_t)tok * PA_LD);
#pragma unroll
      for (int j = 0; j < 4; ++j) { int e = j * 64 + lane; int v = irow[e]; Il[e] = e < nsel ? v : 0; }
      __syncthreads();
      bf16x8 qf0, qf1;
      {
        u32x4 z4 = {0u, 0u, 0u, 0u};
        qf0 = __builtin_bit_cast(bf16x8, z4); qf1 = qf0;
        if (c < 8) { const bf16_t* qp = QA + (size_t)tok * 512 + c * 64 + g4 * 8; qf0 = ld_frag_g(qp); qf1 = ld_frag_g(qp + 32); }
      }
      f32x4 acc[8];
#pragma unroll
      for (int ct = 0; ct < 8; ++ct) acc[ct] = f32x4{0.f, 0.f, 0.f, 0.f};
      float m = -INFINITY, sum = 0.f;
      const int nch = (nsel + 31) >> 5;
      const char* kbase = (const char*)(PA + (size_t)b * S_ * PA_LD);
#pragma nounroll
      for (int ch = 0; ch < nch; ++ch) {
        u32x4 vr[8];
#pragma unroll
        for (int r8 = 0; r8 < 8; ++r8) {
          const int row = r8 * 4 + g4;
          const int key = Il[ch * 32 + row];
          vr[r8] = *(const u32x4*)(kbase + (size_t)key * (PA_LD * 2) + PA_VA * 2 + c * 16);
        }
        f32x4 cc[2];
#pragma unroll
        for (int tt = 0; tt < 2; ++tt) {
          const int key = Il[ch * 32 + tt * 16 + c];
          const bf16_t* kp = (const bf16_t*)(kbase + (size_t)key * (PA_LD * 2)) + PA_KA + g4 * 8;
          const bf16x8 ka0 = ld_frag_g(kp), ka1 = ld_frag_g(kp + 32);
          f32x4 z = {0.f, 0.f, 0.f, 0.f};
          z = MFMA16(ka0, qf0, z);
          z = MFMA16(ka1, qf1, z);
          cc[tt] = z;
        }
        float cmax = -INFINITY;
#pragma unroll
        for (int tt = 0; tt < 2; ++tt)
#pragma unroll
          for (int i = 0; i < 4; ++i) {
            const int e = ch * 32 + tt * 16 + 4 * g4 + i;
            const float v = e < nsel ? cc[tt][i] : -INFINITY;
            cc[tt][i] = v; cmax = fmaxf(cmax, v);
          }
        cmax = fmaxf(cmax, __shfl_xor(cmax, 16)); cmax = fmaxf(cmax, __shfl_xor(cmax, 32));
        const float mn = fmaxf(m, cmax);
        const float alpha = fexp2((m - mn) * sc2);
        m = mn;
        float ps = 0.f; float pv[8];
#pragma unroll
        for (int tt = 0; tt < 2; ++tt)
#pragma unroll
          for (int i = 0; i < 4; ++i) { const float e2 = fexp2((cc[tt][i] - mn) * sc2); pv[tt * 4 + i] = e2; ps += e2; }
        sum = sum * alpha + ps;
        u32x4 pw; pw[0] = pack2(pv[0], pv[1]); pw[1] = pack2(pv[2], pv[3]); pw[2] = pack2(pv[4], pv[5]); pw[3] = pack2(pv[6], pv[7]);
        const bf16x8 pf = __builtin_bit_cast(bf16x8, pw);
#pragma unroll
        for (int ct = 0; ct < 8; ++ct) acc[ct] *= alpha;
#pragma unroll
        for (int r8 = 0; r8 < 8; ++r8) *(u32x4*)(Vl + (r8 * 4 + g4) * 288 + c * 16) = vr[r8];
        {
          const int qq = c >> 2, pp = c & 3;
          const char* vb0 = Vl + (4 * g4 + qq) * 288 + pp * 8;
#pragma unroll
          for (int ct = 0; ct < 8; ++ct) {
            const s16x4 lo = __builtin_amdgcn_ds_read_tr16_b64_v4i16((lds_s16x4*)(vb0 + ct * 32));
            const s16x4 hi = __builtin_amdgcn_ds_read_tr16_b64_v4i16((lds_s16x4*)(vb0 + 16 * 288 + ct * 32));
            const bf16x8 af = __builtin_shufflevector(lo, hi, 0, 1, 2, 3, 4, 5, 6, 7);
            acc[ct] = MFMA16(af, pf, acc[ct]);
          }
        }
      }
      sum += __shfl_xor(sum, 16); sum += __shfl_xor(sum, 32);
      const float inv = 1.f / sum;
      if (c < 8) {
#pragma unroll
        for (int ct = 0; ct < 8; ++ct) {
          u32x2 w; w[0] = pack2(acc[ct][0] * inv, acc[ct][1] * inv); w[1] = pack2(acc[ct][2] * inv, acc[ct][3] * inv);
          *(u32x2*)(OL + q * 2064 + c * 256 + (ct * 16 + 4 * g4) * 2) = w;
        }
      }
      __syncthreads();
    }
    {
      const int h = wid;
      bf16x8 af[4];
#pragma unroll
      for (int ks = 0; ks < 4; ++ks) af[ks] = ld_frag_s(OL + c * 2064 + h * 256 + (ks * 32 + g4 * 8) * 2);
#pragma nounroll
      for (int nt = 0; nt < 4; ++nt) {
        f32x4 cc = {0.f, 0.f, 0.f, 0.f};
        const bf16_t* wp = WUVb + (size_t)(h * 64 + nt * 16 + c) * 128 + g4 * 8;
#pragma unroll
        for (int ks = 0; ks < 4; ++ks) cc = MFMA16(af[ks], ld_frag_g(wp + ks * 32), cc);
#pragma unroll
        for (int i = 0; i < 4; ++i) YA[(size_t)(tok0 + 4 * g4 + i) * 512 + h * 64 + nt * 16 + c] = (bf16_t)f2bf(cc[i]);
      }
    }
    __syncthreads();
  }
}

DI void phase_merge(const Params& p, char* smem) {
  const bf16_t* YA = (const bf16_t*)(p.ws + OFF_SLAB + (size_t)64 * 1024 * 1024);
  const bf16_t* YB = (const bf16_t*)(p.ws + OFF_PA) + PA_QB;
  const bf16_t* Wa = (const bf16_t*)(p.ws + OFF_WB) + WOA;
  const bf16_t* Wb = (const bf16_t*)(p.ws + OFF_WB) + WOB;
  const bf16_t* GT = (const bf16_t*)(p.ws + OFF_GATES);
  bf16_t* MG = (bf16_t*)(p.ws + OFF_SLAB);
  for (int it = 0;; ++it) {
    int mt, nt; int s = sched_tile(it, 128, 4, mt, nt);
    if (s < 0) break; if (s == 0) continue;
    acc8p_t acc;
    gemm8p<512, 512, 8>(YA + (size_t)mt * 256 * 512, Wa + (size_t)nt * 256 * 512, smem, acc);
    EPI_IDS
    const unsigned goff = (unsigned)((wr * 64 + fq * 4) * 2048 + wc * 32 + fr);
    const unsigned loff = (unsigned)((wr * 64 + fq * 4) * D_ + wc * 32 + fr);
    const bf16_t* gp = GT + (size_t)(mt * 256) * 2048 + nt * 256;
    bf16_t* tp = MG + (size_t)(mt * 256) * D_ + nt * 256;
    EPI_FOR {
      const int lr = LROW(ai, m, j), lc = LCOL(bj, n);
      float ga = bf2f((gp + lr * 2048 + lc)[goff]);
      (tp + lr * D_ + lc)[loff] = (bf16_t)f2bf(ga * acc[ai][bj][m][n][j]);
    }
  }
  for (int it = 0;; ++it) {
    int mt, nt; int s = sched_tile(it, 128, 4, mt, nt);
    if (s < 0) break; if (s == 0) continue;
    acc8p_t acc;
    gemm8p<PA_LD, 512, 8>(YB + (size_t)mt * 256 * PA_LD, Wb + (size_t)nt * 256 * 512, smem, acc);
    EPI_IDS
    const unsigned goff = (unsigned)((wr * 64 + fq * 4) * 2048 + wc * 32 + fr);
    const unsigned loff = (unsigned)((wr * 64 + fq * 4) * D_ + wc * 32 + fr);
    const bf16_t* gp = GT + (size_t)(mt * 256) * 2048 + 1024 + nt * 256;
    bf16_t* tp = MG + (size_t)(mt * 256) * D_ + nt * 256;
    EPI_FOR {
      const int lr = LROW(ai, m, j), lc = LCOL(bj, n);
      float gb = bf2f((gp + lr * 2048 + lc)[goff]);
      bf16_t* e = (tp + lr * D_ + lc) + loff;
      *e = (bf16_t)f2bf(bf2f(*e) + gb * acc[ai][bj][m][n][j]);
    }
  }
}

DI void phase_outproj(const Params& p, char* smem) {
  const bf16_t* MG = (const bf16_t*)(p.ws + OFF_SLAB);
  const bf16_t* W = (const bf16_t*)(p.ws + OFF_WB) + WOUT;
  float* out = p.out;
  for (int it = 0;; ++it) {
    int mt, nt; int s = sched_tile(it, 128, 4, mt, nt);
    if (s < 0) break; if (s == 0) continue;
    acc8p_t acc;
    gemm8p<D_, D_, 16>(MG + (size_t)mt * 256 * D_, W + (size_t)nt * 256 * D_, smem, acc);
    EPI_IDS
    float* tp = out + (size_t)(mt * 256) * D_ + nt * 256;
    const unsigned loff = (unsigned)((wr * 64 + fq * 4) * D_ + wc * 32 + fr);
    EPI_FOR {
      const int ro = LROW(ai, m, j) * D_ + LCOL(bj, n);
      (tp + ro)[loff] = (tp + ro)[loff] + acc[ai][bj][m][n][j];
    }
  }
}

#define XB_TMO      128
#define XB_XCNT(j)  (256  + 64 * (j))
#define XB_XSUB(j)  (1280 + 64 * (j))
#define XB_XGEN(j)  (2304 + 64 * (j))
#define XB_TOP      3328
#define XB_TOPGEN   3392
#define XCD_BAR_WORDS 3456
#define XB_SPIN_CAP (1u << 22)
#define LAS __attribute__((address_space(3)))
DI unsigned xb_ld(unsigned* p) { return __hip_atomic_load(p, __ATOMIC_RELAXED, __HIP_MEMORY_SCOPE_AGENT); }
DI unsigned xb_add(unsigned* p, unsigned v) { return __hip_atomic_fetch_add(p, v, __ATOMIC_RELAXED, __HIP_MEMORY_SCOPE_AGENT); }
DI unsigned xb_xcc_id() { return (unsigned)__builtin_amdgcn_s_getreg((3 << 11) | 20) & 0xFu; }
#define XB_SPIN(cond, bar) do { unsigned _sp = 0; while (cond) { __builtin_amdgcn_s_sleep(1); \
    if ((++_sp & 255u) == 0u) { if (xb_ld(&(bar)[XB_TMO])) break; if (_sp > XB_SPIN_CAP) { atomicAdd(&(bar)[XB_TMO], 1u); break; } } } } while (0)
struct XcdBarrier { unsigned* bar; unsigned x; volatile LAS unsigned* st; };
DI XcdBarrier xcd_barrier_post(unsigned* bar, volatile LAS unsigned* st) {
  XcdBarrier b; b.bar = bar; b.x = xb_xcc_id(); b.st = st;
  if (threadIdx.x == 0) (void)xb_add(&bar[XB_XCNT(b.x)], 1u);
  return b;
}
DI void xcd_barrier_complete(unsigned* bar, unsigned x, unsigned& nloc, unsigned& nx) {
  const unsigned G = gridDim.x * gridDim.y * gridDim.z;
  unsigned sum, cnt, mine, sp = 0u;
  for (;;) {
    sum = 0u; cnt = 0u; mine = 0u;
#pragma unroll
    for (unsigned j = 0; j < 16; ++j) { const unsigned c = xb_ld(&bar[XB_XCNT(j)]); sum += c; cnt += (c > 0u) ? 1u : 0u; mine = (j == x) ? c : mine; }
    if (sum == G) break;
    __builtin_amdgcn_s_sleep(1);
    if ((++sp & 255u) == 0u) { if (xb_ld(&bar[XB_TMO])) break; if (sp > XB_SPIN_CAP) { atomicAdd(&bar[XB_TMO], 1u); break; } }
  }
  nloc = mine > 0u ? mine : 1u; nx = cnt > 0u ? cnt : 1u;
}
DI void xcd_barrier(const XcdBarrier& b) {
  asm volatile("s_waitcnt vmcnt(0)" ::: "memory");
  __syncthreads();
  if (threadIdx.x == 0) {
    unsigned* bar = b.bar;
    __builtin_amdgcn_s_waitcnt(0);
    unsigned nloc = b.st[0], nx = b.st[1];
    if (nloc == 0u) { xcd_barrier_complete(bar, b.x, nloc, nx); b.st[0] = nloc; b.st[1] = nx; }
    const unsigned old = xb_add(&bar[XB_XSUB(b.x)], 1u);
    const unsigned gen = old / nloc;
    if (old + 1u == (gen + 1u) * nloc) {
      __builtin_amdgcn_fence(__ATOMIC_RELEASE, "agent");
      asm volatile("s_waitcnt vmcnt(0)" ::: "memory");
      const unsigned og = xb_add(&bar[XB_TOP], 1u);
      const unsigned tg = og / nx;
      if (og + 1u == (tg + 1u) * nx) xb_add(&bar[XB_TOPGEN], 1u);
      else XB_SPIN(xb_ld(&bar[XB_TOPGEN]) == tg, bar);
      __builtin_amdgcn_fence(__ATOMIC_ACQUIRE, "agent");
      xb_add(&bar[XB_XGEN(b.x)], 1u);
      asm volatile("s_waitcnt vmcnt(0)" ::: "memory");
    } else {
      XB_SPIN(xb_ld(&bar[XB_XGEN(b.x)]) == gen, bar);
      __builtin_amdgcn_fence(__ATOMIC_ACQUIRE, "agent");
      asm volatile("s_waitcnt vmcnt(0)" ::: "memory");
    }
  }
  __syncthreads();
}

DI void run_phase(const Params& p, int ph, char* smem) {
  switch (ph) {
    case 0: phase_prep(p, smem); break;
    case 1: phase_ffn_gu(p, W1GU, smem); break;
    case 2: phase_ffn_down(p, W1D, p.x, smem); break;
    case 3: phase_rmsnorm_widx(p, smem); break;
    case 4: phase_win(p, smem); break;
    case 5: phase_qproj(p, smem); break;
    case 6: phase_mix<false>(p, smem); break;
    case 13: phase_mix<true>(p, smem); break;
    case 14: phase_sb_dummy(p, smem); break;
    case 7: phase_sparse(p, smem); break;
    case 8: phase_merge(p, smem); break;
    case 9: phase_outproj(p, smem); break;
    case 10: phase_rmsnorm(p.out, p.g_ffn2, (bf16_t*)(p.ws + OFF_H)); break;
    case 11: phase_ffn_gu(p, W2GU, smem); break;
    case 12: phase_ffn_down(p, W2D, p.out, smem); break;
  }
}
constexpr int NPHASE = 13;

#if !MULTI_LAUNCH
__global__ void __launch_bounds__(512, 2) mega_kernel(Params p) {
  __shared__ __attribute__((aligned(16))) char smem[SMEM_BYTES];
  __shared__ uint4 xb_words;
  cg::grid_group grid = cg::this_grid();
  if (threadIdx.x == 0) xb_words = make_uint4(0u, 0u, 0u, 0u);
  __syncthreads();
  XcdBarrier xb = xcd_barrier_post((unsigned*)(p.ws + OFF_CNT + 256), (volatile LAS unsigned*)&xb_words);
  unsigned* bar0 = (unsigned*)(p.ws + OFF_CNT + 256);
  if (threadIdx.x == 0) g_sched[3] = (int)xb_add(&bar0[XB_XCNT(xb.x) + 16], 1u);
  grid.sync();
  if (threadIdx.x == 0) {
    const unsigned per = gridDim.x >> 3; bool ok = (gridDim.x & 7) == 0 && xb.x < 8;
    for (unsigned jx = 0; jx < 16; ++jx) { const unsigned c = xb_ld(&bar0[XB_XCNT(jx) + 16]); ok = ok && (c == (jx < 8 ? per : 0u)); }
    g_sched[0] = ok ? (int)xb.x : (int)(blockIdx.x & 7);
    g_sched[1] = ok ? g_sched[3] : (int)(blockIdx.x >> 3);
  }
  __syncthreads();
#pragma nounroll
  for (int ph = 0; ph < NPHASE; ++ph) {
    int phv = ph; asm volatile("" : "+s"(phv));
    run_phase(p, phv, smem);
    if (ph + 1 < NPHASE) { XcdBarrier xb2; xb2.bar = (unsigned*)(p.ws + OFF_CNT + 256); xb2.x = xb_xcc_id(); xb2.st = (volatile LAS unsigned*)&xb_words; xcd_barrier(xb2); }
  }
}
#else
template <int PH>
__global__ void __launch_bounds__(512, 2) phase_kernel(Params p) {
  __shared__ __attribute__((aligned(16))) char smem[SMEM_BYTES];
  if (threadIdx.x == 0) { g_sched[0] = blockIdx.x & 7; g_sched[1] = blockIdx.x >> 3; }
  __syncthreads();
  run_phase(p, PH, smem);
}
#ifndef PROBE_MASK
#define PROBE_MASK 0
#endif
template <int PH> static void launch_phases(const Params& p, hipStream_t stream) {
  hipLaunchKernelGGL(phase_kernel<PH>, dim3(256), dim3(NTHR), 0, stream, p);
  if constexpr (((PROBE_MASK >> PH) & 1) != 0 && PH != 6) hipLaunchKernelGGL(phase_kernel<PH>, dim3(256), dim3(NTHR), 0, stream, p);
  if constexpr (((PROBE_MASK >> PH) & 1) != 0 && PH == 6) hipLaunchKernelGGL(phase_kernel<13>, dim3(256), dim3(NTHR), 0, stream, p);
  if constexpr (((PROBE_MASK >> 14) & 1) != 0 && PH == 5) hipLaunchKernelGGL(phase_kernel<14>, dim3(256), dim3(NTHR), 0, stream, p);
  if constexpr (PH + 1 < NPHASE) launch_phases<PH + 1>(p, stream);
}
#endif

extern "C" void kernel_launch(void* const* d_in, const int* in_sizes, int n_in, void* d_out, int out_size, void* d_ws,
                              size_t ws_size, hipStream_t stream) {
  Params p{};
  p.x = (const float*)d_in[0]; p.pos = (const int*)d_in[1];
  p.g_ffn1 = (const float*)d_in[2]; p.w1g = (const float*)d_in[3]; p.w1u = (const float*)d_in[4]; p.w1d = (const float*)d_in[5];
  p.g_mix = (const float*)d_in[6]; p.w_in = (const float*)d_in[7]; p.g_cq = (const float*)d_in[8]; p.w_uq = (const float*)d_in[9];
  p.w_qi = (const float*)d_in[10]; p.g_qa = (const float*)d_in[11]; p.g_ka = (const float*)d_in[12]; p.w_uv = (const float*)d_in[13];
  p.w_oa = (const float*)d_in[14]; p.w_ob = (const float*)d_in[15]; p.w_out = (const float*)d_in[16]; p.g_ffn2 = (const float*)d_in[17];
  p.w2g = (const float*)d_in[18]; p.w2u = (const float*)d_in[19]; p.w2d = (const float*)d_in[20];
  p.out = (float*)d_out; p.ws = (char*)d_ws;
  if (ws_size < WS_NEED) { fprintf(stderr, "workspace too small: %zu < %zu\n", ws_size, (size_t)WS_NEED); return; }
  (void)hipMemsetAsync((char*)d_ws + OFF_CNT, 0, 256 + 16384, stream);
#if MULTI_LAUNCH
  launch_phases<0>(p, stream);
#else
  static int grid_blocks = 0;
  if (!grid_blocks) {
    int dev = 0, cus = 0, per_cu = 0;
    (void)hipGetDevice(&dev);
    (void)hipDeviceGetAttribute(&cus, hipDeviceAttributeMultiprocessorCount, dev);
    (void)hipOccupancyMaxActiveBlocksPerMultiprocessor(&per_cu, mega_kernel, NTHR, 0);
    if (per_cu > 1) per_cu = 1;
    grid_blocks = cus * per_cu;
    if (grid_blocks > 256) grid_blocks = 256;
  }
  void* args[] = {&p};
  hipError_t e = hipLaunchCooperativeKernel((void*)mega_kernel, dim3(grid_blocks), dim3(NTHR), args, 0, stream);
  if (e != hipSuccess) fprintf(stderr, "cooperative launch failed: %s (grid %d)\n", hipGetErrorString(e), grid_blocks);
#endif
}
```

```cpp
#include <hip/hip_runtime.h>
#include <hip/hip_cooperative_groups.h>
#include <stdint.h>
#include <stdio.h>
namespace cg = cooperative_groups;

#ifndef MULTI_LAUNCH
#define MULTI_LAUNCH 0
#endif

#define DI __device__ __forceinline__
typedef unsigned short bf16_t;
typedef __attribute__((ext_vector_type(8))) short bf16x8;
typedef __attribute__((ext_vector_type(16))) float f32x16;
typedef __attribute__((ext_vector_type(4))) float f32x4;
typedef __attribute__((ext_vector_type(4))) unsigned u32x4;
typedef __attribute__((ext_vector_type(2))) unsigned u32x2;
typedef __attribute__((ext_vector_type(4))) short s16x4;

constexpr int T_ = 32768, S_ = 4096, D_ = 1024, FF = 2816;
constexpr int PA_LD = 1536;
constexpr int PA_KA = 256, PA_VA = 320, PA_KI = 448, PA_QB = 512, PA_KB = 1024;
constexpr float EPS = 1e-6f;
constexpr float LOG2E = 1.4426950408889634f;

constexpr size_t W1GU = 0;
constexpr size_t W1D = W1GU + (size_t)5632 * 1024;
constexpr size_t W2GU = W1D + (size_t)1024 * 2816;
constexpr size_t W2D = W2GU + (size_t)5632 * 1024;
constexpr size_t WIN = W2D + (size_t)1024 * 2816;
constexpr size_t WQ = WIN + (size_t)4096 * 1024;
constexpr size_t WUV = WQ + (size_t)1024 * 256;
constexpr size_t WOA = WUV + (size_t)512 * 128;
constexpr size_t WOB = WOA + (size_t)1024 * 512;
constexpr size_t WOUT = WOB + (size_t)1024 * 512;
constexpr size_t WB_ELEMS = WOUT + (size_t)1024 * 1024;
constexpr size_t OFF_WB = 0;
constexpr size_t OFF_H = (WB_ELEMS * 2 + 255) & ~(size_t)255;
constexpr size_t OFF_PA = OFF_H + (size_t)T_ * 1024 * 2;
constexpr size_t OFF_VT = OFF_PA + (size_t)T_ * PA_LD * 2;
constexpr size_t OFF_GATES = OFF_VT + (size_t)T_ * 512 * 2;
constexpr size_t OFF_SLAB = OFF_GATES + (size_t)T_ * 2048 * 2;
constexpr size_t OFF_WIDX = OFF_SLAB + (size_t)512 * 16 * 4096 * 4;
constexpr size_t OFF_ROPE = OFF_WIDX + (size_t)T_ * 8 * 4;
constexpr size_t OFF_CNT = OFF_ROPE + (size_t)T_ * 32 * 8;
constexpr size_t WS_NEED = OFF_CNT + 256 + 16384;
static_assert(WS_NEED <= (size_t)512 * 1024 * 1024, "workspace too large");
static_assert((size_t)T_ * FF * 2 <= OFF_SLAB - OFF_PA, "U must fit in PA+VT+GATES");

constexpr int SMEM_BYTES = 131072 + 2048;
__shared__ int g_sched[4];
constexpr int NTHR = 512, NWAVE = 8;

struct Params {
  const float* x; const int* pos;
  const float *g_ffn1, *w1g, *w1u, *w1d, *g_mix, *w_in, *g_cq, *w_uq, *w_qi, *g_qa, *g_ka, *w_uv, *w_oa, *w_ob, *w_out, *g_ffn2, *w2g, *w2u, *w2d;
  float* out;
  char* ws;
};

typedef __attribute__((ext_vector_type(2))) __bf16 bf16x2_t;
typedef __attribute__((ext_vector_type(2))) float f32x2_t;
DI unsigned pack2(float a, float b) { f32x2_t v = {a, b}; return __builtin_bit_cast(unsigned, __builtin_convertvector(v, bf16x2_t)); }
DI unsigned f2bf(float x) { return pack2(x, 0.f) & 0xffffu; }
DI float bf2f(unsigned v) { return __uint_as_float(v << 16); }
DI float bflo(unsigned v) { return __uint_as_float(v << 16); }
DI float bfhi(unsigned v) { return __uint_as_float(v & 0xffff0000u); }
DI float fexp2(float x) { return __builtin_amdgcn_exp2f(x); }
DI float frcp(float x) { return __builtin_amdgcn_rcpf(x); }
DI float wave_sum(float v) {
#pragma unroll
  for (int o = 32; o > 0; o >>= 1) v += __shfl_xor(v, o);
  return v;
}
#define MFMA32(a, b, c) __builtin_amdgcn_mfma_f32_32x32x16_bf16((a), (b), (c), 0, 0, 0)
#define MFMA16(a, b, c) __builtin_amdgcn_mfma_f32_16x16x32_bf16((a), (b), (c), 0, 0, 0)
DI bf16x8 ld_frag_g(const bf16_t* p) { return __builtin_bit_cast(bf16x8, *(const u32x4*)p); }
DI bf16x8 ld_frag_s(const char* p) { return __builtin_bit_cast(bf16x8, *(const u32x4*)p); }
DI int otid() { int t = threadIdx.x; asm volatile("" : "+v"(t)); return t; }
DI int owid(int tid) { return __builtin_amdgcn_readfirstlane(tid >> 6); }
DI int crow(int reg, int g) { return (reg & 3) + 8 * (reg >> 2) + 4 * g; }

DI const float* prep_col(const Params& p, int mat, int r, int& ld) {
  switch (mat) {
    case 0: case 2: {
      int j = r >> 8, q = r & 255; int half = q >> 7, c = q & 127;
      int n = j * 128 + c; ld = FF;
      const float* g = mat == 0 ? p.w1g : p.w2g; const float* u = mat == 0 ? p.w1u : p.w2u;
      return (half ? u : g) + n;
    }
    case 1: ld = D_; return p.w1d + r;
    case 3: ld = D_; return p.w2d + r;
    case 4: {
      ld = 4104;
      if (r < 512) return p.w_in + r;
      return p.w_in + r + 8;
    }
    case 5: {
      ld = 512;
      int T = r >> 8, q = r & 255; int hl = (q & 127) >> 5, d = (q >> 7) * 32 + (q & 31);
      int col = ((T & 1) * 4 + hl) * 64 + d;
      return (T < 2 ? p.w_uq : p.w_qi) + col;
    }
    case 6: { ld = 64; int h = r >> 6, d = r & 63; return p.w_uv + h * 8192 + d; }
    case 7: ld = D_; return p.w_oa + r;
    case 8: ld = D_; return p.w_ob + r;
    default: ld = D_; return p.w_out + r;
  }
}

DI void prep_transpose_tile(const Params& p, bool valid, int mat, int K, bf16_t* dst, int tile, float* lds, int t) {
  const int nkt = K >> 7;
  const int r0 = (tile / nkt) * 32, k0 = (tile % nkt) * 128;
  const int tx = t & 31, ty = t >> 5;
  if (valid) {
    int ld; const float* col = prep_col(p, mat, r0 + tx, ld);
#pragma unroll
    for (int i = 0; i < 16; ++i) {
      int k = k0 + ty + 8 * i;
      float v = 0.f;
      if (col) { v = col[(size_t)k * ld]; if (mat == 5) v *= p.g_cq[k]; }
      lds[tx * 129 + ty + 8 * i] = v;
    }
  }
  __syncthreads();
  if (valid) {
    const int row = t >> 3, kc = (t & 7) * 16;
    const float* s = lds + row * 129 + kc;
    u32x4 o0, o1;
    o0[0] = pack2(s[0], s[1]); o0[1] = pack2(s[2], s[3]); o0[2] = pack2(s[4], s[5]); o0[3] = pack2(s[6], s[7]);
    o1[0] = pack2(s[8], s[9]); o1[1] = pack2(s[10], s[11]); o1[2] = pack2(s[12], s[13]); o1[3] = pack2(s[14], s[15]);
    u32x4* d = (u32x4*)(dst + (size_t)(r0 + row) * K + k0 + kc);
    d[0] = o0; d[1] = o1;
  }
  __syncthreads();
}

DI void rmsnorm_row(const float* __restrict__ xr, const float* __restrict__ g, bf16_t* __restrict__ o) {
  const int lane = otid() & 63;
  float4 v[4]; float ss = 0.f;
#pragma unroll
  for (int j = 0; j < 4; ++j) { v[j] = *(const float4*)(xr + lane * 4 + 256 * j); ss += v[j].x * v[j].x + v[j].y * v[j].y + v[j].z * v[j].z + v[j].w * v[j].w; }
  ss = wave_sum(ss);
  const float rs = rsqrtf(ss * (1.f / 1024.f) + EPS);
#pragma unroll
  for (int j = 0; j < 4; ++j) {
    float4 gg = *(const float4*)(g + lane * 4 + 256 * j);
    u32x2 w; w[0] = pack2(v[j].x * rs * gg.x, v[j].y * rs * gg.y); w[1] = pack2(v[j].z * rs * gg.z, v[j].w * rs * gg.w);
    *(u32x2*)(o + lane * 4 + 256 * j) = w;
  }
}

DI void phase_rmsnorm(const float* __restrict__ src, const float* __restrict__ g, bf16_t* __restrict__ dst) {
  const int wid = owid(otid());
  for (int it = blockIdx.x; it < T_ / NWAVE; it += gridDim.x) {
    int row = it * NWAVE + wid;
    rmsnorm_row(src + (size_t)row * D_, g, dst + (size_t)row * D_);
  }
}

DI void phase_rmsnorm_widx(const Params& p, char* smem) {
  const int tid = otid(), lane = tid & 63, wid = owid(tid);
  float* wl = (float*)smem;
  for (int e = tid; e < 8 * 1024; e += NTHR) { int k = e >> 3, h = e & 7; wl[h * 1024 + k] = p.w_in[(size_t)k * 4104 + 512 + h]; }
  __syncthreads();
  const float* src = p.out; const float* g = p.g_mix;
  bf16_t* dst = (bf16_t*)(p.ws + OFF_H);
  float* WI = (float*)(p.ws + OFF_WIDX);
  for (int it = blockIdx.x; it < T_ / NWAVE; it += gridDim.x) {
    const int row = it * NWAVE + wid;
    const float* xr = src + (size_t)row * D_;
    float4 v[4]; float ss = 0.f;
#pragma unroll
    for (int j = 0; j < 4; ++j) { v[j] = *(const float4*)(xr + lane * 4 + 256 * j); ss += v[j].x * v[j].x + v[j].y * v[j].y + v[j].z * v[j].z + v[j].w * v[j].w; }
    ss = wave_sum(ss);
    const float rs = rsqrtf(ss * (1.f / 1024.f) + EPS);
    float acc[8];
#pragma unroll
    for (int h = 0; h < 8; ++h) acc[h] = 0.f;
#pragma unroll
    for (int j = 0; j < 4; ++j) {
      float4 gg = *(const float4*)(g + lane * 4 + 256 * j);
      const float y0 = v[j].x * rs * gg.x, y1 = v[j].y * rs * gg.y, y2 = v[j].z * rs * gg.z, y3 = v[j].w * rs * gg.w;
      u32x2 w; w[0] = pack2(y0, y1); w[1] = pack2(y2, y3);
      *(u32x2*)(dst + (size_t)row * D_ + lane * 4 + 256 * j) = w;
#pragma unroll
      for (int h = 0; h < 8; ++h) {
        const f32x4 ww = *(const f32x4*)(wl + h * 1024 + lane * 4 + 256 * j);
        acc[h] += y0 * ww[0] + y1 * ww[1] + y2 * ww[2] + y3 * ww[3];
      }
    }
#pragma unroll
    for (int h = 0; h < 8; ++h) acc[h] = wave_sum(acc[h]);
    if (lane < 8) {
      float r = acc[0];
#pragma unroll
      for (int h = 1; h < 8; ++h) r = lane == h ? acc[h] : r;
      WI[(size_t)row * 8 + lane] = r * 0.04419417382415922f;
    }
  }
  __syncthreads();
}

DI void phase_prep(const Params& p, char* smem) {
  bf16_t* wb = (bf16_t*)(p.ws + OFF_WB);
  const int tid = otid(), vb = tid >> 8, t = tid & 255;
  float* lds = (float*)smem + vb * 4160;
  constexpr int c0 = 1408, c1 = c0 + 704, c2 = c1 + 1408, c3 = c2 + 704, c4 = c3 + 1024, c5 = c4 + 64, c6 = c5 + 16, c7 = c6 + 128, c8 = c7 + 128, c9 = c8 + 256;
  static_assert((c9 & 1) == 0, "pairs");
  for (int it0 = blockIdx.x; it0 < c9 / 2; it0 += gridDim.x) {
    const int it = it0 * 2 + vb;
    int mat, K, base; size_t off;
    if (it < c0) { mat = 0; K = 1024; base = 0; off = W1GU; }
    else if (it < c1) { mat = 1; K = 2816; base = c0; off = W1D; }
    else if (it < c2) { mat = 2; K = 1024; base = c1; off = W2GU; }
    else if (it < c3) { mat = 3; K = 2816; base = c2; off = W2D; }
    else if (it < c4) { mat = 4; K = 1024; base = c3; off = WIN; }
    else if (it < c5) { mat = 5; K = 256; base = c4; off = WQ; }
    else if (it < c6) { mat = 6; K = 128; base = c5; off = WUV; }
    else if (it < c7) { mat = 7; K = 512; base = c6; off = WOA; }
    else if (it < c8) { mat = 8; K = 512; base = c7; off = WOB; }
    else { mat = 9; K = 1024; base = c8; off = WOUT; }
    prep_transpose_tile(p, true, mat, K, wb + off, it - base, lds, t);
  }
  {
    const int wid = owid(tid);
    for (int it = blockIdx.x; it < T_ / NWAVE; it += gridDim.x) {
      int row = it * NWAVE + wid;
      rmsnorm_row(p.x + (size_t)row * D_, p.g_ffn1, (bf16_t*)(p.ws + OFF_H) + (size_t)row * D_);
    }
  }
  for (int it = blockIdx.x; it < T_ * 32 / NTHR; it += gridDim.x) {
    int e = it * NTHR + tid;
    int tok = e >> 5, i = e & 31;
    float inv_freq = exp2f(-(float)i * (13.287712379549449f / 32.f));
    float ang = (float)p.pos[tok] * inv_freq;
    double rev = (double)ang * 0.15915494309189535;
    rev -= floor(rev);
    float r = (float)rev;
    float2 cs; cs.x = __builtin_amdgcn_cosf(r); cs.y = __builtin_amdgcn_sinf(r);
    ((float2*)(p.ws + OFF_ROPE))[e] = cs;
  }
}

typedef f32x4 acc8p_t[2][2][4][2];
constexpr int G_BK = 64, G_HALF = 128, G_HT = G_HALF * G_BK;
DI int lds_byte(int r, int c) {
  int st = (r >> 4) * 2 + (c >> 5), rr = r & 15, cc = c & 31, ob = rr * 64 + cc * 2;
  return st * 1024 + (ob ^ (((ob >> 9) & 1) << 5));
}
DI void stage_rc(int b, int& R, int& C) {
  int st = b / 1024, sb = b % 1024, swz = sb ^ (((sb >> 9) & 1) << 5);
  R = (st >> 1) * 16 + swz / 64; C = (st & 1) * 32 + (swz % 64) / 2;
}
template <int LDA, int LDB, int NKT>
DI void gemm8p(const bf16_t* __restrict__ A, const bf16_t* __restrict__ Bt, char* smem, acc8p_t& acc) {
  static_assert(NKT >= 4 && (NKT % 2) == 0, "K tiles");
  bf16_t* shm = (bf16_t*)smem;
  const int tid = otid();
  const int wid = owid(tid), lane = tid & 63, wr = wid >> 2, wc = wid & 3, fr = lane & 15, fq = lane >> 4;
#define SA(b, h) (shm + ((b) * 2 + (h)) * G_HT)
#define SB(b, h) (shm + (4 + (b) * 2 + (h)) * G_HT)
  unsigned sofa, sofb;
  { int _r, _c; stage_rc(tid * 16, _r, _c); sofa = (unsigned)(_r * LDA + _c); sofb = (unsigned)(_r * LDB + _c); }
#define STAGE(P, BASE, LD, br, kt, SOF) do { const bf16_t* _ub = (BASE) + ((long)(br) * (LD) + (long)(kt) * G_BK);     \
    _Pragma("unroll") for (int _i = 0; _i < 2; ++_i) { \
      __builtin_amdgcn_global_load_lds((const unsigned*)((_ub + (long)_i * 64 * (LD)) + SOF), \
        (unsigned*)((char*)(P) + tid * 16 + _i * 8192), 16, 0, 0); } } while (0)
#define LDA_(dst, b, h) _Pragma("unroll") for (int m = 0; m < 4; ++m) _Pragma("unroll") for (int k = 0; k < 2; ++k) \
    dst[m][k] = *reinterpret_cast<const bf16x8*>((char*)SA(b, h) + lds_byte(wr * 64 + m * 16 + fr, k * 32 + fq * 8))
#define LDB_(dst, b, h) _Pragma("unroll") for (int n = 0; n < 2; ++n) _Pragma("unroll") for (int k = 0; k < 2; ++k) \
    dst[n][k] = *reinterpret_cast<const bf16x8*>((char*)SB(b, h) + lds_byte(wc * 32 + n * 16 + fr, k * 32 + fq * 8))
#define MMA(ai, bj, At_, Bt_) do { __builtin_amdgcn_s_setprio(1); \
    _Pragma("unroll") for (int m = 0; m < 4; ++m) _Pragma("unroll") for (int n = 0; n < 2; ++n) _Pragma("unroll") for (int k = 0; k < 2; ++k) \
      acc[ai][bj][m][n] = __builtin_amdgcn_mfma_f32_16x16x32_bf16(At_[m][k], Bt_[n][k], acc[ai][bj][m][n], 0, 0, 0); \
    __builtin_amdgcn_s_setprio(0); } while (0)
#define WAIT_V(n) asm volatile("s_waitcnt vmcnt(" #n ")" ::: "memory")
#define WAIT_L(n) asm volatile("s_waitcnt lgkmcnt(" #n ")" ::: "memory")
#define BAR __builtin_amdgcn_s_barrier()
#define SCHED __builtin_amdgcn_sched_barrier(0)
#pragma unroll
  for (int a = 0; a < 2; ++a)
#pragma unroll
    for (int b = 0; b < 2; ++b)
#pragma unroll
      for (int m = 0; m < 4; ++m)
#pragma unroll
        for (int n = 0; n < 2; ++n) acc[a][b][m][n] = f32x4{0.f, 0.f, 0.f, 0.f};
  bf16x8 At[4][2], B0[2][2], B1[2][2];
  constexpr int nt = NKT;
  WAIT_V(0);
  SCHED;
  STAGE(SB(0, 0), Bt, LDB, 0, 0, sofb); STAGE(SA(0, 0), A, LDA, 0, 0, sofa);
  STAGE(SB(0, 1), Bt, LDB, G_HALF, 0, sofb); STAGE(SA(0, 1), A, LDA, G_HALF, 0, sofa);
  if (wr == 1) BAR;
  WAIT_V(4); BAR;
  STAGE(SB(1, 0), Bt, LDB, 0, 1, sofb); STAGE(SA(1, 0), A, LDA, 0, 1, sofa); STAGE(SB(1, 1), Bt, LDB, G_HALF, 1, sofb);
  WAIT_V(6); BAR;
  for (int t = 0; t < nt - 2; t += 2) {
    LDB_(B0, 0, 0); SCHED; LDA_(At, 0, 0); STAGE(SA(1, 1), A, LDA, G_HALF, t + 1, sofa);
    WAIT_L(8); BAR; WAIT_L(0); MMA(0, 0, At, B0); BAR; SCHED;
    LDB_(B1, 0, 1); STAGE(SB(0, 0), Bt, LDB, 0, t + 2, sofb);
    BAR; WAIT_L(0); MMA(0, 1, At, B1); BAR;
    LDA_(At, 0, 1); STAGE(SA(0, 0), A, LDA, 0, t + 2, sofa);
    BAR; WAIT_L(0); MMA(1, 0, At, B0); BAR; SCHED;
    STAGE(SB(0, 1), Bt, LDB, G_HALF, t + 2, sofb);
    WAIT_V(6); BAR; MMA(1, 1, At, B1); BAR;
    LDB_(B0, 1, 0); SCHED; LDA_(At, 1, 0); STAGE(SA(0, 1), A, LDA, G_HALF, t + 2, sofa);
    WAIT_L(8); BAR; WAIT_L(0); MMA(0, 0, At, B0); BAR; SCHED;
    LDB_(B1, 1, 1); STAGE(SB(1, 0), Bt, LDB, 0, t + 3, sofb);
    BAR; WAIT_L(0); MMA(0, 1, At, B1); BAR;
    LDA_(At, 1, 1); STAGE(SA(1, 0), A, LDA, 0, t + 3, sofa);
    BAR; WAIT_L(0); MMA(1, 0, At, B0); BAR; SCHED;
    STAGE(SB(1, 1), Bt, LDB, G_HALF, t + 3, sofb);
    WAIT_V(6); BAR; MMA(1, 1, At, B1); BAR;
  }
  { LDB_(B0, 0, 0); LDA_(At, 0, 0); STAGE(SA(1, 1), A, LDA, G_HALF, nt - 1, sofa);
    BAR; WAIT_L(0); MMA(0, 0, At, B0); BAR;
    LDB_(B1, 0, 1); BAR; WAIT_L(0); MMA(0, 1, At, B1); BAR;
    LDA_(At, 0, 1); WAIT_V(4); BAR; WAIT_L(0); MMA(1, 0, At, B0); MMA(1, 1, At, B1); BAR; }
  { LDB_(B0, 1, 0); LDA_(At, 1, 0); WAIT_V(2); BAR; WAIT_L(0); MMA(0, 0, At, B0); BAR;
    LDB_(B1, 1, 1); WAIT_V(0); BAR; WAIT_L(0); MMA(0, 1, At, B1); BAR;
    LDA_(At, 1, 1); BAR; WAIT_L(0); MMA(1, 0, At, B0); MMA(1, 1, At, B1); BAR; }
  if (wr == 0) BAR;
#undef SA
#undef SB
#undef STAGE
#undef LDA_
#undef LDB_
#undef MMA
#undef WAIT_V
#undef WAIT_L
#undef BAR
#undef SCHED
}

DI int sched_tile(int it, int MT, int NT, int& mt, int& nt) {
  const int G = gridDim.x, b = blockIdx.x;
  const int per = G >> 3, pm = per >> 2;
  const int nfull = NT >> 2, w = NT & 3;
  if ((G & 31) == 0 && pm > 0 && (MT % pm) == 0 && w != 3 && (w == 0 || (MT % (per / w)) == 0)) {
    const int x = g_sched[0], j = g_sched[1];
    const int nsm = MT / pm;
    const int nmain = nsm * nfull;
    const int pm2 = w ? per / w : 1;
    const int ntail = w ? MT / pm2 : 0;
    const int st = it * 8 + x;
    if (st >= nmain + ntail) return -1;
    if (st < nmain) {
      const int sm = st / nfull, sn = st - sm * nfull;
      mt = sm * pm + (j % pm); nt = sn * 4 + (j / pm);
    } else {
      const int s2 = st - nmain;
      mt = s2 * pm2 + (j % pm2); nt = nfull * 4 + (j / pm2);
    }
    return 1;
  } else {
    const int tile = it * G + b;
    if (tile >= MT * NT) return -1;
    nt = tile % NT; mt = tile / NT;
    return 1;
  }
}

#define EPI_IDS const int tid = otid(), lane = tid & 63, wid = owid(tid), wr = wid >> 2, wc = wid & 3, fr = lane & 15, fq = lane >> 4; (void)wr; (void)wc; (void)fr; (void)fq;
#define LROW(ai, m, j) ((ai) * 128 + (m) * 16 + (j))
#define LCOL(bj, n) ((bj) * 128 + (n) * 16)
#define EPI_FOR _Pragma("unroll") for (int ai = 0; ai < 2; ++ai) _Pragma("unroll") for (int bj = 0; bj < 2; ++bj) \
    _Pragma("unroll") for (int m = 0; m < 4; ++m) _Pragma("unroll") for (int n = 0; n < 2; ++n) _Pragma("unroll") for (int j = 0; j < 4; ++j)

constexpr int EPW = 260;
DI void epi_stage(const acc8p_t& acc, int ai, char* smem, int wr, int wc, int fr, int fq) {
  float* L = (float*)smem + (wr * 64 + fq * 4) * EPW + wc * 32 + fr;
#pragma unroll
  for (int bj = 0; bj < 2; ++bj)
#pragma unroll
    for (int m = 0; m < 4; ++m)
#pragma unroll
      for (int n = 0; n < 2; ++n)
#pragma unroll
        for (int j = 0; j < 4; ++j) L[(m * 16 + j) * EPW + bj * 128 + n * 16] = acc[ai][bj][m][n][j];
}
DI void epi_rmw_f32(char* smem, float* out, const float* res, int mt, int nt, int ai, float scale, int tid) {
  const float* L = (const float*)smem;
#pragma unroll
  for (int hb = 0; hb < 2; ++hb) {
    float4 r[8];
#pragma unroll
    for (int i = 0; i < 8; ++i) {
      const int id = tid + 512 * (hb * 8 + i); const int row = id >> 6, c4 = id & 63;
      r[i] = *(const float4*)(res + (size_t)(mt * 256 + ai * 128 + row) * D_ + nt * 256 + c4 * 4);
    }
#pragma unroll
    for (int i = 0; i < 8; ++i) {
      const int id = tid + 512 * (hb * 8 + i); const int row = id >> 6, c4 = id & 63;
      const float4 a = *(const float4*)(L + row * EPW + c4 * 4);
      float4 o; o.x = r[i].x + scale * a.x; o.y = r[i].y + scale * a.y; o.z = r[i].z + scale * a.z; o.w = r[i].w + scale * a.w;
      *(float4*)(out + (size_t)(mt * 256 + ai * 128 + row) * D_ + nt * 256 + c4 * 4) = o;
    }
  }
}
template <bool ACCUM>
DI void epi_gate_bf16(char* smem, bf16_t* MG, const bf16_t* GT, int gcol0, int mt, int nt, int ai, int tid) {
  const float* L = (const float*)smem;
  u32x4 gt[8], old[8];
#pragma unroll
  for (int i = 0; i < 8; ++i) {
    const int id = tid + 512 * i; const int row = id >> 5, c8 = id & 31;
    const size_t grow = (size_t)(mt * 256 + ai * 128 + row);
    gt[i] = *(const u32x4*)(GT + grow * 2048 + gcol0 + nt * 256 + c8 * 8);
    if (ACCUM) old[i] = *(const u32x4*)(MG + grow * D_ + nt * 256 + c8 * 8);
  }
#pragma unroll
  for (int i = 0; i < 8; ++i) {
    const int id = tid + 512 * i; const int row = id >> 5, c8 = id & 31;
    const size_t grow = (size_t)(mt * 256 + ai * 128 + row);
    const float4 a0 = *(const float4*)(L + row * EPW + c8 * 8), a1 = *(const float4*)(L + row * EPW + c8 * 8 + 4);
    const float av[8] = {a0.x, a0.y, a0.z, a0.w, a1.x, a1.y, a1.z, a1.w};
    u32x4 o;
#pragma unroll
    for (int k = 0; k < 4; ++k) {
      float v0 = bflo(gt[i][k]) * av[2 * k], v1 = bfhi(gt[i][k]) * av[2 * k + 1];
      if (ACCUM) { v0 += bflo(old[i][k]); v1 += bfhi(old[i][k]); }
      o[k] = pack2(v0, v1);
    }
    *(u32x4*)(MG + grow * D_ + nt * 256 + c8 * 8) = o;
  }
}

DI void phase_ffn_gu(const Params& p, size_t woff, char* smem) {
  const bf16_t* H = (const bf16_t*)(p.ws + OFF_H);
  const bf16_t* W = (const bf16_t*)(p.ws + OFF_WB) + woff;
  bf16_t* U = (bf16_t*)(p.ws + OFF_PA);
  for (int it = 0;; ++it) {
    int mt, nt; int s = sched_tile(it, 128, 22, mt, nt);
    if (s < 0) break; if (s == 0) continue;
    acc8p_t acc;
    gemm8p<D_, D_, 16>(H + (size_t)mt * 256 * D_, W + (size_t)nt * 256 * D_, smem, acc);
    EPI_IDS
    bf16_t* tp = U + (size_t)(mt * 256) * FF + nt * 128;
    const unsigned loff = (unsigned)((wr * 64 + fq * 4) * FF + wc * 32 + fr);
#pragma unroll
    for (int ai = 0; ai < 2; ++ai)
#pragma unroll
      for (int m = 0; m < 4; ++m)
#pragma unroll
        for (int n = 0; n < 2; ++n)
#pragma unroll
          for (int j = 0; j < 4; ++j) {
            float gv = acc[ai][0][m][n][j], uv = acc[ai][1][m][n][j];
            float sv = gv * frcp(1.f + fexp2(-LOG2E * gv)) * uv;
            (tp + LROW(ai, m, j) * FF + n * 16)[loff] = (bf16_t)f2bf(sv);
          }
  }
}

DI void phase_ffn_down(const Params& p, size_t woff, const float* res, char* smem) {
  const bf16_t* U = (const bf16_t*)(p.ws + OFF_PA);
  const bf16_t* W = (const bf16_t*)(p.ws + OFF_WB) + woff;
  float* out = p.out;
  for (int it = 0;; ++it) {
    int mt, nt; int s = sched_tile(it, 128, 4, mt, nt);
    if (s < 0) break; if (s == 0) continue;
    acc8p_t acc;
    gemm8p<FF, FF, 44>(U + (size_t)mt * 256 * FF, W + (size_t)nt * 256 * FF, smem, acc);
    EPI_IDS
#pragma unroll
    for (int ai = 0; ai < 2; ++ai) {
      epi_stage(acc, ai, smem, wr, wc, fr, fq);
      __syncthreads();
      epi_rmw_f32(smem, out, res, mt, nt, ai, 0.5f, tid);
      __syncthreads();
    }
  }
}

DI void phase_win(const Params& p, char* smem) {
  const bf16_t* H = (const bf16_t*)(p.ws + OFF_H);
  const bf16_t* W = (const bf16_t*)(p.ws + OFF_WB) + WIN;
  bf16_t* PA = (bf16_t*)(p.ws + OFF_PA);
  bf16_t* VT = (bf16_t*)(p.ws + OFF_VT);
  bf16_t* GT = (bf16_t*)(p.ws + OFF_GATES);
  float* WI = (float*)(p.ws + OFF_WIDX);
  for (int it = 0;; ++it) {
    int mt, nt; int s = sched_tile(it, 128, 16, mt, nt);
    if (s < 0) break; if (s == 0) continue;
    acc8p_t acc;
    gemm8p<D_, D_, 16>(H + (size_t)mt * 256 * D_, W + (size_t)nt * 256 * D_, smem, acc);
    EPI_IDS
    if (nt < 6) {
      bf16_t* tp = PA + (size_t)(mt * 256) * PA_LD + nt * 256;
      const unsigned loff = (unsigned)((wr * 64 + fq * 4) * PA_LD + wc * 32 + fr);
      const float qsc = (nt == 2 || nt == 3) ? 0.125f * LOG2E : 1.f;
      EPI_FOR {
        const int ro = LROW(ai, m, j) * PA_LD + LCOL(bj, n);
        (tp + ro)[loff] = (bf16_t)f2bf(acc[ai][bj][m][n][j] * qsc);
      }
    } else if (nt < 8) {
      const int b = mt >> 4;
#pragma unroll
      for (int ai = 0; ai < 2; ++ai)
#pragma unroll
        for (int bj = 0; bj < 2; ++bj)
#pragma unroll
          for (int m = 0; m < 4; ++m)
#pragma unroll
            for (int n = 0; n < 2; ++n) {
              int c = (nt - 6) * 256 + bj * 128 + wc * 32 + n * 16 + fr;
              int h = c >> 6, d = c & 63;
              int tok = mt * 256 + ai * 128 + wr * 64 + m * 16 + fq * 4;
              bf16_t* dst = VT + ((size_t)(b * 8 + h) * 64 + d) * S_ + (tok & (S_ - 1));
              u32x2 w; w[0] = pack2(acc[ai][bj][m][n][0], acc[ai][bj][m][n][1]); w[1] = pack2(acc[ai][bj][m][n][2], acc[ai][bj][m][n][3]);
              *(u32x2*)dst = w;
            }
    } else if (nt < 16) {
      bf16_t* tp = GT + (size_t)(mt * 256) * 2048 + (nt - 8) * 256;
      const unsigned loff = (unsigned)((wr * 64 + fq * 4) * 2048 + wc * 32 + fr);
      EPI_FOR {
        const int ro = LROW(ai, m, j) * 2048 + LCOL(bj, n);
        float v = acc[ai][bj][m][n][j];
        float sg = frcp(1.f + fexp2(-LOG2E * v));
        (tp + ro)[loff] = (bf16_t)f2bf(sg);
      }
    }
  }
}

DI void phase_qproj(const Params& p, char* smem) {
  bf16_t* PA = (bf16_t*)(p.ws + OFF_PA);
  const bf16_t* W = (const bf16_t*)(p.ws + OFF_WB) + WQ;
  bf16_t* QA = (bf16_t*)(p.ws + OFF_H);
  bf16_t* QI = QA + (size_t)T_ * 512;
  const float2* ROPE = (const float2*)(p.ws + OFF_ROPE);
  float* rstd = (float*)(smem + 131072);
  for (int it = 0;; ++it) {
    int mt, nt; int s = sched_tile(it, 128, 4, mt, nt);
    if (s < 0) break; if (s == 0) continue;
    acc8p_t acc;
    gemm8p<PA_LD, 256, 4>(PA + (size_t)mt * 256 * PA_LD, W + (size_t)nt * 256 * 256, smem, acc);
    {
      const int tq = otid(); int row = tq >> 1, half = tq & 1;
      const bf16_t* src = PA + (size_t)(mt * 256 + row) * PA_LD + half * 128;
      float ss = 0.f;
#pragma unroll 4
      for (int i = 0; i < 16; ++i) {
        u32x4 v = *(const u32x4*)(src + i * 8);
#pragma unroll
        for (int j = 0; j < 4; ++j) { float a = bflo(v[j]), b = bfhi(v[j]); ss += a * a + b * b; }
      }
      ss += __shfl_xor(ss, 1);
      if (half == 0) rstd[row] = rsqrtf(ss * (1.f / 256.f) + EPS);
    }
    __syncthreads();
    EPI_IDS
    const int head = (nt & 1) * 4 + wc;
    bf16_t* dtp = (nt < 2 ? QA : QI) + (size_t)(mt * 256) * 512 + head * 64;
    const float2* rtp = ROPE + (size_t)(mt * 256) * 32;
    const unsigned doff = (unsigned)((wr * 64 + fq * 4) * 512 + fr);
    const unsigned roff = (unsigned)((wr * 64 + fq * 4) * 32 + fr);
    const float* rsl = rstd + wr * 64 + fq * 4;
    float ga[4] = {1.f, 1.f, 1.f, 1.f};
    const bool do_norm = nt < 2;
    if (do_norm) { ga[0] = p.g_qa[fr]; ga[1] = p.g_qa[16 + fr]; ga[2] = p.g_qa[32 + fr]; ga[3] = p.g_qa[48 + fr]; }
#pragma unroll
    for (int ai = 0; ai < 2; ++ai)
#pragma unroll
      for (int m = 0; m < 4; ++m)
#pragma unroll
        for (int j = 0; j < 4; ++j) {
          const int lr = LROW(ai, m, j);
          const float rs = rsl[lr];
          float x0 = acc[ai][0][m][0][j] * rs, x1 = acc[ai][0][m][1][j] * rs;
          float y0 = acc[ai][1][m][0][j] * rs, y1 = acc[ai][1][m][1][j] * rs;
          if (do_norm) {
            float ss = x0 * x0 + x1 * x1 + y0 * y0 + y1 * y1;
#pragma unroll
            for (int o = 8; o > 0; o >>= 1) ss += __shfl_xor(ss, o);
            const float r2 = rsqrtf(ss * (1.f / 64.f) + EPS);
            x0 *= r2 * ga[0]; x1 *= r2 * ga[1]; y0 *= r2 * ga[2]; y1 *= r2 * ga[3];
          }
          const float2 c0 = (rtp + lr * 32)[roff], c1 = (rtp + lr * 32 + 16)[roff];
          bf16_t* dp = dtp + lr * 512;
          (dp)[doff] = (bf16_t)f2bf(x0 * c0.x - y0 * c0.y);
          (dp + 32)[doff] = (bf16_t)f2bf(x0 * c0.y + y0 * c0.x);
          (dp + 16)[doff] = (bf16_t)f2bf(x1 * c1.x - y1 * c1.y);
          (dp + 48)[doff] = (bf16_t)f2bf(x1 * c1.y + y1 * c1.x);
          if (j == 3) __builtin_amdgcn_sched_barrier(0);
        }
    __syncthreads();
  }
  const int tid = otid(), lane = tid & 63, wid = owid(tid);
  for (int it = blockIdx.x; it < T_ / 64; it += gridDim.x) {
    const int d = lane & 31; const bool isidx = lane >= 32;
    const float g0 = isidx ? 1.f : p.g_ka[d], g1 = isidx ? 1.f : p.g_ka[d + 32];
    for (int i = 0; i < 8; ++i) {
      int tok = it * 64 + wid * 8 + i;
      bf16_t* src = PA + (size_t)tok * PA_LD + (isidx ? PA_KI : PA_KA);
      float v0 = bf2f(src[d]), v1 = bf2f(src[d + 32]);
      float ss = v0 * v0 + v1 * v1;
#pragma unroll
      for (int o = 16; o > 0; o >>= 1) ss += __shfl_xor(ss, o);
      if (!isidx) { float r2 = rsqrtf(ss * (1.f / 64.f) + EPS); v0 *= r2 * g0; v1 *= r2 * g1; }
      float2 cs = ROPE[(size_t)tok * 32 + d];
      float o0 = v0 * cs.x - v1 * cs.y, o1 = v0 * cs.y + v1 * cs.x;
      src[d] = (bf16_t)f2bf(o0); src[d + 32] = (bf16_t)f2bf(o1);
    }
  }
}

DI f32x16 sb_qk(const char* cur, int sub, int r, int g, int sw, const bf16x8 (&qf)[4]) {
  f32x16 z;
#pragma unroll
  for (int i = 0; i < 16; ++i) z[i] = 0.f;
#pragma unroll
  for (int ks = 0; ks < 4; ++ks) {
    bf16x8 kf = ld_frag_s(cur + (sub * 32 + r) * 128 + (((ks * 2 + g) ^ sw) << 4));
    z = MFMA32(kf, qf[ks], z);
  }
  return z;
}
template <bool DIAG>
DI void sb_elem(const f32x16& z, int r, int g, float& R, bf16x8& pf0, bf16x8& pf1) {
  float e[16], rr[16];
#pragma unroll
  for (int i = 0; i < 16; ++i) {
    float z2 = fminf(z[i], 80.f);
    float ev = fexp2(z2);
    float rv_ = frcp(1.f + ev);
    if (DIAG && !(crow(i, g) < r)) { ev = 0.f; rv_ = 1.f; }
    e[i] = ev; rr[i] = rv_;
  }
  float G[4], Gp[4];
#pragma unroll
  for (int q = 0; q < 4; ++q) {
    rr[4 * q + 2] *= rr[4 * q + 3];
    rr[4 * q + 1] *= rr[4 * q + 2];
    rr[4 * q + 0] *= rr[4 * q + 1];
    G[q] = rr[4 * q];
  }
#pragma unroll
  for (int q = 0; q < 4; ++q) Gp[q] = __shfl_xor(G[q], 32);
  float SO[4], SP[4];
  SO[3] = 1.f; SO[2] = G[3]; SO[1] = G[2] * G[3]; SO[0] = G[1] * SO[1];
  SP[3] = 1.f; SP[2] = Gp[3]; SP[1] = Gp[2] * Gp[3]; SP[0] = Gp[1] * SP[1];
  float a[16];
#pragma unroll
  for (int q = 0; q < 4; ++q) {
    float part = g == 0 ? SP[q] * Gp[q] : SP[q];
    float E = SO[q] * part * R;
#pragma unroll
    for (int j = 0; j < 4; ++j) a[4 * q + j] = e[4 * q + j] * rr[4 * q + j] * E;
  }
  R = R * (SO[0] * G[0]) * (SP[0] * Gp[0]);
  u32x4 pw0, pw1;
#pragma unroll
  for (int j = 0; j < 4; ++j) { pw0[j] = pack2(a[2 * j], a[2 * j + 1]); pw1[j] = pack2(a[8 + 2 * j], a[8 + 2 * j + 1]); }
  pf0 = __builtin_bit_cast(bf16x8, pw0); pf1 = __builtin_bit_cast(bf16x8, pw1);
}
DI void sb_pv(const char* cur, int sub, int r, int g, const bf16x8& pf0, const bf16x8& pf1, f32x16& o0, f32x16& o1) {
#pragma unroll
  for (int ks2 = 0; ks2 < 2; ++ks2) {
    const bf16x8 pf = ks2 == 0 ? pf0 : pf1;
#pragma unroll
    for (int dt = 0; dt < 2; ++dt) {
      const char* vp = cur + 8192 + (dt * 32 + r) * 136 + (sub * 32 + 16 * ks2 + 4 * g) * 2;
      u32x2 lo = *(const u32x2*)vp, hi = *(const u32x2*)(vp + 16);
      u32x4 vv; vv[0] = lo[0]; vv[1] = lo[1]; vv[2] = hi[0]; vv[3] = hi[1];
      bf16x8 vf = __builtin_bit_cast(bf16x8, vv);
      if (dt == 0) o0 = MFMA32(vf, pf, o0); else o1 = MFMA32(vf, pf, o1);
    }
  }
}

template <bool DUMMY>
DI void sb_item(const Params& p, int b, int h, int qb, char* smem) {
  bf16_t* PA = (bf16_t*)(p.ws + OFF_PA);
  const bf16_t* VT = (const bf16_t*)(p.ws + OFF_VT) + (size_t)(b * 8 + h) * 64 * S_;
  const int tid = otid(), lane = tid & 63, wid = owid(tid), g = lane >> 5, r = lane & 31;
  const int tw = qb * 256 + wid * 32;
  constexpr int BUFSZ = 8192 + 8704;
  bf16x8 qf[4];
  {
    const bf16_t* qp = PA + (size_t)(b * S_ + tw + r) * PA_LD + PA_QB + h * 64 + g * 8;
#pragma unroll
    for (int ks = 0; ks < 4; ++ks) qf[ks] = ld_frag_g(qp + ks * 16);
  }
  const int srow = tid >> 3, sch = tid & 7;
  const bf16_t* gk = PA + (size_t)(b * S_ + srow) * PA_LD + PA_KB + h * 64 + sch * 8;
  const bf16_t* gv = VT + (size_t)srow * S_ + sch * 8;
  const unsigned k_st = srow * 128 + ((sch ^ ((srow >> 1) & 7)) << 4);
  const unsigned v_st = 8192 + srow * 136 + sch * 16;
  const int sw = (lane >> 1) & 7;
  f32x16 o0, o1;
#pragma unroll
  for (int i = 0; i < 16; ++i) { o0[i] = 0.f; o1[i] = 0.f; }
  float R = 1.f;
  const int nkt = 4 * qb + 4;
  u32x4 rk, rv;
  {
    int kt = nkt - 1;
    rk = *(const u32x4*)(gk + (size_t)(kt * 64) * PA_LD); rv = *(const u32x4*)(gv + kt * 64);
    char* cur = smem + (kt & 1) * BUFSZ;
    *(u32x4*)(cur + k_st) = rk;
    u32x2 lo, hi; lo[0] = rv[0]; lo[1] = rv[1]; hi[0] = rv[2]; hi[1] = rv[3];
    *(u32x2*)(cur + v_st) = lo; *(u32x2*)(cur + v_st + 8) = hi;
  }
  __syncthreads();
  for (int kt = nkt - 1; kt >= 0; --kt) {
    const char* cur = smem + (kt & 1) * BUFSZ;
    char* nxt = smem + ((kt + 1) & 1) * BUFSZ;
    const bool more = kt > 0;
    if (more) { rk = *(const u32x4*)(gk + (size_t)((kt - 1) * 64) * PA_LD); rv = *(const u32x4*)(gv + (kt - 1) * 64); }
    __builtin_amdgcn_sched_barrier(0);
    if (kt * 64 + 32 < tw) {
      const f32x16 z1 = sb_qk(cur, 1, r, g, sw, qf);
      const f32x16 z0 = sb_qk(cur, 0, r, g, sw, qf);
      bf16x8 p1a, p1b, p0a, p0b;
      sb_elem<false>(z1, r, g, R, p1a, p1b);
      sb_pv(cur, 1, r, g, p1a, p1b, o0, o1);
      sb_elem<false>(z0, r, g, R, p0a, p0b);
      sb_pv(cur, 0, r, g, p0a, p0b, o0, o1);
    } else {
#pragma unroll
      for (int sub = 1; sub >= 0; --sub) {
        const int sbase = kt * 64 + sub * 32;
        if (sbase <= tw) {
          const f32x16 z = sb_qk(cur, sub, r, g, sw, qf);
          bf16x8 pa, pb;
          if (sbase == tw) sb_elem<true>(z, r, g, R, pa, pb); else sb_elem<false>(z, r, g, R, pa, pb);
          sb_pv(cur, sub, r, g, pa, pb, o0, o1);
        }
      }
    }
    __builtin_amdgcn_sched_barrier(0);
    if (more) {
      *(u32x4*)(nxt + k_st) = rk;
      u32x2 lo, hi; lo[0] = rv[0]; lo[1] = rv[1]; hi[0] = rv[2]; hi[1] = rv[3];
      *(u32x2*)(nxt + v_st) = lo; *(u32x2*)(nxt + v_st + 8) = hi;
    }
    __syncthreads();
  }
  bf16_t* yp = DUMMY ? (bf16_t*)(p.ws + OFF_SLAB) + (size_t)(b * S_ + tw + r) * 512 + h * 64 : PA + (size_t)(b * S_ + tw + r) * PA_LD + PA_QB + h * 64;
#pragma unroll
  for (int rq = 0; rq < 4; ++rq) {
    u32x2 w0, w1;
    w0[0] = pack2(o0[4 * rq], o0[4 * rq + 1]); w0[1] = pack2(o0[4 * rq + 2], o0[4 * rq + 3]);
    w1[0] = pack2(o1[4 * rq], o1[4 * rq + 1]); w1[1] = pack2(o1[4 * rq + 2], o1[4 * rq + 3]);
    *(u32x2*)(yp + 8 * rq + 4 * g) = w0;
    *(u32x2*)(yp + 32 + 8 * rq + 4 * g) = w1;
  }
}

DI unsigned tokey(float f) { unsigned u = __float_as_uint(f); return (u & 0x80000000u) ? ~u : (u | 0x80000000u); }
DI int wave_count_sum(int c) {
  int tot = 0;
#pragma unroll
  for (int bt = 0; bt < 7; ++bt) tot += __builtin_popcountll(__ballot((c >> bt) & 1)) << bt;
  return tot;
}

DI void idx_item(const Params& p, int b, int qt, char* smem) {
  bf16_t* PA = (bf16_t*)(p.ws + OFF_PA);
  const bf16_t* QI = (const bf16_t*)(p.ws + OFF_H) + (size_t)T_ * 512;
  const float* WI = (const float*)(p.ws + OFF_WIDX);
  float* slab = (float*)(p.ws + OFF_SLAB) + (size_t)blockIdx.x * 16 * 4096;
  const int tid = otid(), lane = tid & 63, wid = owid(tid), g4 = lane >> 4, r = lane & 15;
  const int t0 = qt * 16;
  {
    bf16x8 qf[8][2]; float w[8];
    const bf16_t* qp = QI + (size_t)(b * S_ + t0 + r) * 512 + g4 * 8;
#pragma unroll
    for (int hh = 0; hh < 8; ++hh) { qf[hh][0] = ld_frag_g(qp + hh * 64); qf[hh][1] = ld_frag_g(qp + hh * 64 + 32); }
    {
      const float4* wp = (const float4*)(WI + (size_t)(b * S_ + t0 + r) * 8);
      float4 wa = wp[0], wb = wp[1];
      w[0] = wa.x; w[1] = wa.y; w[2] = wa.z; w[3] = wa.w; w[4] = wb.x; w[5] = wb.y; w[6] = wb.z; w[7] = wb.w;
    }
    const int nkt = qt + 1;
    const bf16_t* kbase = PA + (size_t)(b * S_ + r) * PA_LD + PA_KI + g4 * 8;
    bf16x8 k0, k1;
    {
      int kt = wid < nkt ? wid : 0;
      const bf16_t* kp = kbase + (size_t)(kt * 16) * PA_LD;
      k0 = ld_frag_g(kp); k1 = ld_frag_g(kp + 32);
    }
    for (int kt = wid; kt < nkt; kt += NWAVE) {
      bf16x8 n0, n1;
      {
        int kn = kt + NWAVE < nkt ? kt + NWAVE : kt;
        const bf16_t* kp = kbase + (size_t)(kn * 16) * PA_LD;
        n0 = ld_frag_g(kp); n1 = ld_frag_g(kp + 32);
      }
      f32x4 sc = {0.f, 0.f, 0.f, 0.f};
#pragma unroll
      for (int hh = 0; hh < 8; ++hh) {
        f32x4 c = {0.f, 0.f, 0.f, 0.f};
        c = MFMA16(k0, qf[hh][0], c);
        c = MFMA16(k1, qf[hh][1], c);
#pragma unroll
        for (int i = 0; i < 4; ++i) sc[i] += w[hh] * fmaxf(c[i], 0.f);
      }
      *(f32x4*)(slab + (size_t)r * 4096 + kt * 16 + 4 * g4) = sc;
      k0 = n0; k1 = n1;
    }
  }
  __syncthreads();
  for (int qi = 0; qi < 2; ++qi) {
    const int q = wid * 2 + qi;
    const int t = t0 + q, n = t + 1;
    unsigned short* out = (unsigned short*)(PA + (size_t)(b * S_ + t) * PA_LD);
    if (n <= 256) {
#pragma unroll
      for (int j = 0; j < 4; ++j) { int e = j * 64 + lane; out[e] = (unsigned short)(e < n ? e : 0); }
      continue;
    }
    const float* row = slab + (size_t)q * 4096 + lane;
    const int nj = (n + 63) >> 6;
    unsigned key[64];
#pragma unroll
    for (int ch = 0; ch < 4; ++ch) {
#pragma unroll
      for (int jj = 0; jj < 16; ++jj) key[ch * 16 + jj] = 0xff800000u;
      if (nj > ch * 16) {
#pragma unroll
        for (int jj = 0; jj < 16; ++jj) { const int j = ch * 16 + jj; if (j * 64 + lane < n) key[j] = __float_as_uint(row[j * 64]); }
      }
    }
    __builtin_amdgcn_sched_barrier(0);
#pragma unroll
    for (int j = 0; j < 64; ++j) key[j] = (j * 64 + lane < n) ? tokey(__uint_as_float(key[j])) : 0u;
    unsigned Tthr = 0u; int need = 0; bool exact = false;
    for (int bit = 31; bit >= 0; --bit) {
      const unsigned cand = Tthr | (1u << bit);
      int c = 0;
#pragma unroll
      for (int ch = 0; ch < 4; ++ch) {
        if (nj > ch * 16) {
#pragma unroll
          for (int jj = 0; jj < 16; ++jj) c += (key[ch * 16 + jj] >= cand) ? 1 : 0;
        }
      }
      const int cnt = wave_count_sum(c);
      if (cnt >= 256) Tthr = cand;
      if (cnt == 256) { exact = true; break; }
    }
    unsigned Tgt;
    if (exact) { Tgt = Tthr - 1u; need = 0; }
    else {
      int c = 0;
#pragma unroll
      for (int j = 0; j < 64; ++j) c += (key[j] > Tthr) ? 1 : 0;
      Tgt = Tthr; need = 256 - wave_count_sum(c);
    }
    const unsigned long long lt_mask = (1ull << lane) - 1ull;
    int base = 0, ties = 0;
#pragma unroll
    for (int j = 0; j < 64; ++j) {
      if (j < nj) {
        const bool gt = key[j] > Tgt;
        const bool eq = (!exact) && (key[j] == Tthr);
        const unsigned long long meq = __ballot(eq);
        const int myrank = ties + __builtin_popcountll(meq & lt_mask);
        const bool sel = gt || (eq && myrank < need);
        ties += __builtin_popcountll(meq);
        const unsigned long long ms = __ballot(sel);
        const int pos = base + __builtin_popcountll(ms & lt_mask);
        if (sel && pos < 256) out[pos] = (unsigned short)(j * 64 + lane);
        base += __builtin_popcountll(ms);
      }
    }
  }
  __syncthreads();
}

DI void phase_sb_dummy(const Params& p, char* smem) {
  unsigned* cnt = (unsigned*)(p.ws + OFF_CNT) + 16;
  int* s_item = (int*)(smem + SMEM_BYTES - 16);
  while (true) {
    if (otid() == 0) *s_item = (int)atomicAdd(cnt, 1u);
    __syncthreads();
    const int item = *s_item;
    __syncthreads();
    if (item >= 64 * 16) break;
    int qb = 15 - (item >> 6), bh = item & 63;
    sb_item<true>(p, bh >> 3, bh & 7, qb, smem);
  }
}

template <bool IDX_ONLY>
DI void phase_mix(const Params& p, char* smem) {
  unsigned* cnt = (unsigned*)(p.ws + OFF_CNT) + (IDX_ONLY ? 8 : 0);
  int* s_item = (int*)(smem + SMEM_BYTES - 16);
  constexpr int NSB = 64 * 16, NIDX = 8 * 256;
  while (true) {
    if (otid() == 0) *s_item = (int)atomicAdd(cnt, 1u);
    __syncthreads();
    const int item = *s_item;
    __syncthreads();
    if (IDX_ONLY) { if (item >= NIDX) break; int qt = 255 - (item >> 3), b = item & 7; idx_item(p, b, qt, smem); continue; }
    if (item >= NSB + NIDX) break;
    if (item < NSB) {
      int qb = 15 - (item >> 6), bh = item & 63;
      sb_item<false>(p, bh >> 3, bh & 7, qb, smem);
    } else {
      int j = item - NSB;
      int qt = 255 - (j >> 3), b = j & 7;
      idx_item(p, b, qt, smem);
    }
  }
}

DI void phase_sparse(const Params& p, char* smem) {
  const bf16_t* PA = (const bf16_t*)(p.ws + OFF_PA);
  const bf16_t* QA = (const bf16_t*)(p.ws + OFF_H);
  bf16_t* YA = (bf16_t*)(p.ws + OFF_SLAB + (size_t)64 * 1024 * 1024);
  const bf16_t* WUVb = (const bf16_t*)(p.ws + OFF_WB) + WUV;
  const int tid = otid(), lane = tid & 63, wid = owid(tid), g4 = lane >> 4, c = lane & 15;
  constexpr int WST = 10304;
  char* Vl = smem + wid * WST;
  int* Il = (int*)(smem + wid * WST + 9216);
  char* OL = smem + 8 * WST;
  const float sc2 = 0.125f * LOG2E;
  typedef __attribute__((address_space(3))) s16x4 lds_s16x4;
  for (int it = blockIdx.x; it < T_ / 16; it += gridDim.x) {
    const int tok0 = it * 16;
    const int b = tok0 >> 12;
#pragma nounroll
    for (int qi = 0; qi < 2; ++qi) {
      const int q = wid * 2 + qi;
      const int tok = tok0 + q, t = tok & (S_ - 1);
      const int nsel = t + 1 < 256 ? t + 1 : 256;
      const unsigned short* irow = (const unsigned short*)(PA + (size_t)tok * PA_LD);
#pragma unroll
      for (int j = 0; j < 4; ++j) { int e = j * 64 + lane; int v = irow[e]; Il[e] = e < nsel ? v : 0; }
      __syncthreads();
      bf16x8 qf0, qf1;
      {
        u32x4 z4 = {0u, 0u, 0u, 0u};
        qf0 = __builtin_bit_cast(bf16x8, z4); qf1 = qf0;
        if (c < 8) { const bf16_t* qp = QA + (size_t)tok * 512 + c * 64 + g4 * 8; qf0 = ld_frag_g(qp); qf1 = ld_frag_g(qp + 32); }
      }
      f32x4 acc[8];
#pragma unroll
      for (int ct = 0; ct < 8; ++ct) acc[ct] = f32x4{0.f, 0.f, 0.f, 0.f};
      float m = -INFINITY, sum = 0.f;
      const int nch = (nsel + 31) >> 5;
      const char* kbase = (const char*)(PA + (size_t)b * S_ * PA_LD);
#pragma nounroll
      for (int ch = 0; ch < nch; ++ch) {
        u32x4 vr[8];
#pragma unroll
        for (int r8 = 0; r8 < 8; ++r8) {
          const int row = r8 * 4 + g4;
          const int key = Il[ch * 32 + row];
          vr[r8] = *(const u32x4*)(kbase + (size_t)key * (PA_LD * 2) + PA_VA * 2 + c * 16);
        }
        f32x4 cc[2];
#pragma unroll
        for (int tt = 0; tt < 2; ++tt) {
          const int key = Il[ch * 32 + tt * 16 + c];
          const bf16_t* kp = (const bf16_t*)(kbase + (size_t)key * (PA_LD * 2)) + PA_KA + g4 * 8;
          const bf16x8 ka0 = ld_frag_g(kp), ka1 = ld_frag_g(kp + 32);
          f32x4 z = {0.f, 0.f, 0.f, 0.f};
          z = MFMA16(ka0, qf0, z);
          z = MFMA16(ka1, qf1, z);
          cc[tt] = z;
        }
        float cmax = -INFINITY;
#pragma unroll
        for (int tt = 0; tt < 2; ++tt)
#pragma unroll
          for (int i = 0; i < 4; ++i) {
            const int e = ch * 32 + tt * 16 + 4 * g4 + i;
            const float v = e < nsel ? cc[tt][i] : -INFINITY;
            cc[tt][i] = v; cmax = fmaxf(cmax, v);
          }
        cmax = fmaxf(cmax, __shfl_xor(cmax, 16)); cmax = fmaxf(cmax, __shfl_xor(cmax, 32));
        const float mn = fmaxf(m, cmax);
        const float alpha = fexp2((m - mn) * sc2);
        m = mn;
        float ps = 0.f; float pv[8];
#pragma unroll
        for (int tt = 0; tt < 2; ++tt)
#pragma unroll
          for (int i = 0; i < 4; ++i) { const float e2 = fexp2((cc[tt][i] - mn) * sc2); pv[tt * 4 + i] = e2; ps += e2; }
        sum = sum * alpha + ps;
        u32x4 pw; pw[0] = pack2(pv[0], pv[1]); pw[1] = pack2(pv[2], pv[3]); pw[2] = pack2(pv[4], pv[5]); pw[3] = pack2(pv[6], pv[7]);
        const bf16x8 pf = __builtin_bit_cast(bf16x8, pw);
#pragma unroll
        for (int ct = 0; ct < 8; ++ct) acc[ct] *= alpha;
#pragma unroll
        for (int r8 = 0; r8 < 8; ++r8) *(u32x4*)(Vl + (r8 * 4 + g4) * 288 + c * 16) = vr[r8];
        {
          const int qq = c >> 2, pp = c & 3;
          const char* vb0 = Vl + (4 * g4 + qq) * 288 + pp * 8;
#pragma unroll
          for (int ct = 0; ct < 8; ++ct) {
            const s16x4 lo = __builtin_amdgcn_ds_read_tr16_b64_v4i16((lds_s16x4*)(vb0 + ct * 32));
            const s16x4 hi = __builtin_amdgcn_ds_read_tr16_b64_v4i16((lds_s16x4*)(vb0 + 16 * 288 + ct * 32));
            const bf16x8 af = __builtin_shufflevector(lo, hi, 0, 1, 2, 3, 4, 5, 6, 7);
            acc[ct] = MFMA16(af, pf, acc[ct]);
          }
        }
      }
      sum += __shfl_xor(sum, 16); sum += __shfl_xor(sum, 32);
      const float inv = 1.f / sum;
      if (c < 8) {
#pragma unroll
        for (int ct = 0; ct < 8; ++ct) {
          u32x2 w; w[0] = pack2(acc[ct][0] * inv, acc[ct][1] * inv); w[1] = pack2(acc[ct][2] * inv, acc[ct][3] * inv);
          *(u32x2*)(OL + q * 2064 + c * 256 + (ct * 16 + 4 * g4) * 2) = w;
        }
      }
      __syncthreads();
    }
    {
      const int h = wid;
      bf16x8 af[4];
#pragma unroll
      for (int ks = 0; ks < 4; ++ks) af[ks] = ld_frag_s(OL + c * 2064 + h * 256 + (ks * 32 + g4 * 8) * 2);
#pragma nounroll
      for (int nt = 0; nt < 4; ++nt) {
        f32x4 cc = {0.f, 0.f, 0.f, 0.f};
        const bf16_t* wp = WUVb + (size_t)(h * 64 + nt * 16 + c) * 128 + g4 * 8;
#pragma unroll
        for (int ks = 0; ks < 4; ++ks) cc = MFMA16(af[ks], ld_frag_g(wp + ks * 32), cc);
#pragma unroll
        for (int i = 0; i < 4; ++i) YA[(size_t)(tok0 + 4 * g4 + i) * 512 + h * 64 + nt * 16 + c] = (bf16_t)f2bf(cc[i]);
      }
    }
    __syncthreads();
  }
}

DI void phase_merge(const Params& p, char* smem) {
  const bf16_t* YA = (const bf16_t*)(p.ws + OFF_SLAB + (size_t)64 * 1024 * 1024);
  const bf16_t* YB = (const bf16_t*)(p.ws + OFF_PA) + PA_QB;
  const bf16_t* Wa = (const bf16_t*)(p.ws + OFF_WB) + WOA;
  const bf16_t* Wb = (const bf16_t*)(p.ws + OFF_WB) + WOB;
  const bf16_t* GT = (const bf16_t*)(p.ws + OFF_GATES);
  bf16_t* MG = (bf16_t*)(p.ws + OFF_SLAB);
  for (int it = 0;; ++it) {
    int mt, nt; int s = sched_tile(it, 128, 4, mt, nt);
    if (s < 0) break; if (s == 0) continue;
    acc8p_t acc;
    gemm8p<512, 512, 8>(YA + (size_t)mt * 256 * 512, Wa + (size_t)nt * 256 * 512, smem, acc);
    EPI_IDS
#pragma unroll
    for (int ai = 0; ai < 2; ++ai) {
      epi_stage(acc, ai, smem, wr, wc, fr, fq);
      __syncthreads();
      epi_gate_bf16<false>(smem, MG, GT, 0, mt, nt, ai, tid);
      __syncthreads();
    }
  }
  for (int it = 0;; ++it) {
    int mt, nt; int s = sched_tile(it, 128, 4, mt, nt);
    if (s < 0) break; if (s == 0) continue;
    acc8p_t acc;
    gemm8p<PA_LD, 512, 8>(YB + (size_t)mt * 256 * PA_LD, Wb + (size_t)nt * 256 * 512, smem, acc);
    EPI_IDS
#pragma unroll
    for (int ai = 0; ai < 2; ++ai) {
      epi_stage(acc, ai, smem, wr, wc, fr, fq);
      __syncthreads();
      epi_gate_bf16<true>(smem, MG, GT, 1024, mt, nt, ai, tid);
      __syncthreads();
    }
  }
}

DI void phase_outproj(const Params& p, char* smem) {
  const bf16_t* MG = (const bf16_t*)(p.ws + OFF_SLAB);
  const bf16_t* W = (const bf16_t*)(p.ws + OFF_WB) + WOUT;
  float* out = p.out;
  for (int it = 0;; ++it) {
    int mt, nt; int s = sched_tile(it, 128, 4, mt, nt);
    if (s < 0) break; if (s == 0) continue;
    acc8p_t acc;
    gemm8p<D_, D_, 16>(MG + (size_t)mt * 256 * D_, W + (size_t)nt * 256 * D_, smem, acc);
    EPI_IDS
#pragma unroll
    for (int ai = 0; ai < 2; ++ai) {
      epi_stage(acc, ai, smem, wr, wc, fr, fq);
      __syncthreads();
      epi_rmw_f32(smem, out, out, mt, nt, ai, 1.0f, tid);
      __syncthreads();
    }
  }
}

#define XB_TMO      128
#define XB_XCNT(j)  (256  + 64 * (j))
#define XB_XSUB(j)  (1280 + 64 * (j))
#define XB_XGEN(j)  (2304 + 64 * (j))
#define XB_TOP      3328
#define XB_TOPGEN   3392
#define XCD_BAR_WORDS 3456
#define XB_SPIN_CAP (1u << 22)
#define LAS __attribute__((address_space(3)))
DI unsigned xb_ld(unsigned* p) { return __hip_atomic_load(p, __ATOMIC_RELAXED, __HIP_MEMORY_SCOPE_AGENT); }
DI unsigned xb_add(unsigned* p, unsigned v) { return __hip_atomic_fetch_add(p, v, __ATOMIC_RELAXED, __HIP_MEMORY_SCOPE_AGENT); }
DI unsigned xb_xcc_id() { return (unsigned)__builtin_amdgcn_s_getreg((3 << 11) | 20) & 0xFu; }
#define XB_SPIN(cond, bar) do { unsigned _sp = 0; while (cond) { __builtin_amdgcn_s_sleep(1); \
    if ((++_sp & 255u) == 0u) { if (xb_ld(&(bar)[XB_TMO])) break; if (_sp > XB_SPIN_CAP) { atomicAdd(&(bar)[XB_TMO], 1u); break; } } } } while (0)
struct XcdBarrier { unsigned* bar; unsigned x; volatile LAS unsigned* st; };
DI XcdBarrier xcd_barrier_post(unsigned* bar, volatile LAS unsigned* st) {
  XcdBarrier b; b.bar = bar; b.x = xb_xcc_id(); b.st = st;
  if (threadIdx.x == 0) (void)xb_add(&bar[XB_XCNT(b.x)], 1u);
  return b;
}
DI void xcd_barrier_complete(unsigned* bar, unsigned x, unsigned& nloc, unsigned& nx) {
  const unsigned G = gridDim.x * gridDim.y * gridDim.z;
  unsigned sum, cnt, mine, sp = 0u;
  for (;;) {
    sum = 0u; cnt = 0u; mine = 0u;
#pragma unroll
    for (unsigned j = 0; j < 16; ++j) { const unsigned c = xb_ld(&bar[XB_XCNT(j)]); sum += c; cnt += (c > 0u) ? 1u : 0u; mine = (j == x) ? c : mine; }
    if (sum == G) break;
    __builtin_amdgcn_s_sleep(1);
    if ((++sp & 255u) == 0u) { if (xb_ld(&bar[XB_TMO])) break; if (sp > XB_SPIN_CAP) { atomicAdd(&bar[XB_TMO], 1u); break; } }
  }
  nloc = mine > 0u ? mine : 1u; nx = cnt > 0u ? cnt : 1u;
}
DI void xcd_barrier(const XcdBarrier& b) {
  asm volatile("s_waitcnt vmcnt(0)" ::: "memory");
  __syncthreads();
  if (threadIdx.x == 0) {
    unsigned* bar = b.bar;
    __builtin_amdgcn_s_waitcnt(0);
    unsigned nloc = b.st[0], nx = b.st[1];
    if (nloc == 0u) { xcd_barrier_complete(bar, b.x, nloc, nx); b.st[0] = nloc; b.st[1] = nx; }
    const unsigned old = xb_add(&bar[XB_XSUB(b.x)], 1u);
    const unsigned gen = old / nloc;
    if (old + 1u == (gen + 1u) * nloc) {
      __builtin_amdgcn_fence(__ATOMIC_RELEASE, "agent");
      asm volatile("s_waitcnt vmcnt(0)" ::: "memory");
      const unsigned og = xb_add(&bar[XB_TOP], 1u);
      const unsigned tg = og / nx;
      if (og + 1u == (tg + 1u) * nx) xb_add(&bar[XB_TOPGEN], 1u);
      else XB_SPIN(xb_ld(&bar[XB_TOPGEN]) == tg, bar);
      __builtin_amdgcn_fence(__ATOMIC_ACQUIRE, "agent");
      xb_add(&bar[XB_XGEN(b.x)], 1u);
      asm volatile("s_waitcnt vmcnt(0)" ::: "memory");
    } else {
      XB_SPIN(xb_ld(&bar[XB_XGEN(b.x)]) == gen, bar);
      __builtin_amdgcn_fence(__ATOMIC_ACQUIRE, "agent");
      asm volatile("s_waitcnt vmcnt(0)" ::: "memory");
    }
  }
  __syncthreads();
}

DI void run_phase(const Params& p, int ph, char* smem) {
  switch (ph) {
    case 0: phase_prep(p, smem); break;
    case 1: phase_ffn_gu(p, W1GU, smem); break;
    case 2: phase_ffn_down(p, W1D, p.x, smem); break;
    case 3: phase_rmsnorm_widx(p, smem); break;
    case 4: phase_win(p, smem); break;
    case 5: phase_qproj(p, smem); break;
    case 6: phase_mix<false>(p, smem); break;
    case 13: phase_mix<true>(p, smem); break;
    case 14: phase_sb_dummy(p, smem); break;
    case 7: phase_sparse(p, smem); break;
    case 8: phase_merge(p, smem); break;
    case 9: phase_outproj(p, smem); break;
    case 10: phase_rmsnorm(p.out, p.g_ffn2, (bf16_t*)(p.ws + OFF_H)); break;
    case 11: phase_ffn_gu(p, W2GU, smem); break;
    case 12: phase_ffn_down(p, W2D, p.out, smem); break;
  }
}
constexpr int NPHASE = 13;

#if !MULTI_LAUNCH
__global__ void __launch_bounds__(512, 2) mega_kernel(Params p) {
  __shared__ __attribute__((aligned(16))) char smem[SMEM_BYTES];
  __shared__ uint4 xb_words;
  cg::grid_group grid = cg::this_grid();
  if (threadIdx.x == 0) xb_words = make_uint4(0u, 0u, 0u, 0u);
  __syncthreads();
  XcdBarrier xb = xcd_barrier_post((unsigned*)(p.ws + OFF_CNT + 256), (volatile LAS unsigned*)&xb_words);
  unsigned* bar0 = (unsigned*)(p.ws + OFF_CNT + 256);
  if (threadIdx.x == 0) g_sched[3] = (int)xb_add(&bar0[XB_XCNT(xb.x) + 16], 1u);
  grid.sync();
  if (threadIdx.x == 0) {
    const unsigned per = gridDim.x >> 3; bool ok = (gridDim.x & 7) == 0 && xb.x < 8;
    for (unsigned jx = 0; jx < 16; ++jx) { const unsigned c = xb_ld(&bar0[XB_XCNT(jx) + 16]); ok = ok && (c == (jx < 8 ? per : 0u)); }
    g_sched[0] = ok ? (int)xb.x : (int)(blockIdx.x & 7);
    g_sched[1] = ok ? g_sched[3] : (int)(blockIdx.x >> 3);
  }
  __syncthreads();
#pragma nounroll
  for (int ph = 0; ph < NPHASE; ++ph) {
    int phv = ph; asm volatile("" : "+s"(phv));
    run_phase(p, phv, smem);
    if (ph + 1 < NPHASE) { XcdBarrier xb2; xb2.bar = (unsigned*)(p.ws + OFF_CNT + 256); xb2.x = xb_xcc_id(); xb2.st = (volatile LAS unsigned*)&xb_words; xcd_barrier(xb2); }
  }
}
#else
template <int PH>
__global__ void __launch_bounds__(512, 2) phase_kernel(Params p) {
  __shared__ __attribute__((aligned(16))) char smem[SMEM_BYTES];
  if (threadIdx.x == 0) { g_sched[0] = blockIdx.x & 7; g_sched[1] = blockIdx.x >> 3; }
  __syncthreads();
  run_phase(p, PH, smem);
}
#ifndef PROBE_MASK
#define PROBE_MASK 0
#endif
template <int PH> static void launch_phases(const Params& p, hipStream_t stream) {
  hipLaunchKernelGGL(phase_kernel<PH>, dim3(256), dim3(NTHR), 0, stream, p);
  if constexpr (((PROBE_MASK >> PH) & 1) != 0 && PH != 6) hipLaunchKernelGGL(phase_kernel<PH>, dim3(256), dim3(NTHR), 0, stream, p);
  if constexpr (((PROBE_MASK >> PH) & 1) != 0 && PH == 6) hipLaunchKernelGGL(phase_kernel<13>, dim3(256), dim3(NTHR), 0, stream, p);
  if constexpr (((PROBE_MASK >> 14) & 1) != 0 && PH == 5) hipLaunchKernelGGL(phase_kernel<14>, dim3(256), dim3(NTHR), 0, stream, p);
  if constexpr (PH + 1 < NPHASE) launch_phases<PH + 1>(p, stream);
}
#endif

extern "C" void kernel_launch(void* const* d_in, const int* in_sizes, int n_in, void* d_out, int out_size, void* d_ws,
                              size_t ws_size, hipStream_t stream) {
  Params p{};
  p.x = (const float*)d_in[0]; p.pos = (const int*)d_in[1];
  p.g_ffn1 = (const float*)d_in[2]; p.w1g = (const float*)d_in[3]; p.w1u = (const float*)d_in[4]; p.w1d = (const float*)d_in[5];
  p.g_mix = (const float*)d_in[6]; p.w_in = (const float*)d_in[7]; p.g_cq = (const float*)d_in[8]; p.w_uq = (const float*)d_in[9];
  p.w_qi = (const float*)d_in[10]; p.g_qa = (const float*)d_in[11]; p.g_ka = (const float*)d_in[12]; p.w_uv = (const float*)d_in[13];
  p.w_oa = (const float*)d_in[14]; p.w_ob = (const float*)d_in[15]; p.w_out = (const float*)d_in[16]; p.g_ffn2 = (const float*)d_in[17];
  p.w2g = (const float*)d_in[18]; p.w2u = (const float*)d_in[19]; p.w2d = (const float*)d_in[20];
  p.out = (float*)d_out; p.ws = (char*)d_ws;
  if (ws_size < WS_NEED) { fprintf(stderr, "workspace too small: %zu < %zu\n", ws_size, (size_t)WS_NEED); return; }
  (void)hipMemsetAsync((char*)d_ws + OFF_CNT, 0, 256 + 16384, stream);
#if MULTI_LAUNCH
  launch_phases<0>(p, stream);
#else
  static int grid_blocks = 0;
  if (!grid_blocks) {
    int dev = 0, cus = 0, per_cu = 0;
    (void)hipGetDevice(&dev);
    (void)hipDeviceGetAttribute(&cus, hipDeviceAttributeMultiprocessorCount, dev);
    (void)hipOccupancyMaxActiveBlocksPerMultiprocessor(&per_cu, mega_kernel, NTHR, 0);
    if (per_cu > 1) per_cu = 1;
    grid_blocks = cus * per_cu;
    if (grid_blocks > 256) grid_blocks = 256;
  }
  void* args[] = {&p};
  hipError_t e = hipLaunchCooperativeKernel((void*)mega_kernel, dim3(grid_blocks), dim3(NTHR), args, 0, stream);
  if (e != hipSuccess) fprintf(stderr, "cooperative launch failed: %s (grid %d)\n", hipGetErrorString(e), grid_blocks);
#endif
}
```

```cpp
#include <hip/hip_runtime.h>
#include <hip/hip_cooperative_groups.h>
#include <stdint.h>
#include <stdio.h>
namespace cg = cooperative_groups;

#ifndef MULTI_LAUNCH
#define MULTI_LAUNCH 0
#endif

#define DI __device__ __forceinline__
typedef unsigned short bf16_t;
typedef __attribute__((ext_vector_type(8))) short bf16x8;
typedef __attribute__((ext_vector_type(16))) float f32x16;
typedef __attribute__((ext_vector_type(4))) float f32x4;
typedef __attribute__((ext_vector_type(4))) unsigned u32x4;
typedef __attribute__((ext_vector_type(2))) unsigned u32x2;
typedef __attribute__((ext_vector_type(4))) short s16x4;

constexpr int T_ = 32768, S_ = 4096, D_ = 1024, FF = 2816;
constexpr int PA_LD = 1536;
constexpr int PA_KA = 256, PA_VA = 320, PA_KI = 448, PA_QB = 512, PA_KB = 1024;
constexpr float EPS = 1e-6f;
constexpr float LOG2E = 1.4426950408889634f;

constexpr size_t W1GU = 0;
constexpr size_t W1D = W1GU + (size_t)5632 * 1024;
constexpr size_t W2GU = W1D + (size_t)1024 * 2816;
constexpr size_t W2D = W2GU + (size_t)5632 * 1024;
constexpr size_t WIN = W2D + (size_t)1024 * 2816;
constexpr size_t WQ = WIN + (size_t)4096 * 1024;
constexpr size_t WUV = WQ + (size_t)1024 * 256;
constexpr size_t WOA = WUV + (size_t)512 * 128;
constexpr size_t WOB = WOA + (size_t)1024 * 512;
constexpr size_t WOUT = WOB + (size_t)1024 * 512;
constexpr size_t WB_ELEMS = WOUT + (size_t)1024 * 1024;
constexpr size_t OFF_WB = 0;
constexpr size_t OFF_H = (WB_ELEMS * 2 + 255) & ~(size_t)255;
constexpr size_t OFF_PA = OFF_H + (size_t)T_ * 1024 * 2;
constexpr size_t OFF_VT = OFF_PA + (size_t)T_ * PA_LD * 2;
constexpr size_t OFF_GATES = OFF_VT + (size_t)T_ * 512 * 2;
constexpr size_t OFF_SLAB = OFF_GATES + (size_t)T_ * 2048 * 2;
constexpr size_t OFF_WIDX = OFF_SLAB + (size_t)512 * 16 * 4096 * 4;
constexpr size_t OFF_ROPE = OFF_WIDX + (size_t)T_ * 8 * 4;
constexpr size_t OFF_CNT = OFF_ROPE + (size_t)T_ * 32 * 8;
constexpr size_t WS_NEED = OFF_CNT + 256 + 16384;
static_assert(WS_NEED <= (size_t)512 * 1024 * 1024, "workspace too large");
static_assert((size_t)T_ * FF * 2 <= OFF_SLAB - OFF_PA, "U must fit in PA+VT+GATES");

constexpr int SMEM_BYTES = 131072 + 2048;
__shared__ int g_sched[4];
constexpr int NTHR = 512, NWAVE = 8;

struct Params {
  const float* x; const int* pos;
  const float *g_ffn1, *w1g, *w1u, *w1d, *g_mix, *w_in, *g_cq, *w_uq, *w_qi, *g_qa, *g_ka, *w_uv, *w_oa, *w_ob, *w_out, *g_ffn2, *w2g, *w2u, *w2d;
  float* out;
  char* ws;
};

typedef __attribute__((ext_vector_type(2))) __bf16 bf16x2_t;
typedef __attribute__((ext_vector_type(2))) float f32x2_t;
DI unsigned pack2(float a, float b) { f32x2_t v = {a, b}; return __builtin_bit_cast(unsigned, __builtin_convertvector(v, bf16x2_t)); }
DI unsigned f2bf(float x) { return pack2(x, 0.f) & 0xffffu; }
DI float bf2f(unsigned v) { return __uint_as_float(v << 16); }
DI float bflo(unsigned v) { return __uint_as_float(v << 16); }
DI float bfhi(unsigned v) { return __uint_as_float(v & 0xffff0000u); }
DI float fexp2(float x) { return __builtin_amdgcn_exp2f(x); }
DI float frcp(float x) { return __builtin_amdgcn_rcpf(x); }
DI float wave_sum(float v) {
#pragma unroll
  for (int o = 32; o > 0; o >>= 1) v += __shfl_xor(v, o);
  return v;
}
#define MFMA32(a, b, c) __builtin_amdgcn_mfma_f32_32x32x16_bf16((a), (b), (c), 0, 0, 0)
#define MFMA16(a, b, c) __builtin_amdgcn_mfma_f32_16x16x32_bf16((a), (b), (c), 0, 0, 0)
DI bf16x8 ld_frag_g(const bf16_t* p) { return __builtin_bit_cast(bf16x8, *(const u32x4*)p); }
DI bf16x8 ld_frag_s(const char* p) { return __builtin_bit_cast(bf16x8, *(const u32x4*)p); }
DI int otid() { int t = threadIdx.x; asm volatile("" : "+v"(t)); return t; }
DI int owid(int tid) { return __builtin_amdgcn_readfirstlane(tid >> 6); }
DI int crow(int reg, int g) { return (reg & 3) + 8 * (reg >> 2) + 4 * g; }

DI const float* prep_col(const Params& p, int mat, int r, int& ld) {
  switch (mat) {
    case 0: case 2: {
      int j = r >> 8, q = r & 255; int half = q >> 7, c = q & 127;
      int n = j * 128 + c; ld = FF;
      const float* g = mat == 0 ? p.w1g : p.w2g; const float* u = mat == 0 ? p.w1u : p.w2u;
      return (half ? u : g) + n;
    }
    case 1: ld = D_; return p.w1d + r;
    case 3: ld = D_; return p.w2d + r;
    case 4: {
      ld = 4104;
      if (r < 512) return p.w_in + r;
      return p.w_in + r + 8;
    }
    case 5: {
      ld = 512;
      int T = r >> 8, q = r & 255; int hl = (q & 127) >> 5, d = (q >> 7) * 32 + (q & 31);
      int col = ((T & 1) * 4 + hl) * 64 + d;
      return (T < 2 ? p.w_uq : p.w_qi) + col;
    }
    case 6: { ld = 64; int h = r >> 6, d = r & 63; return p.w_uv + h * 8192 + d; }
    case 7: ld = D_; return p.w_oa + r;
    case 8: ld = D_; return p.w_ob + r;
    default: ld = D_; return p.w_out + r;
  }
}

DI void prep_transpose_tile(const Params& p, bool valid, int mat, int K, bf16_t* dst, int tile, float* lds, int t) {
  const int nkt = K >> 7;
  const int r0 = (tile / nkt) * 32, k0 = (tile % nkt) * 128;
  const int tx = t & 31, ty = t >> 5;
  if (valid) {
    int ld; const float* col = prep_col(p, mat, r0 + tx, ld);
#pragma unroll
    for (int i = 0; i < 16; ++i) {
      int k = k0 + ty + 8 * i;
      float v = 0.f;
      if (col) { v = col[(size_t)k * ld]; if (mat == 5) v *= p.g_cq[k]; }
      lds[tx * 129 + ty + 8 * i] = v;
    }
  }
  __syncthreads();
  if (valid) {
    const int row = t >> 3, kc = (t & 7) * 16;
    const float* s = lds + row * 129 + kc;
    u32x4 o0, o1;
    o0[0] = pack2(s[0], s[1]); o0[1] = pack2(s[2], s[3]); o0[2] = pack2(s[4], s[5]); o0[3] = pack2(s[6], s[7]);
    o1[0] = pack2(s[8], s[9]); o1[1] = pack2(s[10], s[11]); o1[2] = pack2(s[12], s[13]); o1[3] = pack2(s[14], s[15]);
    u32x4* d = (u32x4*)(dst + (size_t)(r0 + row) * K + k0 + kc);
    d[0] = o0; d[1] = o1;
  }
  __syncthreads();
}

DI void rmsnorm_row(const float* __restrict__ xr, const float* __restrict__ g, bf16_t* __restrict__ o) {
  const int lane = otid() & 63;
  float4 v[4]; float ss = 0.f;
#pragma unroll
  for (int j = 0; j < 4; ++j) { v[j] = *(const float4*)(xr + lane * 4 + 256 * j); ss += v[j].x * v[j].x + v[j].y * v[j].y + v[j].z * v[j].z + v[j].w * v[j].w; }
  ss = wave_sum(ss);
  const float rs = rsqrtf(ss * (1.f / 1024.f) + EPS);
#pragma unroll
  for (int j = 0; j < 4; ++j) {
    float4 gg = *(const float4*)(g + lane * 4 + 256 * j);
    u32x2 w; w[0] = pack2(v[j].x * rs * gg.x, v[j].y * rs * gg.y); w[1] = pack2(v[j].z * rs * gg.z, v[j].w * rs * gg.w);
    *(u32x2*)(o + lane * 4 + 256 * j) = w;
  }
}

DI void phase_rmsnorm(const float* __restrict__ src, const float* __restrict__ g, bf16_t* __restrict__ dst) {
  const int wid = owid(otid());
  for (int it = blockIdx.x; it < T_ / NWAVE; it += gridDim.x) {
    int row = it * NWAVE + wid;
    rmsnorm_row(src + (size_t)row * D_, g, dst + (size_t)row * D_);
  }
}

DI void phase_rmsnorm_widx(const Params& p, char* smem) {
  const int tid = otid(), lane = tid & 63, wid = owid(tid);
  float* wl = (float*)smem;
  for (int e = tid; e < 8 * 1024; e += NTHR) { int k = e >> 3, h = e & 7; wl[h * 1024 + k] = p.w_in[(size_t)k * 4104 + 512 + h]; }
  __syncthreads();
  const float* src = p.out; const float* g = p.g_mix;
  bf16_t* dst = (bf16_t*)(p.ws + OFF_H);
  float* WI = (float*)(p.ws + OFF_WIDX);
  for (int it = blockIdx.x; it < T_ / NWAVE; it += gridDim.x) {
    const int row = it * NWAVE + wid;
    const float* xr = src + (size_t)row * D_;
    float4 v[4]; float ss = 0.f;
#pragma unroll
    for (int j = 0; j < 4; ++j) { v[j] = *(const float4*)(xr + lane * 4 + 256 * j); ss += v[j].x * v[j].x + v[j].y * v[j].y + v[j].z * v[j].z + v[j].w * v[j].w; }
    ss = wave_sum(ss);
    const float rs = rsqrtf(ss * (1.f / 1024.f) + EPS);
    float acc[8];
#pragma unroll
    for (int h = 0; h < 8; ++h) acc[h] = 0.f;
#pragma unroll
    for (int j = 0; j < 4; ++j) {
      float4 gg = *(const float4*)(g + lane * 4 + 256 * j);
      const float y0 = v[j].x * rs * gg.x, y1 = v[j].y * rs * gg.y, y2 = v[j].z * rs * gg.z, y3 = v[j].w * rs * gg.w;
      u32x2 w; w[0] = pack2(y0, y1); w[1] = pack2(y2, y3);
      *(u32x2*)(dst + (size_t)row * D_ + lane * 4 + 256 * j) = w;
#pragma unroll
      for (int h = 0; h < 8; ++h) {
        const f32x4 ww = *(const f32x4*)(wl + h * 1024 + lane * 4 + 256 * j);
        acc[h] += y0 * ww[0] + y1 * ww[1] + y2 * ww[2] + y3 * ww[3];
      }
    }
#pragma unroll
    for (int h = 0; h < 8; ++h) acc[h] = wave_sum(acc[h]);
    if (lane < 8) {
      float r = acc[0];
#pragma unroll
      for (int h = 1; h < 8; ++h) r = lane == h ? acc[h] : r;
      WI[(size_t)row * 8 + lane] = r * 0.04419417382415922f;
    }
  }
  __syncthreads();
}

DI void phase_prep(const Params& p, char* smem) {
  bf16_t* wb = (bf16_t*)(p.ws + OFF_WB);
  const int tid = otid(), vb = tid >> 8, t = tid & 255;
  float* lds = (float*)smem + vb * 4160;
  constexpr int c0 = 1408, c1 = c0 + 704, c2 = c1 + 1408, c3 = c2 + 704, c4 = c3 + 1024, c5 = c4 + 64, c6 = c5 + 16, c7 = c6 + 128, c8 = c7 + 128, c9 = c8 + 256;
  static_assert((c9 & 1) == 0, "pairs");
  for (int it0 = blockIdx.x; it0 < c9 / 2; it0 += gridDim.x) {
    const int it = it0 * 2 + vb;
    int mat, K, base; size_t off;
    if (it < c0) { mat = 0; K = 1024; base = 0; off = W1GU; }
    else if (it < c1) { mat = 1; K = 2816; base = c0; off = W1D; }
    else if (it < c2) { mat = 2; K = 1024; base = c1; off = W2GU; }
    else if (it < c3) { mat = 3; K = 2816; base = c2; off = W2D; }
    else if (it < c4) { mat = 4; K = 1024; base = c3; off = WIN; }
    else if (it < c5) { mat = 5; K = 256; base = c4; off = WQ; }
    else if (it < c6) { mat = 6; K = 128; base = c5; off = WUV; }
    else if (it < c7) { mat = 7; K = 512; base = c6; off = WOA; }
    else if (it < c8) { mat = 8; K = 512; base = c7; off = WOB; }
    else { mat = 9; K = 1024; base = c8; off = WOUT; }
    prep_transpose_tile(p, true, mat, K, wb + off, it - base, lds, t);
  }
  {
    const int wid = owid(tid);
    for (int it = blockIdx.x; it < T_ / NWAVE; it += gridDim.x) {
      int row = it * NWAVE + wid;
      rmsnorm_row(p.x + (size_t)row * D_, p.g_ffn1, (bf16_t*)(p.ws + OFF_H) + (size_t)row * D_);
    }
  }
  for (int it = blockIdx.x; it < T_ * 32 / NTHR; it += gridDim.x) {
    int e = it * NTHR + tid;
    int tok = e >> 5, i = e & 31;
    float inv_freq = exp2f(-(float)i * (13.287712379549449f / 32.f));
    float ang = (float)p.pos[tok] * inv_freq;
    double rev = (double)ang * 0.15915494309189535;
    rev -= floor(rev);
    float r = (float)rev;
    float2 cs; cs.x = __builtin_amdgcn_cosf(r); cs.y = __builtin_amdgcn_sinf(r);
    ((float2*)(p.ws + OFF_ROPE))[e] = cs;
  }
}

typedef f32x4 acc8p_t[2][2][4][2];
constexpr int G_BK = 64, G_HALF = 128, G_HT = G_HALF * G_BK;
DI int lds_byte(int r, int c) {
  int st = (r >> 4) * 2 + (c >> 5), rr = r & 15, cc = c & 31, ob = rr * 64 + cc * 2;
  return st * 1024 + (ob ^ (((ob >> 9) & 1) << 5));
}
DI void stage_rc(int b, int& R, int& C) {
  int st = b / 1024, sb = b % 1024, swz = sb ^ (((sb >> 9) & 1) << 5);
  R = (st >> 1) * 16 + swz / 64; C = (st & 1) * 32 + (swz % 64) / 2;
}
template <int LDA, int LDB, int NKT>
DI void gemm8p(const bf16_t* __restrict__ A, const bf16_t* __restrict__ Bt, char* smem, acc8p_t& acc) {
  static_assert(NKT >= 4 && (NKT % 2) == 0, "K tiles");
  bf16_t* shm = (bf16_t*)smem;
  const int tid = otid();
  const int wid = owid(tid), lane = tid & 63, wr = wid >> 2, wc = wid & 3, fr = lane & 15, fq = lane >> 4;
#define SA(b, h) (shm + ((b) * 2 + (h)) * G_HT)
#define SB(b, h) (shm + (4 + (b) * 2 + (h)) * G_HT)
  unsigned sofa, sofb;
  { int _r, _c; stage_rc(tid * 16, _r, _c); sofa = (unsigned)(_r * LDA + _c); sofb = (unsigned)(_r * LDB + _c); }
#define STAGE(P, BASE, LD, br, kt, SOF) do { const bf16_t* _ub = (BASE) + ((long)(br) * (LD) + (long)(kt) * G_BK);     \
    _Pragma("unroll") for (int _i = 0; _i < 2; ++_i) { \
      __builtin_amdgcn_global_load_lds((const unsigned*)((_ub + (long)_i * 64 * (LD)) + SOF), \
        (unsigned*)((char*)(P) + tid * 16 + _i * 8192), 16, 0, 0); } } while (0)
#define LDA_(dst, b, h) _Pragma("unroll") for (int m = 0; m < 4; ++m) _Pragma("unroll") for (int k = 0; k < 2; ++k) \
    dst[m][k] = *reinterpret_cast<const bf16x8*>((char*)SA(b, h) + lds_byte(wr * 64 + m * 16 + fr, k * 32 + fq * 8))
#define LDB_(dst, b, h) _Pragma("unroll") for (int n = 0; n < 2; ++n) _Pragma("unroll") for (int k = 0; k < 2; ++k) \
    dst[n][k] = *reinterpret_cast<const bf16x8*>((char*)SB(b, h) + lds_byte(wc * 32 + n * 16 + fr, k * 32 + fq * 8))
#define MMA(ai, bj, At_, Bt_) do { __builtin_amdgcn_s_setprio(1); \
    _Pragma("unroll") for (int m = 0; m < 4; ++m) _Pragma("unroll") for (int n = 0; n < 2; ++n) _Pragma("unroll") for (int k = 0; k < 2; ++k) \
      acc[ai][bj][m][n] = __builtin_amdgcn_mfma_f32_16x16x32_bf16(At_[m][k], Bt_[n][k], acc[ai][bj][m][n], 0, 0, 0); \
    __builtin_amdgcn_s_setprio(0); } while (0)
#define WAIT_V(n) asm volatile("s_waitcnt vmcnt(" #n ")" ::: "memory")
#define WAIT_L(n) asm volatile("s_waitcnt lgkmcnt(" #n ")" ::: "memory")
#define BAR __builtin_amdgcn_s_barrier()
#define SCHED __builtin_amdgcn_sched_barrier(0)
#pragma unroll
  for (int a = 0; a < 2; ++a)
#pragma unroll
    for (int b = 0; b < 2; ++b)
#pragma unroll
      for (int m = 0; m < 4; ++m)
#pragma unroll
        for (int n = 0; n < 2; ++n) acc[a][b][m][n] = f32x4{0.f, 0.f, 0.f, 0.f};
  bf16x8 At[4][2], B0[2][2], B1[2][2];
  constexpr int nt = NKT;
  WAIT_V(0);
  SCHED;
  STAGE(SB(0, 0), Bt, LDB, 0, 0, sofb); STAGE(SA(0, 0), A, LDA, 0, 0, sofa);
  STAGE(SB(0, 1), Bt, LDB, G_HALF, 0, sofb); STAGE(SA(0, 1), A, LDA, G_HALF, 0, sofa);
  if (wr == 1) BAR;
  WAIT_V(4); BAR;
  STAGE(SB(1, 0), Bt, LDB, 0, 1, sofb); STAGE(SA(1, 0), A, LDA, 0, 1, sofa); STAGE(SB(1, 1), Bt, LDB, G_HALF, 1, sofb);
  WAIT_V(6); BAR;
  for (int t = 0; t < nt - 2; t += 2) {
    LDB_(B0, 0, 0); SCHED; LDA_(At, 0, 0); STAGE(SA(1, 1), A, LDA, G_HALF, t + 1, sofa);
    WAIT_L(8); BAR; WAIT_L(0); MMA(0, 0, At, B0); BAR; SCHED;
    LDB_(B1, 0, 1); STAGE(SB(0, 0), Bt, LDB, 0, t + 2, sofb);
    BAR; WAIT_L(0); MMA(0, 1, At, B1); BAR;
    LDA_(At, 0, 1); STAGE(SA(0, 0), A, LDA, 0, t + 2, sofa);
    BAR; WAIT_L(0); MMA(1, 0, At, B0); BAR; SCHED;
    STAGE(SB(0, 1), Bt, LDB, G_HALF, t + 2, sofb);
    WAIT_V(6); BAR; MMA(1, 1, At, B1); BAR;
    LDB_(B0, 1, 0); SCHED; LDA_(At, 1, 0); STAGE(SA(0, 1), A, LDA, G_HALF, t + 2, sofa);
    WAIT_L(8); BAR; WAIT_L(0); MMA(0, 0, At, B0); BAR; SCHED;
    LDB_(B1, 1, 1); STAGE(SB(1, 0), Bt, LDB, 0, t + 3, sofb);
    BAR; WAIT_L(0); MMA(0, 1, At, B1); BAR;
    LDA_(At, 1, 1); STAGE(SA(1, 0), A, LDA, 0, t + 3, sofa);
    BAR; WAIT_L(0); MMA(1, 0, At, B0); BAR; SCHED;
    STAGE(SB(1, 1), Bt, LDB, G_HALF, t + 3, sofb);
    WAIT_V(6); BAR; MMA(1, 1, At, B1); BAR;
  }
  { LDB_(B0, 0, 0); LDA_(At, 0, 0); STAGE(SA(1, 1), A, LDA, G_HALF, nt - 1, sofa);
    BAR; WAIT_L(0); MMA(0, 0, At, B0); BAR;
    LDB_(B1, 0, 1); BAR; WAIT_L(0); MMA(0, 1, At, B1); BAR;
    LDA_(At, 0, 1); WAIT_V(4); BAR; WAIT_L(0); MMA(1, 0, At, B0); MMA(1, 1, At, B1); BAR; }
  { LDB_(B0, 1, 0); LDA_(At, 1, 0); WAIT_V(2); BAR; WAIT_L(0); MMA(0, 0, At, B0); BAR;
    LDB_(B1, 1, 1); WAIT_V(0); BAR; WAIT_L(0); MMA(0, 1, At, B1); BAR;
    LDA_(At, 1, 1); BAR; WAIT_L(0); MMA(1, 0, At, B0); MMA(1, 1, At, B1); BAR; }
  if (wr == 0) BAR;
#undef SA
#undef SB
#undef STAGE
#undef LDA_
#undef LDB_
#undef MMA
#undef WAIT_V
#undef WAIT_L
#undef BAR
#undef SCHED
}

DI int sched_tile(int it, int MT, int NT, int& mt, int& nt) {
  const int G = gridDim.x, b = blockIdx.x;
  const int per = G >> 3, pm = per >> 2;
  const int nfull = NT >> 2, w = NT & 3;
  if ((G & 31) == 0 && pm > 0 && (MT % pm) == 0 && w != 3 && (w == 0 || (MT % (per / w)) == 0)) {
    const int x = g_sched[0], j = g_sched[1];
    const int nsm = MT / pm;
    const int nmain = nsm * nfull;
    const int pm2 = w ? per / w : 1;
    const int ntail = w ? MT / pm2 : 0;
    const int st = it * 8 + x;
    if (st >= nmain + ntail) return -1;
    if (st < nmain) {
      const int sm = st / nfull, sn = st - sm * nfull;
      mt = sm * pm + (j % pm); nt = sn * 4 + (j / pm);
    } else {
      const int s2 = st - nmain;
      mt = s2 * pm2 + (j % pm2); nt = nfull * 4 + (j / pm2);
    }
    return 1;
  } else {
    const int tile = it * G + b;
    if (tile >= MT * NT) return -1;
    nt = tile % NT; mt = tile / NT;
    return 1;
  }
}

#define EPI_IDS const int tid = otid(), lane = tid & 63, wid = owid(tid), wr = wid >> 2, wc = wid & 3, fr = lane & 15, fq = lane >> 4; (void)wr; (void)wc; (void)fr; (void)fq;
#define LROW(ai, m, j) ((ai) * 128 + (m) * 16 + (j))
#define LCOL(bj, n) ((bj) * 128 + (n) * 16)
#define EPI_FOR _Pragma("unroll") for (int ai = 0; ai < 2; ++ai) _Pragma("unroll") for (int bj = 0; bj < 2; ++bj) \
    _Pragma("unroll") for (int m = 0; m < 4; ++m) _Pragma("unroll") for (int n = 0; n < 2; ++n) _Pragma("unroll") for (int j = 0; j < 4; ++j)

constexpr int EPW = 260;
DI void epi_stage(const acc8p_t& acc, int ai, char* smem, int wr, int wc, int fr, int fq) {
  float* L = (float*)smem + (wr * 64 + fq * 4) * EPW + wc * 32 + fr;
#pragma unroll
  for (int bj = 0; bj < 2; ++bj)
#pragma unroll
    for (int m = 0; m < 4; ++m)
#pragma unroll
      for (int n = 0; n < 2; ++n)
#pragma unroll
        for (int j = 0; j < 4; ++j) L[(m * 16 + j) * EPW + bj * 128 + n * 16] = acc[ai][bj][m][n][j];
}
DI void epi_rmw_f32(char* smem, float* out, const float* res, int mt, int nt, int ai, float scale, int tid) {
  const float* L = (const float*)smem;
#pragma unroll
  for (int hb = 0; hb < 2; ++hb) {
    float4 r[8];
#pragma unroll
    for (int i = 0; i < 8; ++i) {
      const int id = tid + 512 * (hb * 8 + i); const int row = id >> 6, c4 = id & 63;
      r[i] = *(const float4*)(res + (size_t)(mt * 256 + ai * 128 + row) * D_ + nt * 256 + c4 * 4);
    }
#pragma unroll
    for (int i = 0; i < 8; ++i) {
      const int id = tid + 512 * (hb * 8 + i); const int row = id >> 6, c4 = id & 63;
      const float4 a = *(const float4*)(L + row * EPW + c4 * 4);
      float4 o; o.x = r[i].x + scale * a.x; o.y = r[i].y + scale * a.y; o.z = r[i].z + scale * a.z; o.w = r[i].w + scale * a.w;
      *(float4*)(out + (size_t)(mt * 256 + ai * 128 + row) * D_ + nt * 256 + c4 * 4) = o;
    }
  }
}
template <bool ACCUM>
DI void epi_gate_bf16(char* smem, bf16_t* MG, const bf16_t* GT, int gcol0, int mt, int nt, int ai, int tid) {
  const float* L = (const float*)smem;
  u32x4 gt[8], old[8];
#pragma unroll
  for (int i = 0; i < 8; ++i) {
    const int id = tid + 512 * i; const int row = id >> 5, c8 = id & 31;
    const size_t grow = (size_t)(mt * 256 + ai * 128 + row);
    gt[i] = *(const u32x4*)(GT + grow * 2048 + gcol0 + nt * 256 + c8 * 8);
    if (ACCUM) old[i] = *(const u32x4*)(MG + grow * D_ + nt * 256 + c8 * 8);
  }
#pragma unroll
  for (int i = 0; i < 8; ++i) {
    const int id = tid + 512 * i; const int row = id >> 5, c8 = id & 31;
    const size_t grow = (size_t)(mt * 256 + ai * 128 + row);
    const float4 a0 = *(const float4*)(L + row * EPW + c8 * 8), a1 = *(const float4*)(L + row * EPW + c8 * 8 + 4);
    const float av[8] = {a0.x, a0.y, a0.z, a0.w, a1.x, a1.y, a1.z, a1.w};
    u32x4 o;
#pragma unroll
    for (int k = 0; k < 4; ++k) {
      float v0 = bflo(gt[i][k]) * av[2 * k], v1 = bfhi(gt[i][k]) * av[2 * k + 1];
      if (ACCUM) { v0 += bflo(old[i][k]); v1 += bfhi(old[i][k]); }
      o[k] = pack2(v0, v1);
    }
    *(u32x4*)(MG + grow * D_ + nt * 256 + c8 * 8) = o;
  }
}

DI void phase_ffn_gu(const Params& p, size_t woff, char* smem) {
  const bf16_t* H = (const bf16_t*)(p.ws + OFF_H);
  const bf16_t* W = (const bf16_t*)(p.ws + OFF_WB) + woff;
  bf16_t* U = (bf16_t*)(p.ws + OFF_PA);
  for (int it = 0;; ++it) {
    int mt, nt; int s = sched_tile(it, 128, 22, mt, nt);
    if (s < 0) break; if (s == 0) continue;
    acc8p_t acc;
    gemm8p<D_, D_, 16>(H + (size_t)mt * 256 * D_, W + (size_t)nt * 256 * D_, smem, acc);
    EPI_IDS
    bf16_t* tp = U + (size_t)(mt * 256) * FF + nt * 128;
    const unsigned loff = (unsigned)((wr * 64 + fq * 4) * FF + wc * 32 + fr);
#pragma unroll
    for (int ai = 0; ai < 2; ++ai)
#pragma unroll
      for (int m = 0; m < 4; ++m)
#pragma unroll
        for (int n = 0; n < 2; ++n)
#pragma unroll
          for (int j = 0; j < 4; ++j) {
            float gv = acc[ai][0][m][n][j], uv = acc[ai][1][m][n][j];
            float sv = gv * frcp(1.f + fexp2(-LOG2E * gv)) * uv;
            (tp + LROW(ai, m, j) * FF + n * 16)[loff] = (bf16_t)f2bf(sv);
          }
  }
}

DI void phase_ffn_down(const Params& p, size_t woff, const float* res, char* smem) {
  const bf16_t* U = (const bf16_t*)(p.ws + OFF_PA);
  const bf16_t* W = (const bf16_t*)(p.ws + OFF_WB) + woff;
  float* out = p.out;
  for (int it = 0;; ++it) {
    int mt, nt; int s = sched_tile(it, 128, 4, mt, nt);
    if (s < 0) break; if (s == 0) continue;
    acc8p_t acc;
    gemm8p<FF, FF, 44>(U + (size_t)mt * 256 * FF, W + (size_t)nt * 256 * FF, smem, acc);
    EPI_IDS
#pragma unroll
    for (int ai = 0; ai < 2; ++ai) {
      epi_stage(acc, ai, smem, wr, wc, fr, fq);
      __syncthreads();
      epi_rmw_f32(smem, out, res, mt, nt, ai, 0.5f, tid);
      __syncthreads();
    }
  }
}

DI void phase_win(const Params& p, char* smem) {
  const bf16_t* H = (const bf16_t*)(p.ws + OFF_H);
  const bf16_t* W = (const bf16_t*)(p.ws + OFF_WB) + WIN;
  bf16_t* PA = (bf16_t*)(p.ws + OFF_PA);
  bf16_t* VT = (bf16_t*)(p.ws + OFF_VT);
  bf16_t* GT = (bf16_t*)(p.ws + OFF_GATES);
  float* WI = (float*)(p.ws + OFF_WIDX);
  for (int it = 0;; ++it) {
    int mt, nt; int s = sched_tile(it, 128, 16, mt, nt);
    if (s < 0) break; if (s == 0) continue;
    acc8p_t acc;
    gemm8p<D_, D_, 16>(H + (size_t)mt * 256 * D_, W + (size_t)nt * 256 * D_, smem, acc);
    EPI_IDS
    if (nt < 6) {
      bf16_t* tp = PA + (size_t)(mt * 256) * PA_LD + nt * 256;
      const unsigned loff = (unsigned)((wr * 64 + fq * 4) * PA_LD + wc * 32 + fr);
      const float qsc = (nt == 2 || nt == 3) ? 0.125f * LOG2E : 1.f;
      EPI_FOR {
        const int ro = LROW(ai, m, j) * PA_LD + LCOL(bj, n);
        (tp + ro)[loff] = (bf16_t)f2bf(acc[ai][bj][m][n][j] * qsc);
      }
    } else if (nt < 8) {
      const int b = mt >> 4;
#pragma unroll
      for (int ai = 0; ai < 2; ++ai)
#pragma unroll
        for (int bj = 0; bj < 2; ++bj)
#pragma unroll
          for (int m = 0; m < 4; ++m)
#pragma unroll
            for (int n = 0; n < 2; ++n) {
              int c = (nt - 6) * 256 + bj * 128 + wc * 32 + n * 16 + fr;
              int h = c >> 6, d = c & 63;
              int tok = mt * 256 + ai * 128 + wr * 64 + m * 16 + fq * 4;
              bf16_t* dst = VT + ((size_t)(b * 8 + h) * 64 + d) * S_ + (tok & (S_ - 1));
              u32x2 w; w[0] = pack2(acc[ai][bj][m][n][0], acc[ai][bj][m][n][1]); w[1] = pack2(acc[ai][bj][m][n][2], acc[ai][bj][m][n][3]);
              *(u32x2*)dst = w;
            }
    } else if (nt < 16) {
      bf16_t* tp = GT + (size_t)(mt * 256) * 2048 + (nt - 8) * 256;
      const unsigned loff = (unsigned)((wr * 64 + fq * 4) * 2048 + wc * 32 + fr);
      EPI_FOR {
        const int ro = LROW(ai, m, j) * 2048 + LCOL(bj, n);
        float v = acc[ai][bj][m][n][j];
        float sg = frcp(1.f + fexp2(-LOG2E * v));
        (tp + ro)[loff] = (bf16_t)f2bf(sg);
      }
    }
  }
}

DI void phase_qproj(const Params& p, char* smem) {
  bf16_t* PA = (bf16_t*)(p.ws + OFF_PA);
  const bf16_t* W = (const bf16_t*)(p.ws + OFF_WB) + WQ;
  bf16_t* QA = (bf16_t*)(p.ws + OFF_H);
  bf16_t* QI = QA + (size_t)T_ * 512;
  const float2* ROPE = (const float2*)(p.ws + OFF_ROPE);
  float* rstd = (float*)(smem + 131072);
  for (int it = 0;; ++it) {
    int mt, nt; int s = sched_tile(it, 128, 4, mt, nt);
    if (s < 0) break; if (s == 0) continue;
    acc8p_t acc;
    gemm8p<PA_LD, 256, 4>(PA + (size_t)mt * 256 * PA_LD, W + (size_t)nt * 256 * 256, smem, acc);
    {
      const int tq = otid(); int row = tq >> 1, half = tq & 1;
      const bf16_t* src = PA + (size_t)(mt * 256 + row) * PA_LD + half * 128;
      float ss = 0.f;
#pragma unroll 4
      for (int i = 0; i < 16; ++i) {
        u32x4 v = *(const u32x4*)(src + i * 8);
#pragma unroll
        for (int j = 0; j < 4; ++j) { float a = bflo(v[j]), b = bfhi(v[j]); ss += a * a + b * b; }
      }
      ss += __shfl_xor(ss, 1);
      if (half == 0) rstd[row] = rsqrtf(ss * (1.f / 256.f) + EPS);
    }
    __syncthreads();
    EPI_IDS
    const int head = (nt & 1) * 4 + wc;
    bf16_t* dtp = (nt < 2 ? QA : QI) + (size_t)(mt * 256) * 512 + head * 64;
    const float2* rtp = ROPE + (size_t)(mt * 256) * 32;
    const unsigned doff = (unsigned)((wr * 64 + fq * 4) * 512 + fr);
    const unsigned roff = (unsigned)((wr * 64 + fq * 4) * 32 + fr);
    const float* rsl = rstd + wr * 64 + fq * 4;
    float ga[4] = {1.f, 1.f, 1.f, 1.f};
    const bool do_norm = nt < 2;
    if (do_norm) { ga[0] = p.g_qa[fr]; ga[1] = p.g_qa[16 + fr]; ga[2] = p.g_qa[32 + fr]; ga[3] = p.g_qa[48 + fr]; }
#pragma unroll
    for (int ai = 0; ai < 2; ++ai)
#pragma unroll
      for (int m = 0; m < 4; ++m)
#pragma unroll
        for (int j = 0; j < 4; ++j) {
          const int lr = LROW(ai, m, j);
          const float rs = rsl[lr];
          float x0 = acc[ai][0][m][0][j] * rs, x1 = acc[ai][0][m][1][j] * rs;
          float y0 = acc[ai][1][m][0][j] * rs, y1 = acc[ai][1][m][1][j] * rs;
          if (do_norm) {
            float ss = x0 * x0 + x1 * x1 + y0 * y0 + y1 * y1;
#pragma unroll
            for (int o = 8; o > 0; o >>= 1) ss += __shfl_xor(ss, o);
            const float r2 = rsqrtf(ss * (1.f / 64.f) + EPS);
            x0 *= r2 * ga[0]; x1 *= r2 * ga[1]; y0 *= r2 * ga[2]; y1 *= r2 * ga[3];
          }
          const float2 c0 = (rtp + lr * 32)[roff], c1 = (rtp + lr * 32 + 16)[roff];
          bf16_t* dp = dtp + lr * 512;
          (dp)[doff] = (bf16_t)f2bf(x0 * c0.x - y0 * c0.y);
          (dp + 32)[doff] = (bf16_t)f2bf(x0 * c0.y + y0 * c0.x);
          (dp + 16)[doff] = (bf16_t)f2bf(x1 * c1.x - y1 * c1.y);
          (dp + 48)[doff] = (bf16_t)f2bf(x1 * c1.y + y1 * c1.x);
          if (j == 3) __builtin_amdgcn_sched_barrier(0);
        }
    __syncthreads();
  }
  const int tid = otid(), lane = tid & 63, wid = owid(tid);
  for (int it = blockIdx.x; it < T_ / 64; it += gridDim.x) {
    const int d = lane & 31; const bool isidx = lane >= 32;
    const float g0 = isidx ? 1.f : p.g_ka[d], g1 = isidx ? 1.f : p.g_ka[d + 32];
    for (int i = 0; i < 8; ++i) {
      int tok = it * 64 + wid * 8 + i;
      bf16_t* src = PA + (size_t)tok * PA_LD + (isidx ? PA_KI : PA_KA);
      float v0 = bf2f(src[d]), v1 = bf2f(src[d + 32]);
      float ss = v0 * v0 + v1 * v1;
#pragma unroll
      for (int o = 16; o > 0; o >>= 1) ss += __shfl_xor(ss, o);
      if (!isidx) { float r2 = rsqrtf(ss * (1.f / 64.f) + EPS); v0 *= r2 * g0; v1 *= r2 * g1; }
      float2 cs = ROPE[(size_t)tok * 32 + d];
      float o0 = v0 * cs.x - v1 * cs.y, o1 = v0 * cs.y + v1 * cs.x;
      src[d] = (bf16_t)f2bf(o0); src[d + 32] = (bf16_t)f2bf(o1);
    }
  }
}

DI f32x16 sb_qk(const char* cur, int sub, int r, int g, int sw, const bf16x8 (&qf)[4]) {
  f32x16 z;
#pragma unroll
  for (int i = 0; i < 16; ++i) z[i] = 0.f;
#pragma unroll
  for (int ks = 0; ks < 4; ++ks) {
    bf16x8 kf = ld_frag_s(cur + (sub * 32 + r) * 128 + (((ks * 2 + g) ^ sw) << 4));
    z = MFMA32(kf, qf[ks], z);
  }
  return z;
}
template <bool DIAG>
DI void sb_elem(const f32x16& z, int r, int g, float& R, bf16x8& pf0, bf16x8& pf1) {
  float e[16], rr[16];
#pragma unroll
  for (int i = 0; i < 16; ++i) {
    float z2 = fminf(z[i], 80.f);
    float ev = fexp2(z2);
    float rv_ = frcp(1.f + ev);
    if (DIAG && !(crow(i, g) < r)) { ev = 0.f; rv_ = 1.f; }
    e[i] = ev; rr[i] = rv_;
  }
  float G[4], Gp[4];
#pragma unroll
  for (int q = 0; q < 4; ++q) {
    rr[4 * q + 2] *= rr[4 * q + 3];
    rr[4 * q + 1] *= rr[4 * q + 2];
    rr[4 * q + 0] *= rr[4 * q + 1];
    G[q] = rr[4 * q];
  }
#pragma unroll
  for (int q = 0; q < 4; ++q) Gp[q] = __shfl_xor(G[q], 32);
  float SO[4], SP[4];
  SO[3] = 1.f; SO[2] = G[3]; SO[1] = G[2] * G[3]; SO[0] = G[1] * SO[1];
  SP[3] = 1.f; SP[2] = Gp[3]; SP[1] = Gp[2] * Gp[3]; SP[0] = Gp[1] * SP[1];
  float a[16];
#pragma unroll
  for (int q = 0; q < 4; ++q) {
    float part = g == 0 ? SP[q] * Gp[q] : SP[q];
    float E = SO[q] * part * R;
#pragma unroll
    for (int j = 0; j < 4; ++j) a[4 * q + j] = e[4 * q + j] * rr[4 * q + j] * E;
  }
  R = R * (SO[0] * G[0]) * (SP[0] * Gp[0]);
  u32x4 pw0, pw1;
#pragma unroll
  for (int j = 0; j < 4; ++j) { pw0[j] = pack2(a[2 * j], a[2 * j + 1]); pw1[j] = pack2(a[8 + 2 * j], a[8 + 2 * j + 1]); }
  pf0 = __builtin_bit_cast(bf16x8, pw0); pf1 = __builtin_bit_cast(bf16x8, pw1);
}
DI void sb_pv(const char* cur, int sub, int r, int g, const bf16x8& pf0, const bf16x8& pf1, f32x16& o0, f32x16& o1) {
#pragma unroll
  for (int ks2 = 0; ks2 < 2; ++ks2) {
    const bf16x8 pf = ks2 == 0 ? pf0 : pf1;
#pragma unroll
    for (int dt = 0; dt < 2; ++dt) {
      const char* vp = cur + 8192 + (dt * 32 + r) * 136 + (sub * 32 + 16 * ks2 + 4 * g) * 2;
      u32x2 lo = *(const u32x2*)vp, hi = *(const u32x2*)(vp + 16);
      u32x4 vv; vv[0] = lo[0]; vv[1] = lo[1]; vv[2] = hi[0]; vv[3] = hi[1];
      bf16x8 vf = __builtin_bit_cast(bf16x8, vv);
      if (dt == 0) o0 = MFMA32(vf, pf, o0); else o1 = MFMA32(vf, pf, o1);
    }
  }
}

template <bool DUMMY>
DI void sb_item(const Params& p, int b, int h, int qb, char* smem) {
  bf16_t* PA = (bf16_t*)(p.ws + OFF_PA);
  const bf16_t* VT = (const bf16_t*)(p.ws + OFF_VT) + (size_t)(b * 8 + h) * 64 * S_;
  const int tid = otid(), lane = tid & 63, wid = owid(tid), g = lane >> 5, r = lane & 31;
  const int tw = qb * 256 + wid * 32;
  constexpr int BUFSZ = 8192 + 8704;
  bf16x8 qf[4];
  {
    const bf16_t* qp = PA + (size_t)(b * S_ + tw + r) * PA_LD + PA_QB + h * 64 + g * 8;
#pragma unroll
    for (int ks = 0; ks < 4; ++ks) qf[ks] = ld_frag_g(qp + ks * 16);
  }
  const int srow = tid >> 3, sch = tid & 7;
  const bf16_t* gk = PA + (size_t)(b * S_ + srow) * PA_LD + PA_KB + h * 64 + sch * 8;
  const bf16_t* gv = VT + (size_t)srow * S_ + sch * 8;
  const unsigned k_st = srow * 128 + ((sch ^ ((srow >> 1) & 7)) << 4);
  const unsigned v_st = 8192 + srow * 136 + sch * 16;
  const int sw = (lane >> 1) & 7;
  f32x16 o0, o1;
#pragma unroll
  for (int i = 0; i < 16; ++i) { o0[i] = 0.f; o1[i] = 0.f; }
  float R = 1.f;
  const int nkt = 4 * qb + 4;
  u32x4 rk, rv;
  {
    int kt = nkt - 1;
    rk = *(const u32x4*)(gk + (size_t)(kt * 64) * PA_LD); rv = *(const u32x4*)(gv + kt * 64);
    char* cur = smem + (kt & 1) * BUFSZ;
    *(u32x4*)(cur + k_st) = rk;
    u32x2 lo, hi; lo[0] = rv[0]; lo[1] = rv[1]; hi[0] = rv[2]; hi[1] = rv[3];
    *(u32x2*)(cur + v_st) = lo; *(u32x2*)(cur + v_st + 8) = hi;
  }
  __syncthreads();
  for (int kt = nkt - 1; kt >= 0; --kt) {
    const char* cur = smem + (kt & 1) * BUFSZ;
    char* nxt = smem + ((kt + 1) & 1) * BUFSZ;
    const bool more = kt > 0;
    if (more) { rk = *(const u32x4*)(gk + (size_t)((kt - 1) * 64) * PA_LD); rv = *(const u32x4*)(gv + (kt - 1) * 64); }
    __builtin_amdgcn_sched_barrier(0);
    if (kt * 64 + 32 < tw) {
      const f32x16 z1 = sb_qk(cur, 1, r, g, sw, qf);
      const f32x16 z0 = sb_qk(cur, 0, r, g, sw, qf);
      bf16x8 p1a, p1b, p0a, p0b;
      sb_elem<false>(z1, r, g, R, p1a, p1b);
      sb_pv(cur, 1, r, g, p1a, p1b, o0, o1);
      sb_elem<false>(z0, r, g, R, p0a, p0b);
      sb_pv(cur, 0, r, g, p0a, p0b, o0, o1);
    } else {
#pragma unroll
      for (int sub = 1; sub >= 0; --sub) {
        const int sbase = kt * 64 + sub * 32;
        if (sbase <= tw) {
          const f32x16 z = sb_qk(cur, sub, r, g, sw, qf);
          bf16x8 pa, pb;
          if (sbase == tw) sb_elem<true>(z, r, g, R, pa, pb); else sb_elem<false>(z, r, g, R, pa, pb);
          sb_pv(cur, sub, r, g, pa, pb, o0, o1);
        }
      }
    }
    __builtin_amdgcn_sched_barrier(0);
    if (more) {
      *(u32x4*)(nxt + k_st) = rk;
      u32x2 lo, hi; lo[0] = rv[0]; lo[1] = rv[1]; hi[0] = rv[2]; hi[1] = rv[3];
      *(u32x2*)(nxt + v_st) = lo; *(u32x2*)(nxt + v_st + 8) = hi;
    }
    __syncthreads();
  }
  bf16_t* yp = DUMMY ? (bf16_t*)(p.ws + OFF_SLAB) + (size_t)(b * S_ + tw + r) * 512 + h * 64 : PA + (size_t)(b * S_ + tw + r) * PA_LD + PA_QB + h * 64;
#pragma unroll
  for (int rq = 0; rq < 4; ++rq) {
    u32x2 w0, w1;
    w0[0] = pack2(o0[4 * rq], o0[4 * rq + 1]); w0[1] = pack2(o0[4 * rq + 2], o0[4 * rq + 3]);
    w1[0] = pack2(o1[4 * rq], o1[4 * rq + 1]); w1[1] = pack2(o1[4 * rq + 2], o1[4 * rq + 3]);
    *(u32x2*)(yp + 8 * rq + 4 * g) = w0;
    *(u32x2*)(yp + 32 + 8 * rq + 4 * g) = w1;
  }
}

DI unsigned tokey(float f) { unsigned u = __float_as_uint(f); return (u & 0x80000000u) ? ~u : (u | 0x80000000u); }
DI int wave_count_sum(int c) {
  int tot = 0;
#pragma unroll
  for (int bt = 0; bt < 7; ++bt) tot += __builtin_popcountll(__ballot((c >> bt) & 1)) << bt;
  return tot;
}

DI void idx_item(const Params& p, int b, int qt, char* smem) {
  bf16_t* PA = (bf16_t*)(p.ws + OFF_PA);
  const bf16_t* QI = (const bf16_t*)(p.ws + OFF_H) + (size_t)T_ * 512;
  const float* WI = (const float*)(p.ws + OFF_WIDX);
  float* slab = (float*)(p.ws + OFF_SLAB) + (size_t)blockIdx.x * 16 * 4096;
  const int tid = otid(), lane = tid & 63, wid = owid(tid), g4 = lane >> 4, r = lane & 15;
  const int t0 = qt * 16;
  {
    bf16x8 qf[8][2]; float w[8];
    const bf16_t* qp = QI + (size_t)(b * S_ + t0 + r) * 512 + g4 * 8;
#pragma unroll
    for (int hh = 0; hh < 8; ++hh) { qf[hh][0] = ld_frag_g(qp + hh * 64); qf[hh][1] = ld_frag_g(qp + hh * 64 + 32); }
    {
      const float4* wp = (const float4*)(WI + (size_t)(b * S_ + t0 + r) * 8);
      float4 wa = wp[0], wb = wp[1];
      w[0] = wa.x; w[1] = wa.y; w[2] = wa.z; w[3] = wa.w; w[4] = wb.x; w[5] = wb.y; w[6] = wb.z; w[7] = wb.w;
    }
    const int nkt = qt + 1;
    const bf16_t* kbase = PA + (size_t)(b * S_ + r) * PA_LD + PA_KI + g4 * 8;
    bf16x8 k0, k1;
    {
      int kt = wid < nkt ? wid : 0;
      const bf16_t* kp = kbase + (size_t)(kt * 16) * PA_LD;
      k0 = ld_frag_g(kp); k1 = ld_frag_g(kp + 32);
    }
    for (int kt = wid; kt < nkt; kt += NWAVE) {
      bf16x8 n0, n1;
      {
        int kn = kt + NWAVE < nkt ? kt + NWAVE : kt;
        const bf16_t* kp = kbase + (size_t)(kn * 16) * PA_LD;
        n0 = ld_frag_g(kp); n1 = ld_frag_g(kp + 32);
      }
      f32x4 sc = {0.f, 0.f, 0.f, 0.f};
#pragma unroll
      for (int hh = 0; hh < 8; ++hh) {
        f32x4 c = {0.f, 0.f, 0.f, 0.f};
        c = MFMA16(k0, qf[hh][0], c);
        c = MFMA16(k1, qf[hh][1], c);
#pragma unroll
        for (int i = 0; i < 4; ++i) sc[i] += w[hh] * fmaxf(c[i], 0.f);
      }
      *(f32x4*)(slab + (size_t)r * 4096 + kt * 16 + 4 * g4) = sc;
      k0 = n0; k1 = n1;
    }
  }
  __syncthreads();
  for (int qi = 0; qi < 2; ++qi) {
    const int q = wid * 2 + qi;
    const int t = t0 + q, n = t + 1;
    unsigned short* out = (unsigned short*)(PA + (size_t)(b * S_ + t) * PA_LD);
    if (n <= 256) {
#pragma unroll
      for (int j = 0; j < 4; ++j) { int e = j * 64 + lane; out[e] = (unsigned short)(e < n ? e : 0); }
      continue;
    }
    const float* row = slab + (size_t)q * 4096 + lane;
    const int nj = (n + 63) >> 6;
    unsigned key[64];
#pragma unroll
    for (int ch = 0; ch < 4; ++ch) {
#pragma unroll
      for (int jj = 0; jj < 16; ++jj) key[ch * 16 + jj] = 0xff800000u;
      if (nj > ch * 16) {
#pragma unroll
        for (int jj = 0; jj < 16; ++jj) { const int j = ch * 16 + jj; if (j * 64 + lane < n) key[j] = __float_as_uint(row[j * 64]); }
      }
    }
    __builtin_amdgcn_sched_barrier(0);
#pragma unroll
    for (int j = 0; j < 64; ++j) key[j] = (j * 64 + lane < n) ? tokey(__uint_as_float(key[j])) : 0u;
    unsigned Tthr = 0u; int need = 0; bool exact = false;
    for (int bit = 31; bit >= 0; --bit) {
      const unsigned cand = Tthr | (1u << bit);
      int c = 0;
#pragma unroll
      for (int ch = 0; ch < 4; ++ch) {
        if (nj > ch * 16) {
#pragma unroll
          for (int jj = 0; jj < 16; ++jj) c += (key[ch * 16 + jj] >= cand) ? 1 : 0;
        }
      }
      const int cnt = wave_count_sum(c);
      if (cnt >= 256) Tthr = cand;
      if (cnt == 256) { exact = true; break; }
    }
    unsigned Tgt;
    if (exact) { Tgt = Tthr - 1u; need = 0; }
    else {
      int c = 0;
#pragma unroll
      for (int j = 0; j < 64; ++j) c += (key[j] > Tthr) ? 1 : 0;
      Tgt = Tthr; need = 256 - wave_count_sum(c);
    }
    const unsigned long long lt_mask = (1ull << lane) - 1ull;
    int base = 0, ties = 0;
#pragma unroll
    for (int j = 0; j < 64; ++j) {
      if (j < nj) {
        const bool gt = key[j] > Tgt;
        const bool eq = (!exact) && (key[j] == Tthr);
        const unsigned long long meq = __ballot(eq);
        const int myrank = ties + __builtin_popcountll(meq & lt_mask);
        const bool sel = gt || (eq && myrank < need);
        ties += __builtin_popcountll(meq);
        const unsigned long long ms = __ballot(sel);
        const int pos = base + __builtin_popcountll(ms & lt_mask);
        if (sel && pos < 256) out[pos] = (unsigned short)(j * 64 + lane);
        base += __builtin_popcountll(ms);
      }
    }
  }
  __syncthreads();
}

DI void phase_sb_dummy(const Params& p, char* smem) {
  unsigned* cnt = (unsigned*)(p.ws + OFF_CNT) + 16;
  int* s_item = (int*)(smem + SMEM_BYTES - 16);
  while (true) {
    if (otid() == 0) *s_item = (int)atomicAdd(cnt, 1u);
    __syncthreads();
    const int item = *s_item;
    __syncthreads();
    if (item >= 64 * 16) break;
    int qb = 15 - (item >> 6), bh = item & 63;
    sb_item<true>(p, bh >> 3, bh & 7, qb, smem);
  }
}

template <bool IDX_ONLY>
DI void phase_mix(const Params& p, char* smem) {
  unsigned* cnt = (unsigned*)(p.ws + OFF_CNT) + (IDX_ONLY ? 8 : 0);
  int* s_item = (int*)(smem + SMEM_BYTES - 16);
  constexpr int NSB = 64 * 16, NIDX = 8 * 256;
  while (true) {
    if (otid() == 0) *s_item = (int)atomicAdd(cnt, 1u);
    __syncthreads();
    const int item = *s_item;
    __syncthreads();
    if (IDX_ONLY) { if (item >= NIDX) break; int qt = 255 - (item >> 3), b = item & 7; idx_item(p, b, qt, smem); continue; }
    if (item >= NSB + NIDX) break;
    if (item < NSB) {
      int qb = 15 - (item >> 6), bh = item & 63;
      sb_item<false>(p, bh >> 3, bh & 7, qb, smem);
    } else {
      int j = item - NSB;
      int qt = 255 - (j >> 3), b = j & 7;
      idx_item(p, b, qt, smem);
    }
  }
}

DI void phase_sparse(const Params& p, char* smem) {
  const bf16_t* PA = (const bf16_t*)(p.ws + OFF_PA);
  const bf16_t* QA = (const bf16_t*)(p.ws + OFF_H);
  bf16_t* YA = (bf16_t*)(p.ws + OFF_SLAB + (size_t)64 * 1024 * 1024);
  const bf16_t* WUVb = (const bf16_t*)(p.ws + OFF_WB) + WUV;
  const int tid = otid(), lane = tid & 63, wid = owid(tid), g4 = lane >> 4, c = lane & 15;
  constexpr int WST = 10304;
  char* Vl = smem + wid * WST;
  int* Il = (int*)(smem + wid * WST + 9216);
  char* OL = smem + 8 * WST;
  const float sc2 = 0.125f * LOG2E;
  typedef __attribute__((address_space(3))) s16x4 lds_s16x4;
  for (int it = blockIdx.x; it < T_ / 16; it += gridDim.x) {
    const int tok0 = it * 16;
    const int b = tok0 >> 12;
    int ivA[4], ivB[4]; bf16x8 qA0, qA1, qB0, qB1;
    {
      const int tA = tok0 + wid * 2, tB = tA + 1;
      const unsigned short* rA = (const unsigned short*)(PA + (size_t)tA * PA_LD);
      const unsigned short* rB = (const unsigned short*)(PA + (size_t)tB * PA_LD);
#pragma unroll
      for (int j = 0; j < 4; ++j) { ivA[j] = rA[j * 64 + lane]; ivB[j] = rB[j * 64 + lane]; }
      u32x4 z4 = {0u, 0u, 0u, 0u};
      qA0 = __builtin_bit_cast(bf16x8, z4); qA1 = qA0; qB0 = qA0; qB1 = qA0;
      if (c < 8) {
        const bf16_t* qp = QA + (size_t)tA * 512 + c * 64 + g4 * 8;
        qA0 = ld_frag_g(qp); qA1 = ld_frag_g(qp + 32); qB0 = ld_frag_g(qp + 512); qB1 = ld_frag_g(qp + 512 + 32);
      }
    }
#pragma nounroll
    for (int qi = 0; qi < 2; ++qi) {
      const int q = wid * 2 + qi;
      const int tok = tok0 + q, t = tok & (S_ - 1);
      const int nsel = t + 1 < 256 ? t + 1 : 256;
#pragma unroll
      for (int j = 0; j < 4; ++j) { int e = j * 64 + lane; int v = qi == 0 ? ivA[j] : ivB[j]; Il[e] = e < nsel ? v : 0; }
      __syncthreads();
      const bf16x8 qf0 = qi == 0 ? qA0 : qB0, qf1 = qi == 0 ? qA1 : qB1;
      f32x4 acc[8];
#pragma unroll
      for (int ct = 0; ct < 8; ++ct) acc[ct] = f32x4{0.f, 0.f, 0.f, 0.f};
      float m = -INFINITY, sum = 0.f;
      const int nch = (nsel + 31) >> 5;
      const char* kbase = (const char*)(PA + (size_t)b * S_ * PA_LD);
#pragma nounroll
      for (int ch = 0; ch < nch; ++ch) {
        u32x4 vr[8];
#pragma unroll
        for (int r8 = 0; r8 < 8; ++r8) {
          const int row = r8 * 4 + g4;
          const int key = Il[ch * 32 + row];
          vr[r8] = *(const u32x4*)(kbase + (size_t)key * (PA_LD * 2) + PA_VA * 2 + c * 16);
        }
        f32x4 cc[2];
#pragma unroll
        for (int tt = 0; tt < 2; ++tt) {
          const int key = Il[ch * 32 + tt * 16 + c];
          const bf16_t* kp = (const bf16_t*)(kbase + (size_t)key * (PA_LD * 2)) + PA_KA + g4 * 8;
          const bf16x8 ka0 = ld_frag_g(kp), ka1 = ld_frag_g(kp + 32);
          f32x4 z = {0.f, 0.f, 0.f, 0.f};
          z = MFMA16(ka0, qf0, z);
          z = MFMA16(ka1, qf1, z);
          cc[tt] = z;
        }
        float cmax = -INFINITY;
#pragma unroll
        for (int tt = 0; tt < 2; ++tt)
#pragma unroll
          for (int i = 0; i < 4; ++i) {
            const int e = ch * 32 + tt * 16 + 4 * g4 + i;
            const float v = e < nsel ? cc[tt][i] : -INFINITY;
            cc[tt][i] = v; cmax = fmaxf(cmax, v);
          }
        cmax = fmaxf(cmax, __shfl_xor(cmax, 16)); cmax = fmaxf(cmax, __shfl_xor(cmax, 32));
        const float mn = fmaxf(m, cmax);
        const float alpha = fexp2((m - mn) * sc2);
        m = mn;
        float ps = 0.f; float pv[8];
#pragma unroll
        for (int tt = 0; tt < 2; ++tt)
#pragma unroll
          for (int i = 0; i < 4; ++i) { const float e2 = fexp2((cc[tt][i] - mn) * sc2); pv[tt * 4 + i] = e2; ps += e2; }
        sum = sum * alpha + ps;
        u32x4 pw; pw[0] = pack2(pv[0], pv[1]); pw[1] = pack2(pv[2], pv[3]); pw[2] = pack2(pv[4], pv[5]); pw[3] = pack2(pv[6], pv[7]);
        const bf16x8 pf = __builtin_bit_cast(bf16x8, pw);
#pragma unroll
        for (int ct = 0; ct < 8; ++ct) acc[ct] *= alpha;
#pragma unroll
        for (int r8 = 0; r8 < 8; ++r8) *(u32x4*)(Vl + (r8 * 4 + g4) * 288 + c * 16) = vr[r8];
        {
          const int qq = c >> 2, pp = c & 3;
          const char* vb0 = Vl + (4 * g4 + qq) * 288 + pp * 8;
#pragma unroll
          for (int ct = 0; ct < 8; ++ct) {
            const s16x4 lo = __builtin_amdgcn_ds_read_tr16_b64_v4i16((lds_s16x4*)(vb0 + ct * 32));
            const s16x4 hi = __builtin_amdgcn_ds_read_tr16_b64_v4i16((lds_s16x4*)(vb0 + 16 * 288 + ct * 32));
            const bf16x8 af = __builtin_shufflevector(lo, hi, 0, 1, 2, 3, 4, 5, 6, 7);
            acc[ct] = MFMA16(af, pf, acc[ct]);
          }
        }
      }
      sum += __shfl_xor(sum, 16); sum += __shfl_xor(sum, 32);
      const float inv = 1.f / sum;
      if (c < 8) {
#pragma unroll
        for (int ct = 0; ct < 8; ++ct) {
          u32x2 w; w[0] = pack2(acc[ct][0] * inv, acc[ct][1] * inv); w[1] = pack2(acc[ct][2] * inv, acc[ct][3] * inv);
          *(u32x2*)(OL + q * 2064 + c * 256 + (ct * 16 + 4 * g4) * 2) = w;
        }
      }
      __syncthreads();
    }
    {
      const int h = wid;
      bf16x8 af[4];
#pragma unroll
      for (int ks = 0; ks < 4; ++ks) af[ks] = ld_frag_s(OL + c * 2064 + h * 256 + (ks * 32 + g4 * 8) * 2);
      bf16x8 wf[4][4];
#pragma unroll
      for (int nt = 0; nt < 4; ++nt) {
        const bf16_t* wp = WUVb + (size_t)(h * 64 + nt * 16 + c) * 128 + g4 * 8;
#pragma unroll
        for (int ks = 0; ks < 4; ++ks) wf[nt][ks] = ld_frag_g(wp + ks * 32);
      }
#pragma unroll
      for (int nt = 0; nt < 4; ++nt) {
        f32x4 cc = {0.f, 0.f, 0.f, 0.f};
#pragma unroll
        for (int ks = 0; ks < 4; ++ks) cc = MFMA16(af[ks], wf[nt][ks], cc);
#pragma unroll
        for (int i = 0; i < 4; ++i) YA[(size_t)(tok0 + 4 * g4 + i) * 512 + h * 64 + nt * 16 + c] = (bf16_t)f2bf(cc[i]);
      }
    }
    __syncthreads();
  }
}

DI void phase_merge(const Params& p, char* smem) {
  const bf16_t* YA = (const bf16_t*)(p.ws + OFF_SLAB + (size_t)64 * 1024 * 1024);
  const bf16_t* YB = (const bf16_t*)(p.ws + OFF_PA) + PA_QB;
  const bf16_t* Wa = (const bf16_t*)(p.ws + OFF_WB) + WOA;
  const bf16_t* Wb = (const bf16_t*)(p.ws + OFF_WB) + WOB;
  const bf16_t* GT = (const bf16_t*)(p.ws + OFF_GATES);
  bf16_t* MG = (bf16_t*)(p.ws + OFF_SLAB);
  for (int it = 0;; ++it) {
    int mt, nt; int s = sched_tile(it, 128, 4, mt, nt);
    if (s < 0) break; if (s == 0) continue;
    acc8p_t acc;
    gemm8p<512, 512, 8>(YA + (size_t)mt * 256 * 512, Wa + (size_t)nt * 256 * 512, smem, acc);
    EPI_IDS
#pragma unroll
    for (int ai = 0; ai < 2; ++ai) {
      epi_stage(acc, ai, smem, wr, wc, fr, fq);
      __syncthreads();
      epi_gate_bf16<false>(smem, MG, GT, 0, mt, nt, ai, tid);
      __syncthreads();
    }
  }
  for (int it = 0;; ++it) {
    int mt, nt; int s = sched_tile(it, 128, 4, mt, nt);
    if (s < 0) break; if (s == 0) continue;
    acc8p_t acc;
    gemm8p<PA_LD, 512, 8>(YB + (size_t)mt * 256 * PA_LD, Wb + (size_t)nt * 256 * 512, smem, acc);
    EPI_IDS
#pragma unroll
    for (int ai = 0; ai < 2; ++ai) {
      epi_stage(acc, ai, smem, wr, wc, fr, fq);
      __syncthreads();
      epi_gate_bf16<true>(smem, MG, GT, 1024, mt, nt, ai, tid);
      __syncthreads();
    }
  }
}

DI void phase_outproj(const Params& p, char* smem) {
  const bf16_t* MG = (const bf16_t*)(p.ws + OFF_SLAB);
  const bf16_t* W = (const bf16_t*)(p.ws + OFF_WB) + WOUT;
  float* out = p.out;
  for (int it = 0;; ++it) {
    int mt, nt; int s = sched_tile(it, 128, 4, mt, nt);
    if (s < 0) break; if (s == 0) continue;
    acc8p_t acc;
    gemm8p<D_, D_, 16>(MG + (size_t)mt * 256 * D_, W + (size_t)nt * 256 * D_, smem, acc);
    EPI_IDS
#pragma unroll
    for (int ai = 0; ai < 2; ++ai) {
      epi_stage(acc, ai, smem, wr, wc, fr, fq);
      __syncthreads();
      epi_rmw_f32(smem, out, out, mt, nt, ai, 1.0f, tid);
      __syncthreads();
    }
  }
}

#define XB_TMO      128
#define XB_XCNT(j)  (256  + 64 * (j))
#define XB_XSUB(j)  (1280 + 64 * (j))
#define XB_XGEN(j)  (2304 + 64 * (j))
#define XB_TOP      3328
#define XB_TOPGEN   3392
#define XCD_BAR_WORDS 3456
#define XB_SPIN_CAP (1u << 22)
#define LAS __attribute__((address_space(3)))
DI unsigned xb_ld(unsigned* p) { return __hip_atomic_load(p, __ATOMIC_RELAXED, __HIP_MEMORY_SCOPE_AGENT); }
DI unsigned xb_add(unsigned* p, unsigned v) { return __hip_atomic_fetch_add(p, v, __ATOMIC_RELAXED, __HIP_MEMORY_SCOPE_AGENT); }
DI unsigned xb_xcc_id() { return (unsigned)__builtin_amdgcn_s_getreg((3 << 11) | 20) & 0xFu; }
#define XB_SPIN(cond, bar) do { unsigned _sp = 0; while (cond) { __builtin_amdgcn_s_sleep(1); \
    if ((++_sp & 255u) == 0u) { if (xb_ld(&(bar)[XB_TMO])) break; if (_sp > XB_SPIN_CAP) { atomicAdd(&(bar)[XB_TMO], 1u); break; } } } } while (0)
struct XcdBarrier { unsigned* bar; unsigned x; volatile LAS unsigned* st; };
DI XcdBarrier xcd_barrier_post(unsigned* bar, volatile LAS unsigned* st) {
  XcdBarrier b; b.bar = bar; b.x = xb_xcc_id(); b.st = st;
  if (threadIdx.x == 0) (void)xb_add(&bar[XB_XCNT(b.x)], 1u);
  return b;
}
DI void xcd_barrier_complete(unsigned* bar, unsigned x, unsigned& nloc, unsigned& nx) {
  const unsigned G = gridDim.x * gridDim.y * gridDim.z;
  unsigned sum, cnt, mine, sp = 0u;
  for (;;) {
    sum = 0u; cnt = 0u; mine = 0u;
#pragma unroll
    for (unsigned j = 0; j < 16; ++j) { const unsigned c = xb_ld(&bar[XB_XCNT(j)]); sum += c; cnt += (c > 0u) ? 1u : 0u; mine = (j == x) ? c : mine; }
    if (sum == G) break;
    __builtin_amdgcn_s_sleep(1);
    if ((++sp & 255u) == 0u) { if (xb_ld(&bar[XB_TMO])) break; if (sp > XB_SPIN_CAP) { atomicAdd(&bar[XB_TMO], 1u); break; } }
  }
  nloc = mine > 0u ? mine : 1u; nx = cnt > 0u ? cnt : 1u;
}
DI void xcd_barrier(const XcdBarrier& b) {
  asm volatile("s_waitcnt vmcnt(0)" ::: "memory");
  __syncthreads();
  if (threadIdx.x == 0) {
    unsigned* bar = b.bar;
    __builtin_amdgcn_s_waitcnt(0);
    unsigned nloc = b.st[0], nx = b.st[1];
    if (nloc == 0u) { xcd_barrier_complete(bar, b.x, nloc, nx); b.st[0] = nloc; b.st[1] = nx; }
    const unsigned old = xb_add(&bar[XB_XSUB(b.x)], 1u);
    const unsigned gen = old / nloc;
    if (old + 1u == (gen + 1u) * nloc) {
      __builtin_amdgcn_fence(__ATOMIC_RELEASE, "agent");
      asm volatile("s_waitcnt vmcnt(0)" ::: "memory");
      const unsigned og = xb_add(&bar[XB_TOP], 1u);
      const unsigned tg = og / nx;
      if (og + 1u == (tg + 1u) * nx) xb_add(&bar[XB_TOPGEN], 1u);
      else XB_SPIN(xb_ld(&bar[XB_TOPGEN]) == tg, bar);
      __builtin_amdgcn_fence(__ATOMIC_ACQUIRE, "agent");
      xb_add(&bar[XB_XGEN(b.x)], 1u);
      asm volatile("s_waitcnt vmcnt(0)" ::: "memory");
    } else {
      XB_SPIN(xb_ld(&bar[XB_XGEN(b.x)]) == gen, bar);
      __builtin_amdgcn_fence(__ATOMIC_ACQUIRE, "agent");
      asm volatile("s_waitcnt vmcnt(0)" ::: "memory");
    }
  }
  __syncthreads();
}

DI void run_phase(const Params& p, int ph, char* smem) {
  switch (ph) {
    case 0: phase_prep(p, smem); break;
    case 1: phase_ffn_gu(p, W1GU, smem); break;
    case 2: phase_ffn_down(p, W1D, p.x, smem); break;
    case 3: phase_rmsnorm_widx(p, smem); break;
    case 4: phase_win(p, smem); break;
    case 5: phase_qproj(p, smem); break;
    case 6: phase_mix<false>(p, smem); break;
    case 13: phase_mix<true>(p, smem); break;
    case 14: phase_sb_dummy(p, smem); break;
    case 7: phase_sparse(p, smem); break;
    case 8: phase_merge(p, smem); break;
    case 9: phase_outproj(p, smem); break;
    case 10: phase_rmsnorm(p.out, p.g_ffn2, (bf16_t*)(p.ws + OFF_H)); break;
    case 11: phase_ffn_gu(p, W2GU, smem); break;
    case 12: phase_ffn_down(p, W2D, p.out, smem); break;
  }
}
constexpr int NPHASE = 13;

#if !MULTI_LAUNCH
__global__ void __launch_bounds__(512, 2) mega_kernel(Params p) {
  __shared__ __attribute__((aligned(16))) char smem[SMEM_BYTES];
  __shared__ uint4 xb_words;
  cg::grid_group grid = cg::this_grid();
  if (threadIdx.x == 0) xb_words = make_uint4(0u, 0u, 0u, 0u);
  __syncthreads();
  XcdBarrier xb = xcd_barrier_post((unsigned*)(p.ws + OFF_CNT + 256), (volatile LAS unsigned*)&xb_words);
  unsigned* bar0 = (unsigned*)(p.ws + OFF_CNT + 256);
  if (threadIdx.x == 0) g_sched[3] = (int)xb_add(&bar0[XB_XCNT(xb.x) + 16], 1u);
  grid.sync();
  if (threadIdx.x == 0) {
    const unsigned per = gridDim.x >> 3; bool ok = (gridDim.x & 7) == 0 && xb.x < 8;
    for (unsigned jx = 0; jx < 16; ++jx) { const unsigned c = xb_ld(&bar0[XB_XCNT(jx) + 16]); ok = ok && (c == (jx < 8 ? per : 0u)); }
    g_sched[0] = ok ? (int)xb.x : (int)(blockIdx.x & 7);
    g_sched[1] = ok ? g_sched[3] : (int)(blockIdx.x >> 3);
  }
  __syncthreads();
#pragma nounroll
  for (int ph = 0; ph < NPHASE; ++ph) {
    int phv = ph; asm volatile("" : "+s"(phv));
    run_phase(p, phv, smem);
    if (ph + 1 < NPHASE) { XcdBarrier xb2; xb2.bar = (unsigned*)(p.ws + OFF_CNT + 256); xb2.x = xb_xcc_id(); xb2.st = (volatile LAS unsigned*)&xb_words; xcd_barrier(xb2); }
  }
}
#else
template <int PH>
__global__ void __launch_bounds__(512, 2) phase_kernel(Params p) {
  __shared__ __attribute__((aligned(16))) char smem[SMEM_BYTES];
  if (threadIdx.x == 0) { g_sched[0] = blockIdx.x & 7; g_sched[1] = blockIdx.x >> 3; }
  __syncthreads();
  run_phase(p, PH, smem);
}
#ifndef PROBE_MASK
#define PROBE_MASK 0
#endif
template <int PH> static void launch_phases(const Params& p, hipStream_t stream) {
  hipLaunchKernelGGL(phase_kernel<PH>, dim3(256), dim3(NTHR), 0, stream, p);
  if constexpr (((PROBE_MASK >> PH) & 1) != 0 && PH != 6) hipLaunchKernelGGL(phase_kernel<PH>, dim3(256), dim3(NTHR), 0, stream, p);
  if constexpr (((PROBE_MASK >> PH) & 1) != 0 && PH == 6) hipLaunchKernelGGL(phase_kernel<13>, dim3(256), dim3(NTHR), 0, stream, p);
  if constexpr (((PROBE_MASK >> 14) & 1) != 0 && PH == 5) hipLaunchKernelGGL(phase_kernel<14>, dim3(256), dim3(NTHR), 0, stream, p);
  if constexpr (PH + 1 < NPHASE) launch_phases<PH + 1>(p, stream);
}
#endif

extern "C" void kernel_launch(void* const* d_in, const int* in_sizes, int n_in, void* d_out, int out_size, void* d_ws,
                              size_t ws_size, hipStream_t stream) {
  Params p{};
  p.x = (const float*)d_in[0]; p.pos = (const int*)d_in[1];
  p.g_ffn1 = (const float*)d_in[2]; p.w1g = (const float*)d_in[3]; p.w1u = (const float*)d_in[4]; p.w1d = (const float*)d_in[5];
  p.g_mix = (const float*)d_in[6]; p.w_in = (const float*)d_in[7]; p.g_cq = (const float*)d_in[8]; p.w_uq = (const float*)d_in[9];
  p.w_qi = (const float*)d_in[10]; p.g_qa = (const float*)d_in[11]; p.g_ka = (const float*)d_in[12]; p.w_uv = (const float*)d_in[13];
  p.w_oa = (const float*)d_in[14]; p.w_ob = (const float*)d_in[15]; p.w_out = (const float*)d_in[16]; p.g_ffn2 = (const float*)d_in[17];
  p.w2g = (const float*)d_in[18]; p.w2u = (const float*)d_in[19]; p.w2d = (const float*)d_in[20];
  p.out = (float*)d_out; p.ws = (char*)d_ws;
  if (ws_size < WS_NEED) { fprintf(stderr, "workspace too small: %zu < %zu\n", ws_size, (size_t)WS_NEED); return; }
  (void)hipMemsetAsync((char*)d_ws + OFF_CNT, 0, 256 + 16384, stream);
#if MULTI_LAUNCH
  launch_phases<0>(p, stream);
#else
  static int grid_blocks = 0;
  if (!grid_blocks) {
    int dev = 0, cus = 0, per_cu = 0;
    (void)hipGetDevice(&dev);
    (void)hipDeviceGetAttribute(&cus, hipDeviceAttributeMultiprocessorCount, dev);
    (void)hipOccupancyMaxActiveBlocksPerMultiprocessor(&per_cu, mega_kernel, NTHR, 0);
    if (per_cu > 1) per_cu = 1;
    grid_blocks = cus * per_cu;
    if (grid_blocks > 256) grid_blocks = 256;
  }
  void* args[] = {&p};
  hipError_t e = hipLaunchCooperativeKernel((void*)mega_kernel, dim3(grid_blocks), dim3(NTHR), args, 0, stream);
  if (e != hipSuccess) fprintf(stderr, "cooperative launch failed: %s (grid %d)\n", hipGetErrorString(e), grid_blocks);
#endif
}
```
